# Optimizing an MI355X kernel written in HIP

```python
import math
import jax, jax.numpy as jnp
from jax import lax
import numpy as np

D_MODEL = 1024
BATCH = 8
SEQ = 4096
DEPTH = 4

EPS = 1e-6
ROPE_THETA = 10000.0
NEG_INF = -1e30
HEAD_DIM = 64
N_Q_HEADS = 8
N_KV_HEADS = 2
GQA_GROUP = N_Q_HEADS // N_KV_HEADS
WINDOW = 128
BLOCK = 128
ATTN_WIDTH = N_Q_HEADS * HEAD_DIM
KV_WIDTH = N_KV_HEADS * HEAD_DIM
SSM_CH = 16
SSM_GROUPS = 32
SSM_STATE = 64
SSM_WIDTH = SSM_GROUPS * SSM_CH
N_MEM = 256
X_HEADS = 4
X_HEAD_DIM = 128
X_WIDTH = X_HEADS * X_HEAD_DIM

MIX_WIDTH = ATTN_WIDTH + SSM_WIDTH + X_WIDTH
SPLIT_SIZES = (ATTN_WIDTH, KV_WIDTH, KV_WIDTH, ATTN_WIDTH, SSM_WIDTH, SSM_WIDTH, X_WIDTH, X_WIDTH)
IN_WIDTH = sum(SPLIT_SIZES)
SPLIT_POINTS = tuple(int(v) for v in np.cumsum(SPLIT_SIZES)[:-1])

kernel_name = "hymba_style_swa_s5_memxattn_trunk"


def _rms(x, g):
    xf = x.astype(jnp.float32)
    y = xf * lax.rsqrt(jnp.mean(xf * xf, axis=-1, keepdims=True) + EPS)
    return (y * g.astype(jnp.float32)).astype(x.dtype)


def _rope(x, pos):
    half = x.shape[-1] // 2
    inv = ROPE_THETA ** (-jnp.arange(half, dtype=jnp.float32) / half)
    ang = pos.astype(jnp.float32)[..., None] * inv
    cos = jnp.cos(ang)[:, :, None, :]
    sin = jnp.sin(ang)[:, :, None, :]
    xf = x.astype(jnp.float32)
    x1, x2 = xf[..., :half], xf[..., half:]
    out = jnp.concatenate([x1 * cos - x2 * sin, x2 * cos + x1 * sin], axis=-1)
    return out.astype(x.dtype)


def _sliding_window_attn(q, k, v, sinks):
    b, s = q.shape[0], q.shape[1]
    nb = s // BLOCK
    qb = q.reshape(b, nb, BLOCK, N_KV_HEADS, GQA_GROUP, HEAD_DIM)
    kb = k.reshape(b, nb, BLOCK, N_KV_HEADS, HEAD_DIM)
    vb = v.reshape(b, nb, BLOCK, N_KV_HEADS, HEAD_DIM)
    zk = jnp.zeros_like(kb[:, :1])
    kk = jnp.concatenate([jnp.concatenate([zk, kb[:, :-1]], axis=1), kb], axis=2)
    vv = jnp.concatenate([jnp.concatenate([zk, vb[:, :-1]], axis=1), vb], axis=2)
    scale = 1.0 / math.sqrt(HEAD_DIM)
    sc = jnp.einsum('bnqhgd,bnkhd->bnhgqk', qb, kk).astype(jnp.float32) * scale
    i = jnp.arange(BLOCK)[:, None]
    j = jnp.arange(2 * BLOCK)[None, :]
    band = (j >= i + BLOCK - WINDOW + 1) & (j <= i + BLOCK)
    first = (jnp.arange(nb) > 0)[:, None, None] | (j >= BLOCK)[None]
    valid = band[None] & first
    sc = jnp.where(valid[None, :, None, None], sc, NEG_INF)
    sink = sinks.astype(jnp.float32).reshape(N_KV_HEADS, GQA_GROUP)[None, None, :, :, None, None]
    m = jnp.maximum(jnp.max(sc, axis=-1, keepdims=True), sink)
    p = jnp.exp(sc - m)
    p = p / (jnp.sum(p, axis=-1, keepdims=True) + jnp.exp(sink - m))
    o = jnp.einsum('bnhgqk,bnkhd->bnqhgd', p.astype(v.dtype), vv)
    return o.reshape(b, s, ATTN_WIDTH)


def _ssm_scan_combine(e1, e2):
    a1r, a1i, b1r, b1i = e1
    a2r, a2i, b2r, b2i = e2
    return (a1r * a2r - a1i * a2i,
            a1r * a2i + a1i * a2r,
            a2r * b1r - a2i * b1i + b2r,
            a2r * b1i + a2i * b1r + b2i)


def _s5(u, lam_re, lam_im, log_dt, b_re, b_im, c_re, c_im, d_skip, w_glu, b_glu):
    b, s = u.shape[0], u.shape[1]
    f32 = jnp.float32
    uf = u.astype(f32).reshape(b, s, SSM_GROUPS, SSM_CH)
    lr, li = lam_re.astype(f32), lam_im.astype(f32)
    dt = jnp.exp(log_dt.astype(f32))[:, None]
    mag = jnp.exp(lr * dt)
    ar, ai = mag * jnp.cos(li * dt), mag * jnp.sin(li * dt)
    den = lr * lr + li * li
    fr = ((ar - 1.0) * lr + ai * li) / den
    fi = (ai * lr - (ar - 1.0) * li) / den
    br, bi = b_re.astype(f32), b_im.astype(f32)
    bbr = fr[..., None] * br - fi[..., None] * bi
    bbi = fr[..., None] * bi + fi[..., None] * br
    xr = jnp.einsum('bsgc,gpc->bsgp', uf, bbr)
    xi = jnp.einsum('bsgc,gpc->bsgp', uf, bbi)
    a_r = jnp.broadcast_to(ar[None, None], (1, s, SSM_GROUPS, SSM_STATE))
    a_i = jnp.broadcast_to(ai[None, None], (1, s, SSM_GROUPS, SSM_STATE))
    _, _, hr, hi = lax.associative_scan(_ssm_scan_combine, (a_r, a_i, xr, xi), axis=1)
    y = (jnp.einsum('bsgp,gcp->bsgc', hr, c_re.astype(f32))
         - jnp.einsum('bsgp,gcp->bsgc', hi, c_im.astype(f32)))
    y = (y + d_skip.astype(f32).reshape(SSM_GROUPS, SSM_CH) * uf).reshape(b, s, SSM_WIDTH)
    y = jax.nn.gelu(y)
    y = y * jax.nn.sigmoid(y @ w_glu.astype(f32) + b_glu.astype(f32))
    return y.astype(u.dtype)


def _mem_cross_attn(q, k, v):
    b, s = q.shape[0], q.shape[1]
    sc = jnp.einsum('bshd,bmhd->bhsm', q, k).astype(jnp.float32) / math.sqrt(X_HEAD_DIM)
    p = jax.nn.softmax(sc, axis=-1)
    o = jnp.einsum('bhsm,bmhd->bshd', p.astype(v.dtype), v)
    return o.reshape(b, s, X_WIDTH)


def setup_inputs(seed: int = 0) -> dict:
    key = jax.random.key(seed)
    ks = jax.random.split(key, 24)
    f32 = jnp.float32
    nrm = lambda k, shape, std: jax.random.normal(k, shape, f32) * std
    x = nrm(ks[0], (BATCH, SEQ, D_MODEL), 1.0)
    mem = nrm(ks[1], (BATCH, N_MEM, D_MODEL), 1.0)
    offset = jax.random.randint(ks[2], (BATCH, 1), 0, 4096, dtype=jnp.int32)
    positions = offset + jnp.arange(SEQ, dtype=jnp.int32)[None, :]
    norm_g = 1.0 + nrm(ks[3], (DEPTH, D_MODEL), 0.02)
    w_in = nrm(ks[4], (DEPTH, D_MODEL, IN_WIDTH), D_MODEL ** -0.5)
    q_norm_g = 1.0 + nrm(ks[5], (DEPTH, HEAD_DIM), 0.02)
    k_norm_g = 1.0 + nrm(ks[6], (DEPTH, HEAD_DIM), 0.02)
    sinks = nrm(ks[7], (DEPTH, N_Q_HEADS), 0.5)
    lam_re = -0.5 + nrm(ks[8], (DEPTH, SSM_GROUPS, SSM_STATE), 0.01)
    lam_im = (math.pi * jnp.arange(SSM_STATE, dtype=f32))[None, None, :] + nrm(ks[9], (DEPTH, SSM_GROUPS, SSM_STATE), 0.01)
    log_dt = jax.random.uniform(ks[10], (DEPTH, SSM_GROUPS), f32, math.log(1e-3), math.log(1e-1))
    b_re = nrm(ks[11], (DEPTH, SSM_GROUPS, SSM_STATE, SSM_CH), (2.0 * SSM_CH) ** -0.5)
    b_im = nrm(ks[12], (DEPTH, SSM_GROUPS, SSM_STATE, SSM_CH), (2.0 * SSM_CH) ** -0.5)
    c_re = nrm(ks[13], (DEPTH, SSM_GROUPS, SSM_CH, SSM_STATE), (2.0 * SSM_STATE) ** -0.5)
    c_im = nrm(ks[14], (DEPTH, SSM_GROUPS, SSM_CH, SSM_STATE), (2.0 * SSM_STATE) ** -0.5)
    d_skip = nrm(ks[15], (DEPTH, SSM_WIDTH), 1.0)
    w_glu = nrm(ks[16], (DEPTH, SSM_WIDTH, SSM_WIDTH), SSM_WIDTH ** -0.5)
    b_glu = nrm(ks[17], (DEPTH, SSM_WIDTH), 0.02)
    mem_norm_g = 1.0 + nrm(ks[18], (DEPTH, D_MODEL), 0.02)
    w_mem_kv = nrm(ks[19], (DEPTH, D_MODEL, 2 * X_WIDTH), D_MODEL ** -0.5)
    xq_norm_g = 1.0 + nrm(ks[20], (DEPTH, X_HEAD_DIM), 0.02)
    xk_norm_g = 1.0 + nrm(ks[21], (DEPTH, X_HEAD_DIM), 0.02)
    w_out = nrm(ks[22], (DEPTH, MIX_WIDTH, D_MODEL), (MIX_WIDTH * 2.0 * DEPTH) ** -0.5)
    return {"x": x, "mem": mem, "positions": positions, "norm_g": norm_g, "w_in": w_in,
            "q_norm_g": q_norm_g, "k_norm_g": k_norm_g, "sinks": sinks,
            "lam_re": lam_re, "lam_im": lam_im, "log_dt": log_dt,
            "b_re": b_re, "b_im": b_im, "c_re": c_re, "c_im": c_im, "d_skip": d_skip,
            "w_glu": w_glu, "b_glu": b_glu, "mem_norm_g": mem_norm_g, "w_mem_kv": w_mem_kv,
            "xq_norm_g": xq_norm_g, "xk_norm_g": xk_norm_g, "w_out": w_out}


def reference(x, mem, positions, norm_g, w_in, q_norm_g, k_norm_g, sinks, lam_re, lam_im, log_dt,
              b_re, b_im, c_re, c_im, d_skip, w_glu, b_glu, mem_norm_g, w_mem_kv,
              xq_norm_g, xk_norm_g, w_out):
    b, s = x.shape[0], x.shape[1]
    for l in range(DEPTH):
        h = _rms(x, norm_g[l])
        z = h @ w_in[l]
        aq, ak, av, ag, su, sg, xq, xg = jnp.split(z, SPLIT_POINTS, axis=-1)
        aq = _rope(_rms(aq.reshape(b, s, N_Q_HEADS, HEAD_DIM), q_norm_g[l]), positions)
        ak = _rope(_rms(ak.reshape(b, s, N_KV_HEADS, HEAD_DIM), k_norm_g[l]), positions)
        av = av.reshape(b, s, N_KV_HEADS, HEAD_DIM)
        out_a = _sliding_window_attn(aq, ak, av, sinks[l]) * jax.nn.silu(ag)
        out_b = _s5(su, lam_re[l], lam_im[l], log_dt[l], b_re[l], b_im[l], c_re[l], c_im[l],
                    d_skip[l], w_glu[l], b_glu[l]) * jax.nn.silu(sg)
        mkv = _rms(mem, mem_norm_g[l]) @ w_mem_kv[l]
        mk, mv = jnp.split(mkv, 2, axis=-1)
        mk = _rms(mk.reshape(b, N_MEM, X_HEADS, X_HEAD_DIM), xk_norm_g[l])
        mv = mv.reshape(b, N_MEM, X_HEADS, X_HEAD_DIM)
        xq = _rms(xq.reshape(b, s, X_HEADS, X_HEAD_DIM), xq_norm_g[l])
        out_c = _mem_cross_attn(xq, mk, mv) * jax.nn.silu(xg)
        y = jnp.concatenate([out_a, out_b, out_c], axis=-1) @ w_out[l]
        x = x + y.astype(x.dtype)
    return x
```

```cpp
#include <hip/hip_runtime.h>
#include <stdint.h>
#include <math.h>

constexpr int D_MODEL = 1024, BATCH = 8, SEQ = 4096, DEPTH = 4, MTOK = BATCH * SEQ;
constexpr int HD = 64, NQH = 8, NKVH = 2, WINDOW = 128;
constexpr int SSM_CH = 16, SSM_G = 32, SSM_P = 64, SSM_W = 512, N_MEM = 256, XH = 4, XHD = 128;
constexpr int MIX_W = 1536, IN_W = 3328;
constexpr int ZQ = 0, ZK = 512, ZV = 640, ZG = 768, ZU = 1280, ZSG = 1792, ZXQ = 2304, ZXG = 2816;
constexpr float EPS = 1e-6f;

typedef unsigned short bf16_t;
__device__ __forceinline__ bf16_t f2bf(float f) { unsigned u = __float_as_uint(f); return (bf16_t)((u + 0x7fffu + ((u >> 16) & 1u)) >> 16); }
__device__ __forceinline__ float bf2f(bf16_t h) { return __uint_as_float(((unsigned)h) << 16); }
__device__ __forceinline__ float sigmoidf_(float x) { return 1.f / (1.f + __expf(-x)); }
__device__ __forceinline__ float siluf_(float x) { return x * sigmoidf_(x); }
__device__ __forceinline__ float gelu_tanh(float x) { const float c = 0.7978845608028654f; float u = c * (x + 0.044715f * x * x * x); return 0.5f * x * (1.f + tanhf(u)); }
__device__ __forceinline__ float wave_sum(float v) {
#pragma unroll
    for (int o = 1; o < 64; o <<= 1) v += __shfl_xor(v, o);
    return v;
}

constexpr size_t MiB = 1u << 20;
constexpr size_t WS_Z = 0;
constexpr size_t WS_MIX = 208 * MiB;
constexpr size_t WS_H = 304 * MiB;
constexpr size_t WS_Y2 = 368 * MiB;
constexpr size_t WS_MK = 400 * MiB;
constexpr size_t WS_MV = 408 * MiB;
constexpr size_t WS_ROPE = 416 * MiB;
constexpr size_t WS_SSMP = 424 * MiB;
constexpr size_t WS_HM = 426 * MiB;
constexpr size_t WS_MKV = 442 * MiB;
constexpr size_t WS_END = 450 * MiB;
constexpr int SSMP_LAYER = SSM_G * SSM_P * 2 + SSM_G * SSM_P * SSM_CH * 2;

__global__ void k_rope_table(const int* __restrict__ pos, float* __restrict__ tab) {
    int idx = blockIdx.x * blockDim.x + threadIdx.x;
    if (idx >= MTOK * 32) return;
    int tok = idx >> 5, i = idx & 31;
    float inv = powf(10000.0f, -(float)i / 32.0f);
    float ang = (float)pos[tok] * inv;
    double a = (double)ang;
    tab[tok * 64 + i] = (float)cos(a);
    tab[tok * 64 + 32 + i] = (float)sin(a);
}
__global__ void k_ssm_params(const float* lam_re, const float* lam_im, const float* log_dt, const float* b_re, const float* b_im, float* out) {
    int idx = blockIdx.x * blockDim.x + threadIdx.x;
    if (idx >= DEPTH * SSM_G * SSM_P) return;
    int l = idx / (SSM_G * SSM_P), gp = idx % (SSM_G * SSM_P), g = gp / SSM_P;
    double lr = lam_re[idx], li = lam_im[idx], dt = exp((double)log_dt[l * SSM_G + g]);
    double mag = exp(lr * dt), ar = mag * cos(li * dt), ai = mag * sin(li * dt);
    double den = lr * lr + li * li;
    double fr = ((ar - 1.0) * lr + ai * li) / den, fi = (ai * lr - (ar - 1.0) * li) / den;
    float* o = out + (size_t)l * SSMP_LAYER;
    o[gp * 2] = (float)ar; o[gp * 2 + 1] = (float)ai;
    float* bb = o + SSM_G * SSM_P * 2 + (size_t)gp * SSM_CH * 2;
    for (int c = 0; c < SSM_CH; ++c) {
        double br = b_re[(size_t)idx * SSM_CH + c], bi = b_im[(size_t)idx * SSM_CH + c];
        bb[c * 2] = (float)(fr * br - fi * bi); bb[c * 2 + 1] = (float)(fr * bi + fi * br);
    }
}
__global__ void k_rmsnorm_rows(const float* __restrict__ x, const float* __restrict__ g, bf16_t* __restrict__ out, int rows) {
    int row = blockIdx.x * (blockDim.x >> 6) + (threadIdx.x >> 6), lane = threadIdx.x & 63;
    if (row >= rows) return;
    const float* xr = x + (size_t)row * D_MODEL;
    float v[16]; float s = 0.f;
#pragma unroll
    for (int j = 0; j < 16; ++j) { v[j] = xr[lane + 64 * j]; s += v[j] * v[j]; }
    s = wave_sum(s);
    float r = rsqrtf(s * (1.f / D_MODEL) + EPS);
#pragma unroll
    for (int j = 0; j < 16; ++j) out[(size_t)row * D_MODEL + lane + 64 * j] = f2bf(v[j] * r * g[lane + 64 * j]);
}

template <class Epi>
__global__ __launch_bounds__(256) void k_sgemm(const bf16_t* __restrict__ A, int lda, const float* __restrict__ B, int ldb, int K, Epi epi) {
    __shared__ float As[16][65];
    __shared__ float Bs[16][64];
    int tx = threadIdx.x & 15, ty = threadIdx.x >> 4;
    int row0 = blockIdx.y * 64, col0 = blockIdx.x * 64;
    float acc[4][4] = {};
    for (int k0 = 0; k0 < K; k0 += 16) {
        {
            int r = threadIdx.x >> 2, c4 = (threadIdx.x & 3) * 4;
            const bf16_t* p = A + (size_t)(row0 + r) * lda + k0 + c4;
#pragma unroll
            for (int i = 0; i < 4; ++i) As[c4 + i][r] = bf2f(p[i]);
            int kr = threadIdx.x >> 4, cc = (threadIdx.x & 15) * 4;
            const float* q = B + (size_t)(k0 + kr) * ldb + col0 + cc;
#pragma unroll
            for (int i = 0; i < 4; ++i) Bs[kr][cc + i] = q[i];
        }
        __syncthreads();
#pragma unroll
        for (int k = 0; k < 16; ++k) {
            float a[4], b[4];
#pragma unroll
            for (int i = 0; i < 4; ++i) { a[i] = As[k][ty * 4 + i]; b[i] = Bs[k][tx * 4 + i]; }
#pragma unroll
            for (int i = 0; i < 4; ++i)
#pragma unroll
                for (int j = 0; j < 4; ++j) acc[i][j] += a[i] * b[j];
        }
        __syncthreads();
    }
#pragma unroll
    for (int i = 0; i < 4; ++i)
#pragma unroll
        for (int j = 0; j < 4; ++j) epi(row0 + ty * 4 + i, col0 + tx * 4 + j, acc[i][j]);
}
struct EpiZ { bf16_t* z; __device__ void operator()(int r, int c, float v) const { z[(size_t)r * IN_W + c] = f2bf(v); } };
struct EpiF32 { float* o; int ld; __device__ void operator()(int r, int c, float v) const { o[(size_t)r * ld + c] = v; } };
struct EpiGlu { const bf16_t* y2; const bf16_t* z; const float* bg; bf16_t* mix;
    __device__ void operator()(int r, int c, float v) const {
        float y = bf2f(y2[(size_t)r * SSM_W + c]);
        float sg = bf2f(z[(size_t)r * IN_W + ZSG + c]);
        mix[(size_t)r * MIX_W + 512 + c] = f2bf(y * sigmoidf_(v + bg[c]) * siluf_(sg));
    } };
struct EpiOut { const float* xin; float* xout; __device__ void operator()(int r, int c, float v) const { size_t i = (size_t)r * D_MODEL + c; xout[i] = xin[i] + v; } };

__global__ void k_qk_prep(bf16_t* __restrict__ z, const float* __restrict__ qg, const float* __restrict__ kg, const float* __restrict__ xqg, const float* __restrict__ rope) {
    int tok = blockIdx.x * (blockDim.x >> 6) + (threadIdx.x >> 6), lane = threadIdx.x & 63;
    bf16_t* zr = z + (size_t)tok * IN_W;
    float cs = rope[(size_t)tok * 64 + (lane & 31)], sn = rope[(size_t)tok * 64 + 32 + (lane & 31)];
    for (int h = 0; h < NQH + NKVH; ++h) {
        int off = (h < NQH) ? ZQ + h * HD : ZK + (h - NQH) * HD;
        float v = bf2f(zr[off + lane]);
        float s = wave_sum(v * v);
        float g = (h < NQH) ? qg[lane] : kg[lane];
        v = v * rsqrtf(s * (1.f / HD) + EPS) * g;
        float p = __shfl_xor(v, 32);
        float o = (lane < 32) ? (v * cs - p * sn) : (v * cs + p * sn);
        zr[off + lane] = f2bf(o);
    }
    for (int h = 0; h < XH; ++h) {
        int off = ZXQ + h * XHD;
        float v0 = bf2f(zr[off + lane]), v1 = bf2f(zr[off + 64 + lane]);
        float s = wave_sum(v0 * v0 + v1 * v1);
        float r = rsqrtf(s * (1.f / XHD) + EPS);
        zr[off + lane] = f2bf(v0 * r * xqg[lane]); zr[off + 64 + lane] = f2bf(v1 * r * xqg[64 + lane]);
    }
}

__global__ __launch_bounds__(256) void k_attn_a(const bf16_t* __restrict__ z, const float* __restrict__ sinks, bf16_t* __restrict__ mix) {
    int idx = blockIdx.x * blockDim.x + threadIdx.x;
    int hq = idx / MTOK, tok = idx % MTOK;
    int t = tok % SEQ, b = tok / SEQ, kvh = hq / (NQH / NKVH);
    float q[HD], o[HD];
    const bf16_t* qp = z + (size_t)tok * IN_W + ZQ + hq * HD;
#pragma unroll
    for (int d = 0; d < HD; ++d) { q[d] = bf2f(qp[d]) * 0.125f; o[d] = 0.f; }
    float m = sinks[hq], l = 1.f;
    int s0 = t - (WINDOW - 1); if (s0 < 0) s0 = 0;
    for (int s = s0; s <= t; ++s) {
        const bf16_t* kp = z + (size_t)(b * SEQ + s) * IN_W + ZK + kvh * HD;
        const bf16_t* vp = z + (size_t)(b * SEQ + s) * IN_W + ZV + kvh * HD;
        float sc = 0.f;
#pragma unroll
        for (int d = 0; d < HD; ++d) sc += q[d] * bf2f(kp[d]);
        float mn = fmaxf(m, sc), f = __expf(m - mn), p = __expf(sc - mn);
        l = l * f + p; m = mn;
#pragma unroll
        for (int d = 0; d < HD; ++d) o[d] = o[d] * f + p * bf2f(vp[d]);
    }
    float il = 1.f / l;
    const bf16_t* gp = z + (size_t)tok * IN_W + ZG + hq * HD;
    bf16_t* mp = mix + (size_t)tok * MIX_W + hq * HD;
#pragma unroll
    for (int d = 0; d < HD; ++d) mp[d] = f2bf(o[d] * il * siluf_(bf2f(gp[d])));
}

__global__ __launch_bounds__(256) void k_attn_c(const bf16_t* __restrict__ z, const bf16_t* __restrict__ mk, const bf16_t* __restrict__ mv, bf16_t* __restrict__ mix) {
    __shared__ float qs[16][XHD];
    __shared__ float ps[16][N_MEM];
    __shared__ float red[16][4];
    int blk = blockIdx.x;
    int tile = blk % (SEQ / 16), h = (blk / (SEQ / 16)) % XH, b = blk / (SEQ / 16 * XH);
    int tid = threadIdx.x, lane = tid & 63, w = tid >> 6;
    int tok0 = b * SEQ + tile * 16;
    for (int i = tid; i < 16 * XHD; i += 256) { int tt = i / XHD, d = i % XHD; qs[tt][d] = bf2f(z[(size_t)(tok0 + tt) * IN_W + ZXQ + h * XHD + d]); }
    __syncthreads();
    const bf16_t* kr = mk + ((size_t)(b * N_MEM + tid) * 512 + h * XHD);
    float sc[16];
#pragma unroll
    for (int tt = 0; tt < 16; ++tt) sc[tt] = 0.f;
    for (int d = 0; d < XHD; ++d) {
        float kv = bf2f(kr[d]);
#pragma unroll
        for (int tt = 0; tt < 16; ++tt) sc[tt] += qs[tt][d] * kv;
    }
    const float scale = 0.08838834764831845f;
#pragma unroll
    for (int tt = 0; tt < 16; ++tt) {
        sc[tt] *= scale;
        float mx = sc[tt];
#pragma unroll
        for (int o = 1; o < 64; o <<= 1) mx = fmaxf(mx, __shfl_xor(mx, o));
        if (lane == 0) red[tt][w] = mx;
    }
    __syncthreads();
#pragma unroll
    for (int tt = 0; tt < 16; ++tt) {
        float mx = fmaxf(fmaxf(red[tt][0], red[tt][1]), fmaxf(red[tt][2], red[tt][3]));
        sc[tt] = __expf(sc[tt] - mx);
    }
    __syncthreads();
#pragma unroll
    for (int tt = 0; tt < 16; ++tt) {
        float s = wave_sum(sc[tt]);
        if (lane == 0) red[tt][w] = s;
    }
    __syncthreads();
#pragma unroll
    for (int tt = 0; tt < 16; ++tt) {
        float s = red[tt][0] + red[tt][1] + red[tt][2] + red[tt][3];
        ps[tt][tid] = sc[tt] / s;
    }
    __syncthreads();
    int d = tid & 127, th = tid >> 7;
    float o[8];
#pragma unroll
    for (int i = 0; i < 8; ++i) o[i] = 0.f;
    for (int m = 0; m < N_MEM; ++m) {
        float v = bf2f(mv[(size_t)(b * N_MEM + m) * 512 + h * XHD + d]);
#pragma unroll
        for (int i = 0; i < 8; ++i) o[i] += ps[th * 8 + i][m] * v;
    }
#pragma unroll
    for (int i = 0; i < 8; ++i) {
        int tok = tok0 + th * 8 + i;
        float g = bf2f(z[(size_t)tok * IN_W + ZXG + h * XHD + d]);
        mix[(size_t)tok * MIX_W + 1024 + h * XHD + d] = f2bf(o[i] * siluf_(g));
    }
}

__global__ void k_memkv_fin(const float* __restrict__ mkv, const float* __restrict__ xkg, bf16_t* __restrict__ mk, bf16_t* __restrict__ mv) {
    int row = blockIdx.x * (blockDim.x >> 6) + (threadIdx.x >> 6), lane = threadIdx.x & 63;
    const float* r = mkv + (size_t)row * 1024;
    for (int h = 0; h < XH; ++h) {
        float v0 = r[h * XHD + lane], v1 = r[h * XHD + 64 + lane];
        float s = wave_sum(v0 * v0 + v1 * v1);
        float rs = rsqrtf(s * (1.f / XHD) + EPS);
        mk[(size_t)row * 512 + h * XHD + lane] = f2bf(v0 * rs * xkg[lane]);
        mk[(size_t)row * 512 + h * XHD + 64 + lane] = f2bf(v1 * rs * xkg[64 + lane]);
        mv[(size_t)row * 512 + h * XHD + lane] = f2bf(r[512 + h * XHD + lane]);
        mv[(size_t)row * 512 + h * XHD + 64 + lane] = f2bf(r[512 + h * XHD + 64 + lane]);
    }
}

__global__ __launch_bounds__(64) void k_ssm_naive(const bf16_t* __restrict__ z, const float* __restrict__ ssmp, const float* __restrict__ c_re, const float* __restrict__ c_im,
                                                  const float* __restrict__ d_skip, bf16_t* __restrict__ y2) {
    int g = blockIdx.x % SSM_G, b = blockIdx.x / SSM_G, p = threadIdx.x;
    const float ar = ssmp[(g * SSM_P + p) * 2], ai = ssmp[(g * SSM_P + p) * 2 + 1];
    const float* bb = ssmp + SSM_G * SSM_P * 2 + (size_t)(g * SSM_P + p) * SSM_CH * 2;
    float bbr[SSM_CH], bbi[SSM_CH], cr[SSM_CH], ci[SSM_CH];
#pragma unroll
    for (int c = 0; c < SSM_CH; ++c) { bbr[c] = bb[c * 2]; bbi[c] = bb[c * 2 + 1]; cr[c] = c_re[(size_t)(g * SSM_CH + c) * SSM_P + p]; ci[c] = c_im[(size_t)(g * SSM_CH + c) * SSM_P + p]; }
    const int ch = (p >> 2) & 15;
    const float dsk = d_skip[g * SSM_CH + ch];
    float hr = 0.f, hi = 0.f;
    for (int t = 0; t < SEQ; ++t) {
        const bf16_t* up = z + (size_t)(b * SEQ + t) * IN_W + ZU + g * SSM_CH;
        float u[SSM_CH];
#pragma unroll
        for (int c = 0; c < SSM_CH; ++c) u[c] = bf2f(up[c]);
        float xr = 0.f, xi = 0.f;
#pragma unroll
        for (int c = 0; c < SSM_CH; ++c) { xr += bbr[c] * u[c]; xi += bbi[c] * u[c]; }
        float nr = ar * hr - ai * hi + xr, ni = ar * hi + ai * hr + xi;
        hr = nr; hi = ni;
        float v[SSM_CH];
#pragma unroll
        for (int c = 0; c < SSM_CH; ++c) v[c] = cr[c] * hr - ci[c] * hi;
        float w8[8], w4[4], w2[2], w1;
        { bool up_ = (p & 32) != 0;
#pragma unroll
          for (int i = 0; i < 8; ++i) { float send = up_ ? v[i] : v[8 + i]; float keep = up_ ? v[8 + i] : v[i]; w8[i] = keep + __shfl_xor(send, 32); } }
        { bool up_ = (p & 16) != 0;
#pragma unroll
          for (int i = 0; i < 4; ++i) { float send = up_ ? w8[i] : w8[4 + i]; float keep = up_ ? w8[4 + i] : w8[i]; w4[i] = keep + __shfl_xor(send, 16); } }
        { bool up_ = (p & 8) != 0;
#pragma unroll
          for (int i = 0; i < 2; ++i) { float send = up_ ? w4[i] : w4[2 + i]; float keep = up_ ? w4[2 + i] : w4[i]; w2[i] = keep + __shfl_xor(send, 8); } }
        { bool up_ = (p & 4) != 0; float send = up_ ? w2[0] : w2[1]; float keep = up_ ? w2[1] : w2[0]; w1 = keep + __shfl_xor(send, 4); }
        w1 += __shfl_xor(w1, 2); w1 += __shfl_xor(w1, 1);
        if ((p & 3) == 0) {
            float uc = bf2f(up[ch]);
            float y = w1 + dsk * uc;
            y2[(size_t)(b * SEQ + t) * SSM_W + g * SSM_CH + ch] = f2bf(gelu_tanh(y));
        }
    }
}

extern "C" void kernel_launch(void* const* d_in, const int* in_sizes, int n_in, void* d_out, int out_size, void* d_ws, size_t ws_size, hipStream_t stream) {
    if (ws_size < WS_END) return;
    const float* x = (const float*)d_in[0]; const float* mem = (const float*)d_in[1]; const int* pos = (const int*)d_in[2];
    const float* norm_g = (const float*)d_in[3]; const float* w_in = (const float*)d_in[4]; const float* q_norm_g = (const float*)d_in[5];
    const float* k_norm_g = (const float*)d_in[6]; const float* sinks = (const float*)d_in[7]; const float* lam_re = (const float*)d_in[8];
    const float* lam_im = (const float*)d_in[9]; const float* log_dt = (const float*)d_in[10]; const float* b_re = (const float*)d_in[11];
    const float* b_im = (const float*)d_in[12]; const float* c_re = (const float*)d_in[13]; const float* c_im = (const float*)d_in[14];
    const float* d_skip = (const float*)d_in[15]; const float* w_glu = (const float*)d_in[16]; const float* b_glu = (const float*)d_in[17];
    const float* mem_norm_g = (const float*)d_in[18]; const float* w_mem_kv = (const float*)d_in[19]; const float* xq_norm_g = (const float*)d_in[20];
    const float* xk_norm_g = (const float*)d_in[21]; const float* w_out = (const float*)d_in[22];
    char* ws = (char*)d_ws; float* out = (float*)d_out;
    bf16_t* Z = (bf16_t*)(ws + WS_Z); bf16_t* MIX = (bf16_t*)(ws + WS_MIX); bf16_t* H = (bf16_t*)(ws + WS_H); bf16_t* Y2 = (bf16_t*)(ws + WS_Y2);
    bf16_t* MK = (bf16_t*)(ws + WS_MK); bf16_t* MV = (bf16_t*)(ws + WS_MV); float* ROPE = (float*)(ws + WS_ROPE); float* SSMP = (float*)(ws + WS_SSMP);
    bf16_t* HM = (bf16_t*)(ws + WS_HM); float* MKV = (float*)(ws + WS_MKV);

    k_rope_table<<<MTOK * 32 / 256, 256, 0, stream>>>(pos, ROPE);
    k_ssm_params<<<DEPTH * SSM_G * SSM_P / 256, 256, 0, stream>>>(lam_re, lam_im, log_dt, b_re, b_im, SSMP);
    for (int l = 0; l < DEPTH; ++l) {
        k_rmsnorm_rows<<<BATCH * N_MEM / 4, 256, 0, stream>>>(mem, mem_norm_g + l * D_MODEL, HM, BATCH * N_MEM);
        k_sgemm<EpiF32><<<dim3(1024 / 64, BATCH * N_MEM / 64), 256, 0, stream>>>(HM, D_MODEL, w_mem_kv + (size_t)l * D_MODEL * 1024, 1024, D_MODEL, EpiF32{MKV, 1024});
        k_memkv_fin<<<BATCH * N_MEM / 4, 256, 0, stream>>>(MKV, xk_norm_g + l * XHD, MK + (size_t)l * BATCH * N_MEM * 512, MV + (size_t)l * BATCH * N_MEM * 512);
    }
    for (int l = 0; l < DEPTH; ++l) {
        const float* xin = (l == 0) ? x : out;
        k_rmsnorm_rows<<<MTOK / 4, 256, 0, stream>>>(xin, norm_g + l * D_MODEL, H, MTOK);
        k_sgemm<EpiZ><<<dim3(IN_W / 64, MTOK / 64), 256, 0, stream>>>(H, D_MODEL, w_in + (size_t)l * D_MODEL * IN_W, IN_W, D_MODEL, EpiZ{Z});
        k_qk_prep<<<MTOK / 4, 256, 0, stream>>>(Z, q_norm_g + l * HD, k_norm_g + l * HD, xq_norm_g + l * XHD, ROPE);
        k_attn_a<<<MTOK * NQH / 256, 256, 0, stream>>>(Z, sinks + l * NQH, MIX);
        k_attn_c<<<BATCH * XH * (SEQ / 16), 256, 0, stream>>>(Z, MK + (size_t)l * BATCH * N_MEM * 512, MV + (size_t)l * BATCH * N_MEM * 512, MIX);
        k_ssm_naive<<<BATCH * SSM_G, 64, 0, stream>>>(Z, SSMP + (size_t)l * SSMP_LAYER, c_re + (size_t)l * SSM_G * SSM_CH * SSM_P, c_im + (size_t)l * SSM_G * SSM_CH * SSM_P, d_skip + l * SSM_W, Y2);
        k_sgemm<EpiGlu><<<dim3(SSM_W / 64, MTOK / 64), 256, 0, stream>>>(Y2, SSM_W, w_glu + (size_t)l * SSM_W * SSM_W, SSM_W, SSM_W, EpiGlu{Y2, Z, b_glu + l * SSM_W, MIX});
        k_sgemm<EpiOut><<<dim3(D_MODEL / 64, MTOK / 64), 256, 0, stream>>>(MIX, MIX_W, w_out + (size_t)l * MIX_W * D_MODEL, D_MODEL, MIX_W, EpiOut{xin, out});
    }
}
```

```cpp
#include <hip/hip_runtime.h>
#define USE_MFMA_A 1
#define USE_MFMA_C 1
#define A_PREPPED 0
#include <stdint.h>
#include <math.h>

constexpr int D_MODEL = 1024, BATCH = 8, SEQ = 4096, DEPTH = 4, MTOK = BATCH * SEQ;
constexpr int HD = 64, NQH = 8, NKVH = 2, WINDOW = 128;
constexpr int SSM_CH = 16, SSM_G = 32, SSM_P = 64, SSM_W = 512, N_MEM = 256, XH = 4, XHD = 128;
constexpr int MIX_W = 1536, IN_W = 3328;
constexpr int ZQ = 0, ZK = 512, ZV = 640, ZG = 768, ZU = 1280, ZSG = 1792, ZXQ = 2304, ZXG = 2816;
constexpr float EPS = 1e-6f;

typedef unsigned short bf16_t;
__device__ __forceinline__ bf16_t f2bf(float f) { _Float16 h = (_Float16)f; return __builtin_bit_cast(unsigned short, h); }
__device__ __forceinline__ float bf2f(bf16_t h) { return (float)__builtin_bit_cast(_Float16, h); }
__device__ __forceinline__ float sigmoidf_(float x) { return 1.f / (1.f + __expf(-x)); }
__device__ __forceinline__ float siluf_(float x) { return x * sigmoidf_(x); }
__device__ __forceinline__ float gelu_tanh(float x) { const float c = 0.7978845608028654f; float u = c * (x + 0.044715f * x * x * x); return 0.5f * x * (1.f + tanhf(u)); }
__device__ __forceinline__ float wave_sum(float v) {
#pragma unroll
    for (int o = 1; o < 64; o <<= 1) v += __shfl_xor(v, o);
    return v;
}

constexpr size_t MiB = 1u << 20;
constexpr size_t WS_Z = 0;
constexpr size_t WS_MIX = 208 * MiB;
constexpr size_t WS_XB = 304 * MiB;
constexpr size_t WS_Y2 = 368 * MiB;
constexpr size_t WS_WIN = 400 * MiB;
constexpr size_t WS_WOUT = 426 * MiB;
constexpr size_t WS_WGLU = 438 * MiB;
constexpr size_t WS_WMEM = 440 * MiB;
constexpr size_t WS_MEMB = 448 * MiB;
constexpr size_t WS_MK = 452 * MiB;
constexpr size_t WS_MV = 460 * MiB;
constexpr size_t WS_ROPE = 468 * MiB;
constexpr size_t WS_SSMP = 476 * MiB;
constexpr size_t WS_SUMSQ = 508 * MiB;
constexpr size_t WS_MISC = 510 * MiB;
constexpr size_t WS_END = 511 * MiB;
constexpr int SSMP_LAYER = SSM_G * SSM_P * 2 + SSM_G * SSM_P * SSM_CH * 2;

__global__ void k_ssm_params(const float* lam_re, const float* lam_im, const float* log_dt, const float* b_re, const float* b_im, float* out) {
    int idx = blockIdx.x * blockDim.x + threadIdx.x;
    if (idx >= DEPTH * SSM_G * SSM_P) return;
    int l = idx / (SSM_G * SSM_P), gp = idx % (SSM_G * SSM_P), g = gp / SSM_P;
    double lr = lam_re[idx], li = lam_im[idx], dt = exp((double)log_dt[l * SSM_G + g]);
    double mag = exp(lr * dt), ar = mag * cos(li * dt), ai = mag * sin(li * dt);
    double den = lr * lr + li * li;
    double fr = ((ar - 1.0) * lr + ai * li) / den, fi = (ai * lr - (ar - 1.0) * li) / den;
    float* o = out + (size_t)l * SSMP_LAYER;
    o[gp * 2] = (float)ar; o[gp * 2 + 1] = (float)ai;
    float* bb = o + SSM_G * SSM_P * 2 + (size_t)gp * SSM_CH * 2;
    for (int c = 0; c < SSM_CH; ++c) {
        double br = b_re[(size_t)idx * SSM_CH + c], bi = b_im[(size_t)idx * SSM_CH + c];
        bb[c * 2] = (float)(fr * br - fi * bi); bb[c * 2 + 1] = (float)(fr * bi + fi * br);
    }
}

namespace pg8 {
#define PG8_LAS __attribute__((address_space(3)))
typedef _Float16 f16x8 __attribute__((ext_vector_type(8)));
typedef _Float16 f16x2 __attribute__((ext_vector_type(2)));
typedef float f32x4 __attribute__((ext_vector_type(4)));
typedef unsigned u32x4 __attribute__((ext_vector_type(4)));
typedef unsigned u32x2 __attribute__((ext_vector_type(2)));
constexpr int BM = 256, BK = 64, HALF = 128, HTB = HALF * BK * 2, STAGE_BYTES = 8 * HTB, NXCD = 8, WGM = 8;
__host__ __device__ __forceinline__ int lds_byte(int r, int c) { const int st = (r >> 4) * 2 + (c >> 5), rr = r & 15, cc = c & 31, ob = rr * 64 + cc * 2; return st * 1024 + (ob ^ (((ob >> 9) & 1) << 5)); }
__host__ __device__ __forceinline__ void stage_rc(int b, int& R, int& C) { const int st = b / 1024, sb = b % 1024, swz = sb ^ (((sb >> 9) & 1) << 5); R = (st >> 1) * 16 + swz / 64; C = (st & 1) * 32 + (swz % 64) / 2; }
__host__ __device__ __forceinline__ int perm32(int rho) { const int n = rho >> 4, i = rho & 15; return 8 * (i >> 2) + 4 * n + (i & 3); }
struct Unit { int pm, pn; };
struct Gemm { const bf16_t* A; const bf16_t* Bt; int M, N, K; };
struct StaticOrder {
    int nM, nN, nwg, G, c;
    __host__ __device__ void init(int M, int N, int G_, int c_) { nM = M / BM; nN = N / BM; nwg = nM * nN; G = G_; c = c_; }
    __host__ __device__ bool next(int i, Unit& u) const {
        const long L = (long)i * G + c; if (L >= nwg) return false;
        int wgid = (int)L; { const int q = nwg / NXCD, r = nwg % NXCD, xcd = wgid % NXCD, off = wgid / NXCD; wgid = (xcd < r ? xcd * (q + 1) : r * (q + 1) + (xcd - r) * q) + off; }
        const int nig = WGM * nN, gid = wgid / nig, fm = gid * WGM, gsz = (nM - fm) < WGM ? (nM - fm) : WGM;
        u.pm = fm + ((wgid % nig) % gsz); u.pn = (wgid % nig) / gsz; return true;
    }
    __device__ __forceinline__ void a_ready(const Unit&) const {}
    __device__ __forceinline__ void done(const Unit&) const {}
};
__device__ __forceinline__ unsigned pk_f16(float lo, float hi) { f16x2 v = {(_Float16)lo, (_Float16)hi}; return __builtin_bit_cast(unsigned, v); }
__device__ __forceinline__ float h_lo(unsigned w) { return (float)__builtin_bit_cast(_Float16, (unsigned short)(w & 0xffffu)); }
__device__ __forceinline__ float h_hi(unsigned w) { return (float)__builtin_bit_cast(_Float16, (unsigned short)(w >> 16)); }

struct EpiZ {
    static constexpr bool PERM = true, AFTER_DRAIN = false;
    bf16_t* Z; const float* sumsq;
    __device__ __forceinline__ void operator()(const f32x4 (&acc)[2][2][4][2], const Unit& u, int wr, int wc, int fr, int fq) const {
        const int row0 = u.pm * BM + wr * 64 + fr, col0 = u.pn * BM + wc * 32 + 8 * fq;
#pragma unroll
        for (int ai = 0; ai < 2; ++ai)
#pragma unroll
            for (int m = 0; m < 4; ++m) { const int r = row0 + ai * HALF + m * 16;
                const f32x4* sp = (const f32x4*)(sumsq + (size_t)r * 16); const f32x4 s0 = sp[0], s1 = sp[1], s2 = sp[2], s3 = sp[3];
                const float ss = ((s0[0] + s0[1]) + (s0[2] + s0[3])) + ((s1[0] + s1[1]) + (s1[2] + s1[3])) + ((s2[0] + s2[1]) + (s2[2] + s2[3])) + ((s3[0] + s3[1]) + (s3[2] + s3[3]));
                const float rs = rsqrtf(ss * (1.f / D_MODEL) + EPS);
                bf16_t* rowp = Z + (size_t)r * IN_W + col0;
#pragma unroll
                for (int bj = 0; bj < 2; ++bj) { const f32x4 v0 = acc[ai][bj][m][0] * rs, v1 = acc[ai][bj][m][1] * rs;
                    u32x4 w; w.x = pk_f16(v0[0], v0[1]); w.y = pk_f16(v0[2], v0[3]); w.z = pk_f16(v1[0], v1[1]); w.w = pk_f16(v1[2], v1[3]);
                    *(u32x4*)(rowp + bj * HALF) = w; } }
    }
};
struct EpiGlu {
    static constexpr bool PERM = true, AFTER_DRAIN = false;
    const bf16_t* Y2; const bf16_t* Z; const float* bg; bf16_t* MIX;
    __device__ __forceinline__ void operator()(const f32x4 (&acc)[2][2][4][2], const Unit& u, int wr, int wc, int fr, int fq) const {
        const int row0 = u.pm * BM + wr * 64 + fr, col0 = u.pn * BM + wc * 32 + 8 * fq;
#pragma unroll
        for (int bj = 0; bj < 2; ++bj) { const int c = col0 + bj * HALF;
            const f32x4 b0 = *(const f32x4*)(bg + c), b1 = *(const f32x4*)(bg + c + 4);
#pragma unroll
            for (int ai = 0; ai < 2; ++ai)
#pragma unroll
                for (int m = 0; m < 4; ++m) { const int r = row0 + ai * HALF + m * 16;
                    const u32x4 yv = *(const u32x4*)(Y2 + (size_t)r * SSM_W + c), sv = *(const u32x4*)(Z + (size_t)r * IN_W + ZSG + c);
                    const f32x4 a0 = acc[ai][bj][m][0] + b0, a1 = acc[ai][bj][m][1] + b1;
                    float o[8];
#pragma unroll
                    for (int j = 0; j < 4; ++j) { const unsigned yw = yv[j], sw = sv[j];
                        const float g0 = (j < 2) ? a0[2 * j] : a1[2 * j - 4], g1 = (j < 2) ? a0[2 * j + 1] : a1[2 * j - 3];
                        o[2 * j] = h_lo(yw) * sigmoidf_(g0) * siluf_(h_lo(sw)); o[2 * j + 1] = h_hi(yw) * sigmoidf_(g1) * siluf_(h_hi(sw)); }
                    u32x4 w; w.x = pk_f16(o[0], o[1]); w.y = pk_f16(o[2], o[3]); w.z = pk_f16(o[4], o[5]); w.w = pk_f16(o[6], o[7]);
                    *(u32x4*)(MIX + (size_t)r * MIX_W + 512 + c) = w; } }
    }
};
struct EpiOut {
    static constexpr bool PERM = false, AFTER_DRAIN = false;
    const float* xin; float* xout; bf16_t* XB; float* sumsq;
    __device__ __forceinline__ void operator()(const f32x4 (&acc)[2][2][4][2], const Unit& u, int wr, int wc, int fr, int fq) const {
        const int row0 = u.pm * BM + wr * 64 + fr, col0 = u.pn * BM + wc * 32 + 4 * fq;
#pragma unroll
        for (int ai = 0; ai < 2; ++ai)
#pragma unroll
            for (int m = 0; m < 4; ++m) { const int r = row0 + ai * HALF + m * 16; const size_t off = (size_t)r * D_MODEL + col0; float ss = 0.f;
#pragma unroll
                for (int bj = 0; bj < 2; ++bj)
#pragma unroll
                    for (int n = 0; n < 2; ++n) { const f32x4 xv = *(const f32x4*)(xin + off + bj * HALF + n * 16); const f32x4 o = xv + acc[ai][bj][m][n];
                        *(f32x4*)(xout + off + bj * HALF + n * 16) = o;
                        u32x2 w; w.x = pk_f16(o[0], o[1]); w.y = pk_f16(o[2], o[3]); *(u32x2*)(XB + off + bj * HALF + n * 16) = w;
                        ss += (o[0] * o[0] + o[1] * o[1]) + (o[2] * o[2] + o[3] * o[3]); }
                ss += __shfl_xor(ss, 16); ss += __shfl_xor(ss, 32);
                if (fq == 0) sumsq[(size_t)r * 16 + u.pn * 4 + wc] = ss; }
    }
};
struct EpiMemF32 {
    static constexpr bool PERM = false, AFTER_DRAIN = false;
    float* C; int ldc; const float* rstd;
    __device__ __forceinline__ void operator()(const f32x4 (&acc)[2][2][4][2], const Unit& u, int wr, int wc, int fr, int fq) const {
        const int row0 = u.pm * BM + wr * 64 + fr, col0 = u.pn * BM + wc * 32 + 4 * fq;
#pragma unroll
        for (int ai = 0; ai < 2; ++ai)
#pragma unroll
            for (int m = 0; m < 4; ++m) { const int r = row0 + ai * HALF + m * 16; const float rs = rstd[r]; float* rowp = C + (size_t)r * ldc + col0;
#pragma unroll
                for (int bj = 0; bj < 2; ++bj)
#pragma unroll
                    for (int n = 0; n < 2; ++n) *(f32x4*)(rowp + bj * HALF + n * 16) = acc[ai][bj][m][n] * rs; }
    }
};

template <class Epi, class Sched, bool ALIGN_EPI>
__device__ __forceinline__ void gemm_phase(PG8_LAS unsigned char* lds, const Gemm g, const Sched& S, const Epi& E) {
    const int tid = threadIdx.x, wid = __builtin_amdgcn_readfirstlane(tid >> 6), lane = tid & 63, wr = wid >> 2, wc = wid & 3, fr = lane & 15, fq = lane >> 4;
    const int K = g.K, nt = K / BK;
    unsigned voffA[2], voffB[2];
#pragma unroll
    for (int i = 0; i < 2; ++i) { int R, C; stage_rc(tid * 16 + i * 8192, R, C); const int Rb = Epi::PERM ? ((R & ~31) + perm32(R & 31)) : R;
        voffA[i] = (unsigned)(R * K + C) * 2u; voffB[i] = (unsigned)(Rb * K + C) * 2u; }
    const size_t kstep = (size_t)(BK * 2);
    const size_t hstep = (size_t)HALF * K * 2;
    const size_t tstep = 2 * hstep;
    const unsigned ldsw = (unsigned)wid * 1024u;
    const int aoff = lds_byte(wr * 64 + fr, fq * 8), boff = lds_byte(wc * 32 + fr, fq * 8);
#define PG8_SA(b, h) (((b) * 2 + (h)) * HTB)
#define PG8_SB(b, h) ((4 + (b) * 2 + (h)) * HTB)
#define PG8_STAGE(bufoff, gbase, voff) do { _Pragma("unroll") for (int _i = 0; _i < 2; ++_i) \
        __builtin_amdgcn_global_load_lds((const unsigned*)((const char*)(gbase) + (voff)[_i]), (PG8_LAS unsigned*)(lds + (bufoff) + ldsw + _i * 8192), 16, 0, 0); } while (0)
#define PG8_LDA(dst, b, h) do { _Pragma("unroll") for (int m = 0; m < 4; ++m) _Pragma("unroll") for (int k = 0; k < 2; ++k) dst[m][k] = *(const PG8_LAS f16x8*)(lds + PG8_SA(b, h) + aoff + m * 2048 + k * 1024); } while (0)
#define PG8_LDB(dst, b, h) do { _Pragma("unroll") for (int n = 0; n < 2; ++n) _Pragma("unroll") for (int k = 0; k < 2; ++k) dst[n][k] = *(const PG8_LAS f16x8*)(lds + PG8_SB(b, h) + boff + n * 2048 + k * 1024); } while (0)
#define PG8_MMA(ai, bj, At, Bt) do { __builtin_amdgcn_s_setprio(1); _Pragma("unroll") for (int m = 0; m < 4; ++m) _Pragma("unroll") for (int n = 0; n < 2; ++n) _Pragma("unroll") for (int k = 0; k < 2; ++k) \
        acc[ai][bj][m][n] = __builtin_amdgcn_mfma_f32_16x16x32_f16(Bt[n][k], At[m][k], acc[ai][bj][m][n], 0, 0, 0); __builtin_amdgcn_s_setprio(0); } while (0)
#define PG8_WAIT_V(n) asm volatile("s_waitcnt vmcnt(" #n ")" ::: "memory")
#define PG8_WAIT_L(n) asm volatile("s_waitcnt lgkmcnt(" #n ")" ::: "memory")
#define PG8_BAR __builtin_amdgcn_s_barrier()
#define PG8_SCHED __builtin_amdgcn_sched_barrier(0)
    Unit cur, nxt; int ui = 0;
    if (!S.next(0, cur)) return;
    f32x4 acc[2][2][4][2];
#pragma unroll
    for (int a = 0; a < 2; ++a)
#pragma unroll
        for (int b = 0; b < 2; ++b)
#pragma unroll
            for (int m = 0; m < 4; ++m)
#pragma unroll
                for (int n = 0; n < 2; ++n) acc[a][b][m][n] = (f32x4){0.f, 0.f, 0.f, 0.f};
    f16x8 At[4][2], B0[2][2], B1[2][2];
    const char* cA = (const char*)g.A + (size_t)cur.pm * tstep; const char* cB = (const char*)g.Bt + (size_t)cur.pn * tstep;
    S.a_ready(cur);
    PG8_STAGE(PG8_SB(0, 0), cB, voffB); PG8_STAGE(PG8_SB(0, 1), cB + hstep, voffB); PG8_STAGE(PG8_SA(0, 0), cA, voffA); PG8_STAGE(PG8_SA(0, 1), cA + hstep, voffA);
    if (wr == 1) PG8_BAR;
    PG8_WAIT_V(2); PG8_BAR;
    PG8_STAGE(PG8_SB(1, 0), cB + kstep, voffB); PG8_STAGE(PG8_SA(1, 0), cA + kstep, voffA); PG8_STAGE(PG8_SB(1, 1), cB + hstep + kstep, voffB);
    PG8_WAIT_V(6); PG8_BAR;
    for (;;) {
        const bool has_next = S.next(ui + 1, nxt);
        const char* nA = has_next ? (const char*)g.A + (size_t)nxt.pm * tstep : cA; const char* nB = has_next ? (const char*)g.Bt + (size_t)nxt.pn * tstep : cB;
        for (int t = 0; t < nt; t += 2) {
            const bool last = (t == nt - 2);
            const char* a1 = cA + (size_t)(t + 1) * kstep;
            const char* a2 = last ? nA : cA + (size_t)(t + 2) * kstep; const char* b2 = last ? nB : cB + (size_t)(t + 2) * kstep;
            const char* a3 = a2 + kstep; const char* b3 = b2 + kstep;
            if (last && has_next) S.a_ready(nxt);
            PG8_LDB(B0, 0, 0); PG8_LDB(B1, 0, 1); PG8_SCHED; PG8_LDA(At, 0, 0); PG8_STAGE(PG8_SA(1, 1), a1 + hstep, voffA);
            PG8_WAIT_V(8); PG8_WAIT_L(0); PG8_BAR; PG8_MMA(0, 0, At, B0); PG8_MMA(0, 1, At, B1); PG8_BAR; PG8_SCHED;
            PG8_LDA(At, 0, 1); PG8_STAGE(PG8_SB(0, 0), b2, voffB); PG8_STAGE(PG8_SB(0, 1), b2 + hstep, voffB); PG8_STAGE(PG8_SA(0, 0), a2, voffA);
            PG8_WAIT_V(8); PG8_WAIT_L(0); PG8_BAR; PG8_MMA(1, 0, At, B0); PG8_MMA(1, 1, At, B1); PG8_BAR; PG8_SCHED;
            PG8_LDB(B0, 1, 0); PG8_LDB(B1, 1, 1); PG8_SCHED; PG8_LDA(At, 1, 0); PG8_STAGE(PG8_SA(0, 1), a2 + hstep, voffA);
            PG8_WAIT_V(8); PG8_WAIT_L(0); PG8_BAR; PG8_MMA(0, 0, At, B0); PG8_MMA(0, 1, At, B1); PG8_BAR; PG8_SCHED;
            PG8_LDA(At, 1, 1); PG8_STAGE(PG8_SB(1, 0), b3, voffB); PG8_STAGE(PG8_SB(1, 1), b3 + hstep, voffB); PG8_STAGE(PG8_SA(1, 0), a3, voffA);
            PG8_WAIT_V(8); PG8_WAIT_L(0); PG8_BAR; PG8_MMA(1, 0, At, B0); PG8_MMA(1, 1, At, B1); PG8_BAR; PG8_SCHED;
        }
        if constexpr (ALIGN_EPI) { if (wr == 0) PG8_BAR; }
        E(acc, cur, wr, wc, fr, fq); S.done(cur);
        if (!has_next) break;
#pragma unroll
        for (int a = 0; a < 2; ++a)
#pragma unroll
            for (int b = 0; b < 2; ++b)
#pragma unroll
                for (int m = 0; m < 4; ++m)
#pragma unroll
                    for (int n = 0; n < 2; ++n) acc[a][b][m][n] = (f32x4){0.f, 0.f, 0.f, 0.f};
        cur = nxt; cA = nA; cB = nB; ++ui;
        if constexpr (ALIGN_EPI) { if (wr == 1) PG8_BAR; }
    }
    PG8_WAIT_V(0);
    if constexpr (!ALIGN_EPI) { if (wr == 0) PG8_BAR; }
    PG8_BAR;
#undef PG8_SA
#undef PG8_SB
#undef PG8_STAGE
#undef PG8_LDA
#undef PG8_LDB
#undef PG8_MMA
#undef PG8_WAIT_V
#undef PG8_WAIT_L
#undef PG8_BAR
#undef PG8_SCHED
}
}

constexpr int NWAVES = 8, NTHREADS = 512;
constexpr int LDS_BYTES = 147456;
#define LAS __attribute__((address_space(3)))
typedef unsigned v4u __attribute__((ext_vector_type(4)));
typedef float f32x4 __attribute__((ext_vector_type(4)));

struct Params {
    const float* x; const float* mem; const int* pos; const float* norm_g; const float* w_in; const float* q_norm_g; const float* k_norm_g; const float* sinks;
    const float* lam_re; const float* lam_im; const float* log_dt; const float* b_re; const float* b_im; const float* c_re; const float* c_im; const float* d_skip;
    const float* w_glu; const float* b_glu; const float* mem_norm_g; const float* w_mem_kv; const float* xq_norm_g; const float* xk_norm_g; const float* w_out;
    float* out; unsigned char* ws;
};

__device__ __forceinline__ void p0_transpose_item(const float* W, int K, int N, const float* scale, bf16_t* WT, LAS float* scr, int item, int lane) {
    const int nblk = N / 32, kb = item / nblk, nb = item % nblk, k0 = 64 * kb, n0 = 32 * nb;
#pragma unroll 8
    for (int i = 0; i < 32; ++i) { const int kk = 2 * i + (lane >> 5); const float sc = scale ? scale[k0 + kk] : 1.f; scr[kk * 33 + (lane & 31)] = W[(size_t)(k0 + kk) * N + n0 + (lane & 31)] * sc; }
    asm volatile("s_waitcnt lgkmcnt(0)" ::: "memory");
    const int c = lane & 7;
#pragma unroll
    for (int j = 0; j < 4; ++j) { const int n = (lane >> 3) + 8 * j; const LAS float* s = scr + (8 * c) * 33 + n;
        v4u o; o.x = pg8::pk_f16(s[0 * 33], s[1 * 33]); o.y = pg8::pk_f16(s[2 * 33], s[3 * 33]); o.z = pg8::pk_f16(s[4 * 33], s[5 * 33]); o.w = pg8::pk_f16(s[6 * 33], s[7 * 33]);
        *(v4u*)(WT + (size_t)(n0 + n) * K + k0 + 8 * c) = o; }
    asm volatile("s_waitcnt lgkmcnt(0)" ::: "memory");
}
__device__ __forceinline__ void phase_prep(const Params& P, LAS unsigned char* lds, int vcu, int G) {
    const int tid = threadIdx.x, lane = tid & 63, wave = __builtin_amdgcn_readfirstlane(tid >> 6);
    LAS float* scr = (LAS float*)(lds + wave * 16384);
    const int gw = vcu * NWAVES + wave, NGW = G * NWAVES;
    unsigned char* ws = P.ws;
    constexpr int I_IN = (D_MODEL / 64) * (IN_W / 32), I_OUT = (MIX_W / 64) * (D_MODEL / 32), I_GLU = (SSM_W / 64) * (SSM_W / 32), I_MEM = (D_MODEL / 64) * (1024 / 32);
    constexpr int I_LAYER = I_IN + I_OUT + I_GLU + I_MEM;
    for (int it = gw; it < DEPTH * I_LAYER; it += NGW) {
        const int l = it / I_LAYER; int r = it % I_LAYER;
        if (r < I_IN) { p0_transpose_item(P.w_in + (size_t)l * D_MODEL * IN_W, D_MODEL, IN_W, P.norm_g + l * D_MODEL, (bf16_t*)(ws + WS_WIN) + (size_t)l * IN_W * D_MODEL, scr, r, lane); continue; } r -= I_IN;
        if (r < I_OUT) { p0_transpose_item(P.w_out + (size_t)l * MIX_W * D_MODEL, MIX_W, D_MODEL, nullptr, (bf16_t*)(ws + WS_WOUT) + (size_t)l * D_MODEL * MIX_W, scr, r, lane); continue; } r -= I_OUT;
        if (r < I_GLU) { p0_transpose_item(P.w_glu + (size_t)l * SSM_W * SSM_W, SSM_W, SSM_W, nullptr, (bf16_t*)(ws + WS_WGLU) + (size_t)l * SSM_W * SSM_W, scr, r, lane); continue; } r -= I_GLU;
        p0_transpose_item(P.w_mem_kv + (size_t)l * D_MODEL * 1024, D_MODEL, 1024, P.mem_norm_g + l * D_MODEL, (bf16_t*)(ws + WS_WMEM) + (size_t)l * 1024 * D_MODEL, scr, r, lane);
    }
    for (int m = gw; m < MTOK + BATCH * N_MEM; m += NGW) {
        const bool is_x = m < MTOK; const int row = is_x ? m : m - MTOK;
        const f32x4* xr = (const f32x4*)((is_x ? P.x : P.mem) + (size_t)row * D_MODEL) + lane;
        bf16_t* ob = (bf16_t*)(ws + (is_x ? WS_XB : WS_MEMB)) + (size_t)row * D_MODEL;
        f32x4 v[4]; float s = 0.f;
#pragma unroll
        for (int j = 0; j < 4; ++j) { v[j] = xr[64 * j]; s += (v[j][0] * v[j][0] + v[j][1] * v[j][1]) + (v[j][2] * v[j][2] + v[j][3] * v[j][3]); }
        s = wave_sum(s);
#pragma unroll
        for (int j = 0; j < 4; ++j) { pg8::u32x2 w; w.x = pg8::pk_f16(v[j][0], v[j][1]); w.y = pg8::pk_f16(v[j][2], v[j][3]); *((pg8::u32x2*)ob + lane + 64 * j) = w; }
        if (is_x) { if (lane < 16) ((float*)(ws + WS_SUMSQ))[(size_t)row * 16 + lane] = (lane == 0) ? s : 0.f; }
        else if (lane == 0) ((float*)(ws + WS_MISC))[row] = rsqrtf(s * (1.f / D_MODEL) + EPS);
    }
    { float* tab = (float*)(ws + WS_ROPE);
      for (int idx = vcu * NTHREADS + tid; idx < MTOK * 32; idx += G * NTHREADS) { const int tok = idx >> 5, i = idx & 31;
          const float inv = powf(10000.0f, -(float)i / 32.0f); const float ang = (float)P.pos[tok] * inv; const double a = (double)ang;
          tab[tok * 64 + i] = (float)cos(a); tab[tok * 64 + 32 + i] = (float)sin(a); } }
}


typedef _Float16 f16x8 __attribute__((ext_vector_type(8)));
typedef float f32x16 __attribute__((ext_vector_type(16)));
__device__ __forceinline__ int crow(int r, int hi) { return (r & 3) + 8 * (r >> 2) + 4 * hi; }
__device__ __forceinline__ float hf(_Float16 h) { return (float)h; }
constexpr float LOG2E = 1.4426950408889634f;
__device__ __forceinline__ f16x8 pack8(const f32x16& p, int s) { f16x8 r;
#pragma unroll
    for (int j = 0; j < 8; ++j) r[j] = (_Float16)p[8 * s + j];
    return r; }

constexpr int ATT_KF = 0, ATT_VF = 32768;
__device__ __forceinline__ void attn_a_item(const Params& P, int layer, LAS unsigned char* lds, int item) {
    const int tid = threadIdx.x, lane = tid & 63, wave = __builtin_amdgcn_readfirstlane(tid >> 6);
    const int kvh = item & 1, blk = (item >> 1) & 31, b = item >> 6;
    const bf16_t* Z = (const bf16_t*)(P.ws + WS_Z); bf16_t* MIX = (bf16_t*)(P.ws + WS_MIX); const float* rope = (const float*)(P.ws + WS_ROPE);
    const float* kg = P.k_norm_g + layer * HD; const float* qg = P.q_norm_g + layer * HD;
    {
        const int key = tid >> 1, hh = tid & 1, tpos = blk * 128 - 128 + key; const bool valid = tpos >= 0;
        const int tok = b * SEQ + (valid ? tpos : 0);
        const bf16_t* zr = Z + (size_t)tok * IN_W;
        f16x8 x1[2], x2[2]; float ss = 0.f;
#pragma unroll
        for (int i = 0; i < 2; ++i) { const int c = 2 * hh + i; x1[i] = *(const f16x8*)(zr + ZK + kvh * HD + 8 * c); x2[i] = *(const f16x8*)(zr + ZK + kvh * HD + 32 + 8 * c);
#pragma unroll
            for (int j = 0; j < 8; ++j) { const float a = hf(x1[i][j]), c2 = hf(x2[i][j]); ss += a * a + c2 * c2; } }
        ss += __shfl_xor(ss, 1);
        const float rs = rsqrtf(ss * (1.f / HD) + EPS);
        const int kt = key >> 5, kl = key & 31;
#pragma unroll
        for (int i = 0; i < 2; ++i) { const int c = 2 * hh + i; f16x8 o1, o2;
#pragma unroll
            for (int j = 0; j < 8; ++j) { const int d = 8 * c + j; const float cs = rope[(size_t)tok * 64 + d], sn = rope[(size_t)tok * 64 + 32 + d];
                const float a = hf(x1[i][j]) * rs * kg[d], bb = hf(x2[i][j]) * rs * kg[32 + d];
#if A_PREPPED
                o1[j] = valid ? x1[i][j] : (_Float16)0.f; o2[j] = valid ? x2[i][j] : (_Float16)0.f; }
#else
                o1[j] = valid ? (_Float16)(a * cs - bb * sn) : (_Float16)0.f; o2[j] = valid ? (_Float16)(bb * cs + a * sn) : (_Float16)0.f; }
#endif
            { const int cc = c;     *(LAS f16x8*)(lds + ATT_KF + (((kt * 4 + (cc >> 1)) * 64) + kl + 32 * (cc & 1)) * 16) = o1; }
            { const int cc = c + 4; *(LAS f16x8*)(lds + ATT_KF + (((kt * 4 + (cc >> 1)) * 64) + kl + 32 * (cc & 1)) * 16) = o2; } }
        const int sK = kl >> 4, h2 = ((kl & 15) >> 2) & 1, jj = 4 * ((kl & 15) >> 3) + (kl & 3);
        LAS unsigned short* vb = (LAS unsigned short*)(lds + ATT_VF + ((((kt * 2 + hh) * 2 + sK) * 64) + 32 * h2) * 16 + 2 * jj);
#pragma unroll
        for (int i = 0; i < 4; ++i) { const v4u v = *(const v4u*)(zr + ZV + kvh * HD + 32 * hh + 8 * i);
#pragma unroll
            for (int j = 0; j < 8; ++j) { const unsigned wv = v[j >> 1]; vb[(8 * i + j) * 8] = valid ? (unsigned short)((j & 1) ? (wv >> 16) : (wv & 0xffffu)) : (unsigned short)0; } }
    }
    __syncthreads();
    const int ql = lane & 31, hi = lane >> 5;
    for (int ui = 0; ui < 2; ++ui) {
        const int u = wave * 2 + ui, head = u >> 2, w = u & 3, hq = kvh * 4 + head;
        const int tq = b * SEQ + blk * 128 + 32 * w + ql;
        const bf16_t* zq = Z + (size_t)tq * IN_W + ZQ + hq * HD;
        f16x8 xq[4]; float ss = 0.f;
#pragma unroll
        for (int d0 = 0; d0 < 4; ++d0) { xq[d0] = *(const f16x8*)(zq + 16 * d0 + 8 * hi);
#pragma unroll
            for (int j = 0; j < 8; ++j) { const float a = hf(xq[d0][j]); ss += a * a; } }
        ss += __shfl_xor(ss, 32);
        const float rs = rsqrtf(ss * (1.f / HD) + EPS) * (0.125f * LOG2E);
        f16x8 qf[4];
#pragma unroll
        for (int d0 = 0; d0 < 2; ++d0)
#pragma unroll
            for (int j = 0; j < 8; ++j) { const int d = 16 * d0 + 8 * hi + j; const float cs = rope[(size_t)tq * 64 + d], sn = rope[(size_t)tq * 64 + 32 + d];
                const float a = hf(xq[d0][j]) * qg[d], bb = hf(xq[d0 + 2][j]) * qg[32 + d];
#if A_PREPPED
                qf[d0][j] = (_Float16)(hf(xq[d0][j]) * (0.125f * LOG2E)); qf[d0 + 2][j] = (_Float16)(hf(xq[d0 + 2][j]) * (0.125f * LOG2E)); }
#else
                qf[d0][j] = (_Float16)((a * cs - bb * sn) * rs); qf[d0 + 2][j] = (_Float16)((bb * cs + a * sn) * rs); }
#endif
        f32x16 p[5];
#pragma unroll
        for (int t = 0; t < 5; ++t) { const int kt = w + t; f32x16 acc = {};
#pragma unroll
            for (int d0 = 0; d0 < 4; ++d0) { const f16x8 kf = *(const LAS f16x8*)(lds + ATT_KF + ((kt * 4 + d0) * 64 + lane) * 16);
                acc = __builtin_amdgcn_mfma_f32_32x32x16_f16(kf, qf[d0], acc, 0, 0, 0); }
            p[t] = acc; }
        float mx = -INFINITY;
#pragma unroll
        for (int t = 0; t < 5; ++t)
#pragma unroll
            for (int r = 0; r < 16; ++r) { const int jrel = 32 * t + crow(r, hi);
                bool ok = (jrel >= ql + 1) && (jrel <= ql + 128); if (blk == 0) ok = ok && (32 * w + jrel >= 128);
                const float v = ok ? p[t][r] : -INFINITY; p[t][r] = v; mx = fmaxf(mx, v); }
        mx = fmaxf(mx, __shfl_xor(mx, 32));
        const float sink2 = P.sinks[layer * NQH + hq] * LOG2E;
        mx = fmaxf(mx, sink2);
        float l = 0.f;
#pragma unroll
        for (int t = 0; t < 5; ++t)
#pragma unroll
            for (int r = 0; r < 16; ++r) { const float e = __builtin_amdgcn_exp2f(p[t][r] - mx); p[t][r] = e; l += e; }
        l += __shfl_xor(l, 32);
        l += __builtin_amdgcn_exp2f(sink2 - mx);
        const float linv = 1.f / l;
        f32x16 o[2] = {};
#pragma unroll
        for (int t = 0; t < 5; ++t) { const int kt = w + t;
#pragma unroll
            for (int s2 = 0; s2 < 2; ++s2) { const f16x8 pa = pack8(p[t], s2);
#pragma unroll
                for (int db = 0; db < 2; ++db) { const f16x8 vf = *(const LAS f16x8*)(lds + ATT_VF + (((kt * 2 + db) * 2 + s2) * 64 + lane) * 16);
                    o[db] = __builtin_amdgcn_mfma_f32_32x32x16_f16(pa, vf, o[db], 0, 0, 0); } } }
#pragma unroll
        for (int r = 0; r < 16; ++r) { const int qr = crow(r, hi); const float li = __shfl(linv, qr);
            const size_t tok = (size_t)b * SEQ + blk * 128 + 32 * w + qr;
#pragma unroll
            for (int db = 0; db < 2; ++db) { const int col = hq * HD + 32 * db + ql;
                const float g = bf2f(Z[tok * IN_W + ZG + col]);
                MIX[tok * MIX_W + col] = f2bf(o[db][r] * li * siluf_(g)); } }
    }
    __syncthreads();
}
__device__ __forceinline__ void phase_attn_a(const Params& P, int layer, LAS unsigned char* lds, int vcu, int G) {
    for (int it = vcu; it < BATCH * 32 * NKVH; it += G) attn_a_item(P, layer, lds, it);
}

__device__ __forceinline__ void attn_c_item(const Params& P, int layer, LAS unsigned char* lds, int item) {
    const int tid = threadIdx.x, lane = tid & 63, wave = __builtin_amdgcn_readfirstlane(tid >> 6);
    const int sblk = item & 7, h = (item >> 3) & 3, b = item >> 5;
    const bf16_t* Z = (const bf16_t*)(P.ws + WS_Z); bf16_t* MIX = (bf16_t*)(P.ws + WS_MIX);
    const f16x8* KFg = (const f16x8*)(P.ws + WS_MK) + (size_t)((layer * BATCH + b) * XH + h) * (8 * 8 * 64);
    const f16x8* VFg = (const f16x8*)(P.ws + WS_MV) + (size_t)((layer * BATCH + b) * XH + h) * (8 * 4 * 2 * 64);
    const float* xqg = P.xq_norm_g + layer * XHD;
#pragma unroll
    for (int i = 0; i < 16; ++i) { const int f = wave * 16 + i; const f16x8* src = (f < 64 ? KFg + f * 64 : VFg + (f - 64) * 64) + lane;
        __builtin_amdgcn_global_load_lds((const unsigned*)src, (LAS unsigned*)(lds + f * 1024), 16, 0, 0); }
    asm volatile("s_waitcnt vmcnt(0)" ::: "memory");
    __syncthreads();
    const int ql = lane & 31, hi = lane >> 5;
    for (int ui = 0; ui < 2; ++ui) {
        const int qbase = b * SEQ + sblk * 512 + (wave * 2 + ui) * 32;
        const bf16_t* zq = Z + (size_t)(qbase + ql) * IN_W + ZXQ + h * XHD;
        f16x8 qf[8]; float ss = 0.f;
#pragma unroll
        for (int d0 = 0; d0 < 8; ++d0) { qf[d0] = *(const f16x8*)(zq + 16 * d0 + 8 * hi);
#pragma unroll
            for (int j = 0; j < 8; ++j) { const float a = hf(qf[d0][j]); ss += a * a; } }
        ss += __shfl_xor(ss, 32);
        const float rs = rsqrtf(ss * (1.f / XHD) + EPS) * (0.08838834764831845f * LOG2E);
#pragma unroll
        for (int d0 = 0; d0 < 8; ++d0)
#pragma unroll
            for (int j = 0; j < 8; ++j) qf[d0][j] = (_Float16)(hf(qf[d0][j]) * rs * xqg[16 * d0 + 8 * hi + j]);
        f16x8 pa[2][4][2]; float mh[2], lh[2];
#pragma unroll
        for (int hf2 = 0; hf2 < 2; ++hf2) {
            f32x16 p[4];
#pragma unroll
            for (int t = 0; t < 4; ++t) { const int kt = 4 * hf2 + t; f32x16 acc = {};
#pragma unroll
                for (int d0 = 0; d0 < 8; ++d0) acc = __builtin_amdgcn_mfma_f32_32x32x16_f16(*(const LAS f16x8*)(lds + ((kt * 8 + d0) * 64 + lane) * 16), qf[d0], acc, 0, 0, 0);
                p[t] = acc; asm volatile("" ::: "memory"); }
            float mx = -INFINITY;
#pragma unroll
            for (int t = 0; t < 4; ++t)
#pragma unroll
                for (int r = 0; r < 16; ++r) mx = fmaxf(mx, p[t][r]);
            mx = fmaxf(mx, __shfl_xor(mx, 32));
            float l = 0.f;
#pragma unroll
            for (int t = 0; t < 4; ++t) {
#pragma unroll
                for (int r = 0; r < 16; ++r) { const float e = __builtin_amdgcn_exp2f(p[t][r] - mx); p[t][r] = e; l += e; }
                pa[hf2][t][0] = pack8(p[t], 0); pa[hf2][t][1] = pack8(p[t], 1); }
            l += __shfl_xor(l, 32);
            mh[hf2] = mx; lh[hf2] = l;
        }
        const float mm = fmaxf(mh[0], mh[1]); const float e0 = __builtin_amdgcn_exp2f(mh[0] - mm), e1 = __builtin_amdgcn_exp2f(mh[1] - mm);
        const float linv = 1.f / (lh[0] * e0 + lh[1] * e1); const float f0 = e0 * linv, f1 = e1 * linv;
#pragma unroll
        for (int db = 0; db < 4; ++db) { f32x16 o0 = {}, o1 = {};
#pragma unroll
            for (int t = 0; t < 4; ++t) {
#pragma unroll
                for (int s2 = 0; s2 < 2; ++s2) { o0 = __builtin_amdgcn_mfma_f32_32x32x16_f16(pa[0][t][s2], *(const LAS f16x8*)(lds + 65536 + (((t * 4 + db) * 2 + s2) * 64 + lane) * 16), o0, 0, 0, 0);
                    o1 = __builtin_amdgcn_mfma_f32_32x32x16_f16(pa[1][t][s2], *(const LAS f16x8*)(lds + 65536 + ((((4 + t) * 4 + db) * 2 + s2) * 64 + lane) * 16), o1, 0, 0, 0); }
                asm volatile("" ::: "memory"); }
#pragma unroll
            for (int r = 0; r < 16; ++r) { const int qr = crow(r, hi); const float g0 = __shfl(f0, qr), g1 = __shfl(f1, qr);
                const size_t tok = (size_t)qbase + qr; const int col = h * XHD + 32 * db + ql;
                const float g = bf2f(Z[tok * IN_W + ZXG + col]);
                MIX[tok * MIX_W + 1024 + col] = f2bf((o0[r] * g0 + o1[r] * g1) * siluf_(g)); }
            asm volatile("" ::: "memory"); }
    }
    __syncthreads();
}
__device__ __forceinline__ void phase_attn_c(const Params& P, int layer, LAS unsigned char* lds, int vcu, int G) {
    for (int it = vcu; it < BATCH * XH * 8; it += G) attn_c_item(P, layer, lds, it);
}
__device__ __forceinline__ void phase_memfin(const Params& P, int vcu, int G) {
    const int tid = threadIdx.x, lane = tid & 63, wave = __builtin_amdgcn_readfirstlane(tid >> 6);
    const float* mkv = (const float*)(P.ws + WS_Y2);
    for (int it = vcu * NWAVES + wave; it < DEPTH * BATCH * N_MEM; it += G * NWAVES) {
        const int l = it / (BATCH * N_MEM), row = it % (BATCH * N_MEM), b = row / N_MEM, key = row % N_MEM;
        const float* r = mkv + (size_t)row * (DEPTH * 1024) + l * 1024; const float* xkg = P.xk_norm_g + l * XHD;
        const int kt = key >> 5, kl = key & 31, sK = kl >> 4, h2 = ((kl & 15) >> 2) & 1, jj = 4 * ((kl & 15) >> 3) + (kl & 3);
        for (int h = 0; h < XH; ++h) {
            bf16_t* KF = (bf16_t*)(P.ws + WS_MK) + (size_t)((l * BATCH + b) * XH + h) * (8 * 8 * 64 * 8);
            bf16_t* VF = (bf16_t*)(P.ws + WS_MV) + (size_t)((l * BATCH + b) * XH + h) * (8 * 4 * 2 * 64 * 8);
            float v[2]; v[0] = r[h * XHD + lane]; v[1] = r[h * XHD + 64 + lane];
            const float s = wave_sum(v[0] * v[0] + v[1] * v[1]); const float rs = rsqrtf(s * (1.f / XHD) + EPS);
#pragma unroll
            for (int e = 0; e < 2; ++e) { const int d = lane + 64 * e;
                KF[(size_t)((kt * 8 + (d >> 4)) * 64 + kl + 32 * ((d >> 3) & 1)) * 8 + (d & 7)] = f2bf(v[e] * rs * xkg[d]);
                VF[(size_t)(((kt * 4 + (d >> 5)) * 2 + sK) * 64 + (d & 31) + 32 * h2) * 8 + jj] = f2bf(r[512 + h * XHD + d]); }
        }
    }
}


constexpr size_t SSMC_WE = 0, SSMC_TOEP = 64 * 1024, SSMC_WC = SSMC_TOEP + 128 * 1024, SSMC_STRIDE = 256 * 1024;
constexpr size_t WS_A16 = WS_MISC + 128 * 1024;
__device__ __forceinline__ void ssm_consts_item(const Params& P, LAS unsigned char* lds, int item) {
    const int tid = threadIdx.x; const int l = item / SSM_G, g = item % SSM_G;
    LAS float* apw = (LAS float*)lds;
    LAS float* bbar = apw + 17 * 64 * 2;
    LAS float* kj = bbar + 64 * 16 * 2;
    const float* c_re = P.c_re + (size_t)(l * SSM_G + g) * SSM_CH * SSM_P; const float* c_im = P.c_im + (size_t)(l * SSM_G + g) * SSM_CH * SSM_P;
    const double dt = exp((double)P.log_dt[l * SSM_G + g]);
    for (int i = tid; i < 17 * 64; i += NTHREADS) { const int j = i / 64, p = i % 64; const int gp = (l * SSM_G + g) * SSM_P + p;
        const double lr = P.lam_re[gp], li = P.lam_im[gp]; const double mag = exp(lr * dt * j); double sn, cs; sincos(li * dt * j, &sn, &cs);
        apw[i * 2] = (float)(mag * cs); apw[i * 2 + 1] = (float)(mag * sn); }
    for (int i = tid; i < 64 * 16; i += NTHREADS) { const int p = i / 16, c = i % 16; const int gp = (l * SSM_G + g) * SSM_P + p;
        const double lr = P.lam_re[gp], li = P.lam_im[gp]; const double mag = exp(lr * dt), ar = mag * cos(li * dt), ai = mag * sin(li * dt), den = lr * lr + li * li;
        const double fr = ((ar - 1.0) * lr + ai * li) / den, fi = (ai * lr - (ar - 1.0) * li) / den;
        const double br = P.b_re[(size_t)gp * SSM_CH + c], bi = P.b_im[(size_t)gp * SSM_CH + c];
        bbar[i * 2] = (float)(fr * br - fi * bi); bbar[i * 2 + 1] = (float)(fr * bi + fi * br); }
    __syncthreads();
    for (int i = tid; i < 16 * 256; i += NTHREADS) { const int j = i >> 8, co = (i >> 4) & 15, ci = i & 15; float acc = 0.f;
        for (int p = 0; p < 64; ++p) { const float er = apw[(j * 64 + p) * 2], ei = apw[(j * 64 + p) * 2 + 1], br = bbar[(p * 16 + ci) * 2], bi = bbar[(p * 16 + ci) * 2 + 1];
            const float wr = er * br - ei * bi, wi = er * bi + ei * br; acc += c_re[co * SSM_P + p] * wr - c_im[co * SSM_P + p] * wi; }
        if (j == 0 && co == ci) acc += P.d_skip[l * SSM_W + g * SSM_CH + co];
        kj[i] = acc; }
    __syncthreads();
    unsigned char* base = P.ws + WS_SSMP + (size_t)item * SSMC_STRIDE;
    bf16_t* WE = (bf16_t*)(base + SSMC_WE); bf16_t* TP = (bf16_t*)(base + SSMC_TOEP); bf16_t* WC = (bf16_t*)(base + SSMC_WC);
    for (int i = tid; i < 64 * 512; i += NTHREADS) { const int f = i >> 9, e = i & 511, ln = e >> 3, j = e & 7, mt = f >> 4, sx = f & 15, r = ln & 31, hh = ln >> 5;
        const int R = 32 * mt + r, p = R >> 1, ri = R & 1, ci = 8 * hh + j; const float er = apw[((15 - sx) * 64 + p) * 2], ei = apw[((15 - sx) * 64 + p) * 2 + 1], br = bbar[(p * 16 + ci) * 2], bi = bbar[(p * 16 + ci) * 2 + 1];
        WE[i] = f2bf(ri ? (er * bi + ei * br) : (er * br - ei * bi)); }
    for (int i = tid; i < 128 * 512; i += NTHREADS) { const int f = i >> 9, e = i & 511, ln = e >> 3, j = e & 7, mt = f >> 4, sx = f & 15, r = ln & 31, hh = ln >> 5;
        const int t = 2 * mt + (r >> 4), co = r & 15, ci = 8 * hh + j; TP[i] = f2bf(sx <= t ? kj[((t - sx) << 8) + co * 16 + ci] : 0.f); }
    for (int i = tid; i < 64 * 512; i += NTHREADS) { const int f = i >> 9, e = i & 511, ln = e >> 3, j = e & 7, mt = f >> 3, kc = f & 7, r = ln & 31, hh = ln >> 5;
        const int t = 2 * mt + (r >> 4), co = r & 15, p = 8 * kc + 4 * hh + (j >> 1), ri = j & 1; const float er = apw[((t + 1) * 64 + p) * 2], ei = apw[((t + 1) * 64 + p) * 2 + 1];
        const float cr = c_re[co * SSM_P + p], cim = c_im[co * SSM_P + p]; WC[i] = f2bf(ri ? -(cr * ei + cim * er) : (cr * er - cim * ei)); }
    if (tid < 64) { float* a16 = (float*)(P.ws + WS_A16) + (size_t)(item * 64 + tid) * 2; a16[0] = apw[(16 * 64 + tid) * 2]; a16[1] = apw[(16 * 64 + tid) * 2 + 1]; }
    __syncthreads();
}
__device__ __forceinline__ void phase_ssm_consts(const Params& P, LAS unsigned char* lds, int vcu, int G) {
    for (int it = vcu; it < DEPTH * SSM_G; it += G) ssm_consts_item(P, lds, it);
}
__device__ __forceinline__ float gelu_tanh_fast(float x) {
    const float u = 0.7978845608028654f * (x + 0.044715f * x * x * x); return x / (1.f + __expf(-2.f * u)); }

constexpr int SSM_E_PITCH = 65, SSM_E_BYTES = 128 * 65 * 8, SSM_H_PITCHB = 272, SSM_H_OFF = SSM_E_BYTES, SSM_H_BYTES = 128 * 272;
static_assert(SSM_H_OFF + SSM_H_BYTES <= 131072 && SSM_H_OFF % 16 == 0, "ssm lds");
__device__ __forceinline__ void ssm_item(const Params& P, int layer, LAS unsigned char* lds, int item) {
    const int tid = threadIdx.x, lane = tid & 63, wave = __builtin_amdgcn_readfirstlane(tid >> 6);
    const int g = item >> 3, b = item & 7;
    const bf16_t* Z = (const bf16_t*)(P.ws + WS_Z); bf16_t* Y2 = (bf16_t*)(P.ws + WS_Y2);
    const unsigned char* cbase = P.ws + WS_SSMP + (size_t)(layer * SSM_G + g) * SSMC_STRIDE;
    const f16x8* WE = (const f16x8*)(cbase + SSMC_WE) + lane; const f16x8* TP = (const f16x8*)(cbase + SSMC_TOEP) + lane; const f16x8* WC = (const f16x8*)(cbase + SSMC_WC) + lane;
    const int nl = lane & 31, hh = lane >> 5, ntile = wave & 3, msel = wave >> 2;
    typedef float f32x2v __attribute__((ext_vector_type(2)));
    LAS f32x2v* E = (LAS f32x2v*)lds; LAS unsigned char* Hl = lds + SSM_H_OFF;
    float hr = 0.f, hi_ = 0.f, a16r = 0.f, a16i = 0.f;
    if (wave == 0) { const float* a16 = (const float*)(P.ws + WS_A16) + (size_t)((layer * SSM_G + g) * 64 + lane) * 2; a16r = a16[0]; a16i = a16[1]; }
    for (int hf2 = 0; hf2 < 2; ++hf2) {
        const int nglob = 128 * hf2 + 32 * ntile + nl;
        const bf16_t* up = Z + (size_t)(b * SEQ + 16 * nglob) * IN_W + ZU + g * SSM_CH + 8 * hh;
        f16x8 uf[16];
#pragma unroll
        for (int sx = 0; sx < 16; ++sx) uf[sx] = *(const f16x8*)(up + (size_t)sx * IN_W);
        {
            f32x16 ae[2] = {};
#pragma unroll
            for (int sx = 0; sx < 16; ++sx) {
#pragma unroll
                for (int m2 = 0; m2 < 2; ++m2) ae[m2] = __builtin_amdgcn_mfma_f32_32x32x16_f16(WE[((2 * msel + m2) * 16 + sx) * 64], uf[sx], ae[m2], 0, 0, 0);
                if ((sx & 3) == 3) asm volatile("" ::: "memory"); }
#pragma unroll
            for (int m2 = 0; m2 < 2; ++m2)
#pragma unroll
                for (int r = 0; r < 16; r += 2) { const int p = 16 * (2 * msel + m2) + (crow(r, hh) >> 1);
                    E[(32 * ntile + nl) * SSM_E_PITCH + p] = (f32x2v){ae[m2][r], ae[m2][r + 1]}; }
        }
        __syncthreads();
        if (wave == 0) {
#pragma unroll 4
            for (int n = 0; n < 128; ++n) { const f32x2v e = E[n * SSM_E_PITCH + lane];
                *(LAS unsigned*)(Hl + n * SSM_H_PITCHB + 4 * lane) = pg8::pk_f16(hr, hi_);
                const float nr = a16r * hr - a16i * hi_ + e.x, ni = a16r * hi_ + a16i * hr + e.y; hr = nr; hi_ = ni; }
        }
        __syncthreads();
        {
            f32x16 ay[4] = {};
#pragma unroll
            for (int sx = 0; sx < 16; ++sx) {
#pragma unroll
                for (int i = 0; i < 4; ++i) { const int mt = (i & 1) ? (msel ? (i == 1 ? 2 : 6) : (i == 1 ? 3 : 7)) : (msel ? (i == 0 ? 1 : 5) : (i == 0 ? 0 : 4));
                    if (sx <= 2 * mt + 1) ay[i] = __builtin_amdgcn_mfma_f32_32x32x16_f16(TP[(mt * 16 + sx) * 64], uf[sx], ay[i], 0, 0, 0); }
                if ((sx & 1) == 1) asm volatile("" ::: "memory"); }
#pragma unroll
            for (int kc = 0; kc < 8; ++kc) { const f16x8 hfr = *(const LAS f16x8*)(Hl + (32 * ntile + nl) * SSM_H_PITCHB + 32 * kc + 16 * hh);
#pragma unroll
                for (int i = 0; i < 4; ++i) { const int mt = (i & 1) ? (msel ? (i == 1 ? 2 : 6) : (i == 1 ? 3 : 7)) : (msel ? (i == 0 ? 1 : 5) : (i == 0 ? 0 : 4));
                    ay[i] = __builtin_amdgcn_mfma_f32_32x32x16_f16(WC[(mt * 8 + kc) * 64], hfr, ay[i], 0, 0, 0); }
                if ((kc & 1) == 1) asm volatile("" ::: "memory"); }
#pragma unroll
            for (int i = 0; i < 4; ++i) { const int mt = (i & 1) ? (msel ? (i == 1 ? 2 : 6) : (i == 1 ? 3 : 7)) : (msel ? (i == 0 ? 1 : 5) : (i == 0 ? 0 : 4));
#pragma unroll
                for (int q = 0; q < 4; ++q) { const int t = 2 * mt + (q >> 1), co0 = 8 * (q & 1) + 4 * hh;
                    pg8::u32x2 w; w.x = pg8::pk_f16(gelu_tanh_fast(ay[i][4 * q]), gelu_tanh_fast(ay[i][4 * q + 1])); w.y = pg8::pk_f16(gelu_tanh_fast(ay[i][4 * q + 2]), gelu_tanh_fast(ay[i][4 * q + 3]));
                    *(pg8::u32x2*)(Y2 + (size_t)(b * SEQ + 16 * nglob + t) * SSM_W + g * SSM_CH + co0) = w; } }
        }
        __syncthreads();
    }
}
__device__ __forceinline__ void phase_ssm(const Params& P, int layer, LAS unsigned char* lds, int vcu, int G) {
    for (int it = vcu; it < SSM_G * BATCH; it += G) ssm_item(P, layer, lds, it);
}

enum { PH_PREP = 0, PH_MEMGEMM = 1, PH_INPROJ = 2, PH_GLU = 3, PH_OUTPROJ = 4, PH_MEMFIN = 5, PH_ATTN_A = 6, PH_ATTN_C = 7, PH_SSMC = 8, PH_SSM = 9 };
template <int PH>
__global__ void __launch_bounds__(NTHREADS, 2) k_phase(Params P, int layer) {
    extern __shared__ __attribute__((aligned(16))) unsigned char lds_raw[];
    LAS unsigned char* lds = (LAS unsigned char*)lds_raw;
    const int G = gridDim.x, bx = blockIdx.x; const int vcu = (G % 8 == 0) ? (bx % 8) * (G / 8) + bx / 8 : bx;
    unsigned char* ws = P.ws;
    if constexpr (PH == PH_PREP) { phase_prep(P, lds, vcu, G); }
    if constexpr (PH == PH_MEMFIN) { phase_memfin(P, vcu, G); }
    if constexpr (PH == PH_SSMC) { phase_ssm_consts(P, lds, vcu, G); }
    if constexpr (PH == PH_SSM) { phase_ssm(P, layer, lds, vcu, G); }
    if constexpr (PH == PH_ATTN_A) { phase_attn_a(P, layer, lds, vcu, G); }
    if constexpr (PH == PH_ATTN_C) { phase_attn_c(P, layer, lds, vcu, G); }
    if constexpr (PH == PH_MEMGEMM) {
        pg8::Gemm g{(const bf16_t*)(ws + WS_MEMB), (const bf16_t*)(ws + WS_WMEM), BATCH * N_MEM, DEPTH * 1024, D_MODEL}; pg8::StaticOrder S; S.init(g.M, g.N, G, bx);
        pg8::EpiMemF32 E{(float*)(ws + WS_Y2), DEPTH * 1024, (const float*)(ws + WS_MISC)};
        pg8::gemm_phase<pg8::EpiMemF32, pg8::StaticOrder, true>(lds, g, S, E);
    }
    if constexpr (PH == PH_INPROJ) {
        pg8::Gemm g{(const bf16_t*)(ws + WS_XB), (const bf16_t*)(ws + WS_WIN) + (size_t)layer * IN_W * D_MODEL, MTOK, IN_W, D_MODEL}; pg8::StaticOrder S; S.init(g.M, g.N, G, bx);
        pg8::EpiZ E{(bf16_t*)(ws + WS_Z), (const float*)(ws + WS_SUMSQ)};
        pg8::gemm_phase<pg8::EpiZ, pg8::StaticOrder, true>(lds, g, S, E);
    }
    if constexpr (PH == PH_GLU) {
        pg8::Gemm g{(const bf16_t*)(ws + WS_Y2), (const bf16_t*)(ws + WS_WGLU) + (size_t)layer * SSM_W * SSM_W, MTOK, SSM_W, SSM_W}; pg8::StaticOrder S; S.init(g.M, g.N, G, bx);
        pg8::EpiGlu E{(const bf16_t*)(ws + WS_Y2), (const bf16_t*)(ws + WS_Z), P.b_glu + layer * SSM_W, (bf16_t*)(ws + WS_MIX)};
        pg8::gemm_phase<pg8::EpiGlu, pg8::StaticOrder, true>(lds, g, S, E);
    }
    if constexpr (PH == PH_OUTPROJ) {
        pg8::Gemm g{(const bf16_t*)(ws + WS_MIX), (const bf16_t*)(ws + WS_WOUT) + (size_t)layer * D_MODEL * MIX_W, MTOK, D_MODEL, MIX_W}; pg8::StaticOrder S; S.init(g.M, g.N, G, bx);
        pg8::EpiOut E{layer == 0 ? P.x : P.out, P.out, (bf16_t*)(ws + WS_XB), (float*)(ws + WS_SUMSQ)};
        pg8::gemm_phase<pg8::EpiOut, pg8::StaticOrder, true>(lds, g, S, E);
    }
}
__global__ void k_memkv_fin2(const float* __restrict__ mkv, int layer, const float* __restrict__ xkg, bf16_t* __restrict__ mk, bf16_t* __restrict__ mv) {
    int row = blockIdx.x * (blockDim.x >> 6) + (threadIdx.x >> 6), lane = threadIdx.x & 63;
    const float* r = mkv + (size_t)row * (DEPTH * 1024) + layer * 1024;
    for (int h = 0; h < XH; ++h) {
        float v0 = r[h * XHD + lane], v1 = r[h * XHD + 64 + lane];
        float s = wave_sum(v0 * v0 + v1 * v1);
        float rs = rsqrtf(s * (1.f / XHD) + EPS);
        mk[(size_t)row * 512 + h * XHD + lane] = f2bf(v0 * rs * xkg[lane]);
        mk[(size_t)row * 512 + h * XHD + 64 + lane] = f2bf(v1 * rs * xkg[64 + lane]);
        mv[(size_t)row * 512 + h * XHD + lane] = f2bf(r[512 + h * XHD + lane]);
        mv[(size_t)row * 512 + h * XHD + 64 + lane] = f2bf(r[512 + h * XHD + 64 + lane]);
    }
}
__global__ void k_qk_prep(bf16_t* __restrict__ z, const float* __restrict__ qg, const float* __restrict__ kg, const float* __restrict__ xqg, const float* __restrict__ rope) {
    int tok = blockIdx.x * (blockDim.x >> 6) + (threadIdx.x >> 6), lane = threadIdx.x & 63;
    bf16_t* zr = z + (size_t)tok * IN_W;
    float cs = rope[(size_t)tok * 64 + (lane & 31)], sn = rope[(size_t)tok * 64 + 32 + (lane & 31)];
    for (int h = 0; h < NQH + NKVH; ++h) {
        int off = (h < NQH) ? ZQ + h * HD : ZK + (h - NQH) * HD;
        float v = bf2f(zr[off + lane]);
        float s = wave_sum(v * v);
        float g = (h < NQH) ? qg[lane] : kg[lane];
        v = v * rsqrtf(s * (1.f / HD) + EPS) * g;
        float p = __shfl_xor(v, 32);
        float o = (lane < 32) ? (v * cs - p * sn) : (v * cs + p * sn);
        zr[off + lane] = f2bf(o);
    }
    for (int h = 0; h < XH; ++h) {
        int off = ZXQ + h * XHD;
        float v0 = bf2f(zr[off + lane]), v1 = bf2f(zr[off + 64 + lane]);
        float s = wave_sum(v0 * v0 + v1 * v1);
        float r = rsqrtf(s * (1.f / XHD) + EPS);
        zr[off + lane] = f2bf(v0 * r * xqg[lane]); zr[off + 64 + lane] = f2bf(v1 * r * xqg[64 + lane]);
    }
}

__global__ __launch_bounds__(256) void k_attn_a(const bf16_t* __restrict__ z, const float* __restrict__ sinks, bf16_t* __restrict__ mix) {
    int idx = blockIdx.x * blockDim.x + threadIdx.x;
    int hq = idx / MTOK, tok = idx % MTOK;
    int t = tok % SEQ, b = tok / SEQ, kvh = hq / (NQH / NKVH);
    float q[HD], o[HD];
    const bf16_t* qp = z + (size_t)tok * IN_W + ZQ + hq * HD;
#pragma unroll
    for (int d = 0; d < HD; ++d) { q[d] = bf2f(qp[d]) * 0.125f; o[d] = 0.f; }
    float m = sinks[hq], l = 1.f;
    int s0 = t - (WINDOW - 1); if (s0 < 0) s0 = 0;
    for (int s = s0; s <= t; ++s) {
        const bf16_t* kp = z + (size_t)(b * SEQ + s) * IN_W + ZK + kvh * HD;
        const bf16_t* vp = z + (size_t)(b * SEQ + s) * IN_W + ZV + kvh * HD;
        float sc = 0.f;
#pragma unroll
        for (int d = 0; d < HD; ++d) sc += q[d] * bf2f(kp[d]);
        float mn = fmaxf(m, sc), f = __expf(m - mn), p = __expf(sc - mn);
        l = l * f + p; m = mn;
#pragma unroll
        for (int d = 0; d < HD; ++d) o[d] = o[d] * f + p * bf2f(vp[d]);
    }
    float il = 1.f / l;
    const bf16_t* gp = z + (size_t)tok * IN_W + ZG + hq * HD;
    bf16_t* mp = mix + (size_t)tok * MIX_W + hq * HD;
#pragma unroll
    for (int d = 0; d < HD; ++d) mp[d] = f2bf(o[d] * il * siluf_(bf2f(gp[d])));
}

__global__ __launch_bounds__(256) void k_attn_c(const bf16_t* __restrict__ z, const bf16_t* __restrict__ mk, const bf16_t* __restrict__ mv, bf16_t* __restrict__ mix) {
    __shared__ float qs[16][XHD];
    __shared__ float ps[16][N_MEM];
    __shared__ float red[16][4];
    int blk = blockIdx.x;
    int tile = blk % (SEQ / 16), h = (blk / (SEQ / 16)) % XH, b = blk / (SEQ / 16 * XH);
    int tid = threadIdx.x, lane = tid & 63, w = tid >> 6;
    int tok0 = b * SEQ + tile * 16;
    for (int i = tid; i < 16 * XHD; i += 256) { int tt = i / XHD, d = i % XHD; qs[tt][d] = bf2f(z[(size_t)(tok0 + tt) * IN_W + ZXQ + h * XHD + d]); }
    __syncthreads();
    const bf16_t* kr = mk + ((size_t)(b * N_MEM + tid) * 512 + h * XHD);
    float sc[16];
#pragma unroll
    for (int tt = 0; tt < 16; ++tt) sc[tt] = 0.f;
    for (int d = 0; d < XHD; ++d) {
        float kv = bf2f(kr[d]);
#pragma unroll
        for (int tt = 0; tt < 16; ++tt) sc[tt] += qs[tt][d] * kv;
    }
    const float scale = 0.08838834764831845f;
#pragma unroll
    for (int tt = 0; tt < 16; ++tt) {
        sc[tt] *= scale;
        float mx = sc[tt];
#pragma unroll
        for (int o = 1; o < 64; o <<= 1) mx = fmaxf(mx, __shfl_xor(mx, o));
        if (lane == 0) red[tt][w] = mx;
    }
    __syncthreads();
#pragma unroll
    for (int tt = 0; tt < 16; ++tt) {
        float mx = fmaxf(fmaxf(red[tt][0], red[tt][1]), fmaxf(red[tt][2], red[tt][3]));
        sc[tt] = __expf(sc[tt] - mx);
    }
    __syncthreads();
#pragma unroll
    for (int tt = 0; tt < 16; ++tt) {
        float s = wave_sum(sc[tt]);
        if (lane == 0) red[tt][w] = s;
    }
    __syncthreads();
#pragma unroll
    for (int tt = 0; tt < 16; ++tt) {
        float s = red[tt][0] + red[tt][1] + red[tt][2] + red[tt][3];
        ps[tt][tid] = sc[tt] / s;
    }
    __syncthreads();
    int d = tid & 127, th = tid >> 7;
    float o[8];
#pragma unroll
    for (int i = 0; i < 8; ++i) o[i] = 0.f;
    for (int m = 0; m < N_MEM; ++m) {
        float v = bf2f(mv[(size_t)(b * N_MEM + m) * 512 + h * XHD + d]);
#pragma unroll
        for (int i = 0; i < 8; ++i) o[i] += ps[th * 8 + i][m] * v;
    }
#pragma unroll
    for (int i = 0; i < 8; ++i) {
        int tok = tok0 + th * 8 + i;
        float g = bf2f(z[(size_t)tok * IN_W + ZXG + h * XHD + d]);
        mix[(size_t)tok * MIX_W + 1024 + h * XHD + d] = f2bf(o[i] * siluf_(g));
    }
}

__global__ __launch_bounds__(64) void k_ssm_naive(const bf16_t* __restrict__ z, const float* __restrict__ ssmp, const float* __restrict__ c_re, const float* __restrict__ c_im,
                                                  const float* __restrict__ d_skip, bf16_t* __restrict__ y2) {
    int g = blockIdx.x % SSM_G, b = blockIdx.x / SSM_G, p = threadIdx.x;
    const float ar = ssmp[(g * SSM_P + p) * 2], ai = ssmp[(g * SSM_P + p) * 2 + 1];
    const float* bb = ssmp + SSM_G * SSM_P * 2 + (size_t)(g * SSM_P + p) * SSM_CH * 2;
    float bbr[SSM_CH], bbi[SSM_CH], cr[SSM_CH], ci[SSM_CH];
#pragma unroll
    for (int c = 0; c < SSM_CH; ++c) { bbr[c] = bb[c * 2]; bbi[c] = bb[c * 2 + 1]; cr[c] = c_re[(size_t)(g * SSM_CH + c) * SSM_P + p]; ci[c] = c_im[(size_t)(g * SSM_CH + c) * SSM_P + p]; }
    const int ch = (p >> 2) & 15;
    const float dsk = d_skip[g * SSM_CH + ch];
    float hr = 0.f, hi = 0.f;
    for (int t = 0; t < SEQ; ++t) {
        const bf16_t* up = z + (size_t)(b * SEQ + t) * IN_W + ZU + g * SSM_CH;
        float u[SSM_CH];
#pragma unroll
        for (int c = 0; c < SSM_CH; ++c) u[c] = bf2f(up[c]);
        float xr = 0.f, xi = 0.f;
#pragma unroll
        for (int c = 0; c < SSM_CH; ++c) { xr += bbr[c] * u[c]; xi += bbi[c] * u[c]; }
        float nr = ar * hr - ai * hi + xr, ni = ar * hi + ai * hr + xi;
        hr = nr; hi = ni;
        float v[SSM_CH];
#pragma unroll
        for (int c = 0; c < SSM_CH; ++c) v[c] = cr[c] * hr - ci[c] * hi;
        float w8[8], w4[4], w2[2], w1;
        { bool up_ = (p & 32) != 0;
#pragma unroll
          for (int i = 0; i < 8; ++i) { float send = up_ ? v[i] : v[8 + i]; float keep = up_ ? v[8 + i] : v[i]; w8[i] = keep + __shfl_xor(send, 32); } }
        { bool up_ = (p & 16) != 0;
#pragma unroll
          for (int i = 0; i < 4; ++i) { float send = up_ ? w8[i] : w8[4 + i]; float keep = up_ ? w8[4 + i] : w8[i]; w4[i] = keep + __shfl_xor(send, 16); } }
        { bool up_ = (p & 8) != 0;
#pragma unroll
          for (int i = 0; i < 2; ++i) { float send = up_ ? w4[i] : w4[2 + i]; float keep = up_ ? w4[2 + i] : w4[i]; w2[i] = keep + __shfl_xor(send, 8); } }
        { bool up_ = (p & 4) != 0; float send = up_ ? w2[0] : w2[1]; float keep = up_ ? w2[1] : w2[0]; w1 = keep + __shfl_xor(send, 4); }
        w1 += __shfl_xor(w1, 2); w1 += __shfl_xor(w1, 1);
        if ((p & 3) == 0) {
            float uc = bf2f(up[ch]);
            float y = w1 + dsk * uc;
            y2[(size_t)(b * SEQ + t) * SSM_W + g * SSM_CH + ch] = f2bf(gelu_tanh(y));
        }
    }
}


template <int PH> static void launch_phase(const Params& P, int layer, int grid, hipStream_t stream) {
    hipFuncSetAttribute((const void*)k_phase<PH>, hipFuncAttributeMaxDynamicSharedMemorySize, LDS_BYTES);
    hipLaunchKernelGGL(k_phase<PH>, dim3(grid), dim3(NTHREADS), LDS_BYTES, stream, P, layer);
}
extern "C" void kernel_launch(void* const* d_in, const int* in_sizes, int n_in, void* d_out, int out_size, void* d_ws, size_t ws_size, hipStream_t stream) {
    if (ws_size < WS_END || n_in != 23) return;
    static int grid = 0;
    if (grid == 0) { int dev = 0, cus = 0; hipGetDevice(&dev); hipDeviceGetAttribute(&cus, hipDeviceAttributeMultiprocessorCount, dev); grid = cus > 0 ? cus : 256; }
    Params P{};
    P.x = (const float*)d_in[0]; P.mem = (const float*)d_in[1]; P.pos = (const int*)d_in[2]; P.norm_g = (const float*)d_in[3]; P.w_in = (const float*)d_in[4];
    P.q_norm_g = (const float*)d_in[5]; P.k_norm_g = (const float*)d_in[6]; P.sinks = (const float*)d_in[7]; P.lam_re = (const float*)d_in[8]; P.lam_im = (const float*)d_in[9];
    P.log_dt = (const float*)d_in[10]; P.b_re = (const float*)d_in[11]; P.b_im = (const float*)d_in[12]; P.c_re = (const float*)d_in[13]; P.c_im = (const float*)d_in[14];
    P.d_skip = (const float*)d_in[15]; P.w_glu = (const float*)d_in[16]; P.b_glu = (const float*)d_in[17]; P.mem_norm_g = (const float*)d_in[18]; P.w_mem_kv = (const float*)d_in[19];
    P.xq_norm_g = (const float*)d_in[20]; P.xk_norm_g = (const float*)d_in[21]; P.w_out = (const float*)d_in[22];
    P.out = (float*)d_out; P.ws = (unsigned char*)d_ws;
    char* ws = (char*)d_ws;
    bf16_t* Z = (bf16_t*)(ws + WS_Z); bf16_t* MIX = (bf16_t*)(ws + WS_MIX); bf16_t* Y2 = (bf16_t*)(ws + WS_Y2);
    bf16_t* MK = (bf16_t*)(ws + WS_MK); bf16_t* MV = (bf16_t*)(ws + WS_MV); float* ROPE = (float*)(ws + WS_ROPE); float* SSMP = (float*)(ws + WS_SSMP);

    launch_phase<PH_PREP>(P, 0, grid, stream);
    launch_phase<PH_SSMC>(P, 0, grid, stream);
    launch_phase<PH_MEMGEMM>(P, 0, grid, stream);
#if USE_MFMA_C
    launch_phase<PH_MEMFIN>(P, 0, grid, stream);
#else
    for (int l = 0; l < DEPTH; ++l)
        k_memkv_fin2<<<BATCH * N_MEM / 4, 256, 0, stream>>>((const float*)(ws + WS_Y2), l, P.xk_norm_g + l * XHD, MK + (size_t)l * BATCH * N_MEM * 512, MV + (size_t)l * BATCH * N_MEM * 512);
#endif
    for (int l = 0; l < DEPTH; ++l) {
        launch_phase<PH_INPROJ>(P, l, grid, stream);
#if USE_MFMA_A && A_PREPPED
        k_qk_prep<<<MTOK / 4, 256, 0, stream>>>(Z, P.q_norm_g + l * HD, P.k_norm_g + l * HD, P.xq_norm_g + l * XHD, ROPE);
#endif
#if USE_MFMA_A
        launch_phase<PH_ATTN_A>(P, l, grid, stream);
#endif
#if USE_MFMA_C
        launch_phase<PH_ATTN_C>(P, l, grid, stream);
#endif
#if (!USE_MFMA_A || !USE_MFMA_C) && !(USE_MFMA_A && A_PREPPED)
        k_qk_prep<<<MTOK / 4, 256, 0, stream>>>(Z, P.q_norm_g + l * HD, P.k_norm_g + l * HD, P.xq_norm_g + l * XHD, ROPE);
#endif
#if !USE_MFMA_A
        k_attn_a<<<MTOK * NQH / 256, 256, 0, stream>>>(Z, P.sinks + l * NQH, MIX);
#endif
#if !USE_MFMA_C
        k_attn_c<<<BATCH * XH * (SEQ / 16), 256, 0, stream>>>(Z, MK + (size_t)l * BATCH * N_MEM * 512, MV + (size_t)l * BATCH * N_MEM * 512, MIX);
#endif
        launch_phase<PH_SSM>(P, l, grid, stream);
        launch_phase<PH_GLU>(P, l, grid, stream);
        launch_phase<PH_OUTPROJ>(P, l, grid, stream);
    }
}
```

```cpp
#include <hip/hip_runtime.h>
#include <cstdio>
#include <stdint.h>
#include <math.h>

constexpr int D_MODEL = 1024, BATCH = 8, SEQ = 4096, DEPTH = 4, MTOK = BATCH * SEQ;
constexpr int HD = 64, NQH = 8, NKVH = 2, WINDOW = 128;
constexpr int SSM_CH = 16, SSM_G = 32, SSM_P = 64, SSM_W = 512, N_MEM = 256, XH = 4, XHD = 128;
constexpr int MIX_W = 1536, IN_W = 3328;
constexpr int ZQ = 0, ZK = 512, ZV = 640, ZG = 768, ZU = 1280, ZSG = 1792, ZXQ = 2304, ZXG = 2816;
constexpr float EPS = 1e-6f;

typedef unsigned short bf16_t;
__device__ __forceinline__ bf16_t f2bf(float f) { _Float16 h = (_Float16)f; return __builtin_bit_cast(unsigned short, h); }
__device__ __forceinline__ float bf2f(bf16_t h) { return (float)__builtin_bit_cast(_Float16, h); }
__device__ __forceinline__ float sigmoidf_(float x) { return __builtin_amdgcn_rcpf(1.f + __expf(-x)); }
__device__ __forceinline__ float siluf_(float x) { return x * sigmoidf_(x); }
__device__ __forceinline__ float gelu_tanh(float x) { const float c = 0.7978845608028654f; float u = c * (x + 0.044715f * x * x * x); return 0.5f * x * (1.f + tanhf(u)); }
__device__ __forceinline__ float wave_sum(float v) {
#pragma unroll
    for (int o = 1; o < 64; o <<= 1) v += __shfl_xor(v, o);
    return v;
}

constexpr size_t MiB = 1u << 20;
constexpr size_t WS_Z = 0;
constexpr size_t WS_MIX = 208 * MiB;
constexpr size_t WS_XB = 304 * MiB;
constexpr size_t WS_Y2 = 368 * MiB;
constexpr size_t WS_WIN = 400 * MiB;
constexpr size_t WS_WOUT = 426 * MiB;
constexpr size_t WS_WGLU = 438 * MiB;
constexpr size_t WS_WMEM = 440 * MiB;
constexpr size_t WS_MEMB = 448 * MiB;
constexpr size_t WS_MK = 452 * MiB;
constexpr size_t WS_MV = 460 * MiB;
constexpr size_t WS_ROPE = 468 * MiB;
constexpr size_t WS_SSMP = 476 * MiB;
constexpr size_t WS_SUMSQ = 508 * MiB;
constexpr size_t WS_MISC = 510 * MiB;
constexpr size_t WS_END = 511 * MiB;


namespace pg8 {
#define PG8_LAS __attribute__((address_space(3)))
typedef _Float16 f16x8 __attribute__((ext_vector_type(8)));
typedef _Float16 f16x2 __attribute__((ext_vector_type(2)));
typedef float f32x4 __attribute__((ext_vector_type(4)));
typedef unsigned u32x4 __attribute__((ext_vector_type(4)));
typedef unsigned u32x2 __attribute__((ext_vector_type(2)));
constexpr int BM = 256, BK = 64, HALF = 128, HTB = HALF * BK * 2, STAGE_BYTES = 8 * HTB, NXCD = 8, WGM = 8;
__host__ __device__ __forceinline__ int lds_byte(int r, int c) { const int st = (r >> 4) * 2 + (c >> 5), rr = r & 15, cc = c & 31, ob = rr * 64 + cc * 2; return st * 1024 + (ob ^ (((ob >> 9) & 1) << 5)); }
__host__ __device__ __forceinline__ void stage_rc(int b, int& R, int& C) { const int st = b / 1024, sb = b % 1024, swz = sb ^ (((sb >> 9) & 1) << 5); R = (st >> 1) * 16 + swz / 64; C = (st & 1) * 32 + (swz % 64) / 2; }
__host__ __device__ __forceinline__ int perm32(int rho) { const int n = rho >> 4, i = rho & 15; return 8 * (i >> 2) + 4 * n + (i & 3); }
struct Unit { int pm, pn, c0, half; };
struct Gemm { const bf16_t* A; const bf16_t* Bt; int M, N, K; };
struct StaticOrder {
    int nM, nN, nwg, G, c;
    __host__ __device__ void init(int M, int N, int G_, int c_) { nM = M / BM; nN = N / BM; nwg = nM * nN; G = G_; c = c_; }
    __host__ __device__ bool next(int i, Unit& u) const {
        const long L = (long)i * G + c; if (L >= nwg) return false;
        int wgid = (int)L; { const int q = nwg / NXCD, r = nwg % NXCD, xcd = wgid % NXCD, off = wgid / NXCD; wgid = (xcd < r ? xcd * (q + 1) : r * (q + 1) + (xcd - r) * q) + off; }
        const int nig = WGM * nN, gid = wgid / nig, fm = gid * WGM, gsz = (nM - fm) < WGM ? (nM - fm) : WGM;
        u.pm = fm + ((wgid % nig) % gsz); u.pn = (wgid % nig) / gsz; u.c0 = u.pn * BM; u.half = 0; return true;
    }
    __device__ __forceinline__ void a_ready(const Unit&) const {}
    __device__ __forceinline__ void done(const Unit&) const {}
};
struct TailOrder : StaticOrder {
    __host__ __device__ bool next(int i, Unit& u) const {
        const int full = nwg / G, left = nwg - full * G;
        if (i < full || 2 * left > G) return StaticOrder::next(i, u);
        if (i > full || c >= 2 * left) return false;
        StaticOrder t = *this; t.c = c >> 1;
        (void)t.StaticOrder::next(full, u);
        u.c0 += 128 * (c & 1); u.half = 1; return true;
    }
};
struct SkipOrder : StaticOrder {
    int skip;
    __host__ __device__ void init2(int M, int N, int G_, int c_, int skip_) { init(M, N - BM, G_, c_); skip = skip_; }
    __host__ __device__ bool next(int i, Unit& u) const { if (!StaticOrder::next(i, u)) return false; if (u.pn >= skip) { u.pn += 1; u.c0 = u.pn * BM; } return true; }
};
struct DeferOrder {
    int nM, pn, G, c;
    __host__ __device__ void init(int M, int G_, int c_, int pn_) { nM = M / BM; G = G_; c = c_; pn = pn_; }
    __host__ __device__ bool next(int i, Unit& u) const { const int L = i * G + c; if (L >= nM) return false; u.pm = L; u.pn = pn; u.c0 = pn * BM; u.half = 0; return true; }
    __device__ __forceinline__ void a_ready(const Unit&) const {}
    __device__ __forceinline__ void done(const Unit&) const {}
};
struct MemTailOrder {
    int k, stride, nM, nwg;
    __host__ __device__ void init(int M, int N, int G, int c, int first) { nM = M / BM; nwg = nM * (N / BM); k = c - first; stride = G - first; }
    __host__ __device__ bool next(int i, Unit& u) const {
        if (k < 0) return false;
        const int L = i * stride + k; if (L >= nwg) return false;
        u.pm = L % nM; u.pn = L / nM; u.c0 = u.pn * BM; u.half = 0; return true;
    }
    __device__ __forceinline__ void a_ready(const Unit&) const {}
    __device__ __forceinline__ void done(const Unit&) const {}
};
__device__ __forceinline__ unsigned pk_f16(float lo, float hi) { f16x2 v = {(_Float16)lo, (_Float16)hi}; return __builtin_bit_cast(unsigned, v); }
__device__ __forceinline__ float h_lo(unsigned w) { return (float)__builtin_bit_cast(_Float16, (unsigned short)(w & 0xffffu)); }
__device__ __forceinline__ float h_hi(unsigned w) { return (float)__builtin_bit_cast(_Float16, (unsigned short)(w >> 16)); }

struct EpiZ {
    static constexpr bool PERM = true, AFTER_DRAIN = false;
    bf16_t* Z; const float* sumsq;
    __device__ __forceinline__ void operator()(const f32x4 (&acc)[2][2][4][2], const Unit& u, int wr, int wc, int fr, int fq) const {
        const int row0 = u.pm * BM + wr * 64 + fr, col0 = u.c0 + wc * 64 + 8 * fq; const bool full_w = !u.half;
#pragma unroll
        for (int ai = 0; ai < 2; ++ai)
#pragma unroll
            for (int m = 0; m < 4; ++m) { const int r = row0 + ai * HALF + m * 16;
                const f32x4* sp = (const f32x4*)(sumsq + (size_t)r * 16); const f32x4 s0 = sp[0], s1 = sp[1], s2 = sp[2], s3 = sp[3];
                const float ss = ((s0[0] + s0[1]) + (s0[2] + s0[3])) + ((s1[0] + s1[1]) + (s1[2] + s1[3])) + ((s2[0] + s2[1]) + (s2[2] + s2[3])) + ((s3[0] + s3[1]) + (s3[2] + s3[3]));
                const float rs = rsqrtf(ss * (1.f / D_MODEL) + EPS);
                bf16_t* rowp = Z + (size_t)r * IN_W + col0;
#pragma unroll
                for (int bj = 0; bj < 2; ++bj) { if (bj == 0 || full_w) { const f32x4 v0 = acc[ai][bj][m][0] * rs, v1 = acc[ai][bj][m][1] * rs;
                    u32x4 w; w.x = pk_f16(v0[0], v0[1]); w.y = pk_f16(v0[2], v0[3]); w.z = pk_f16(v1[0], v1[1]); w.w = pk_f16(v1[2], v1[3]);
                    *(u32x4*)(rowp + bj * 32) = w; } } }
    }
};
struct EpiGlu {
    static constexpr bool PERM = true, AFTER_DRAIN = false;
    const bf16_t* Y2; const bf16_t* Z; const float* bg; bf16_t* MIX;
    __device__ __forceinline__ void operator()(const f32x4 (&acc)[2][2][4][2], const Unit& u, int wr, int wc, int fr, int fq) const {
        const int row0 = u.pm * BM + wr * 64 + fr, col0 = u.c0 + wc * 64 + 8 * fq;
#pragma unroll
        for (int bj = 0; bj < 2; ++bj) { const int c = col0 + bj * 32;
            const f32x4 b0 = *(const f32x4*)(bg + c), b1 = *(const f32x4*)(bg + c + 4);
#pragma unroll
            for (int ai = 0; ai < 2; ++ai)
#pragma unroll
                for (int m = 0; m < 4; ++m) { const int r = row0 + ai * HALF + m * 16;
                    const u32x4 yv = *(const u32x4*)(Y2 + (size_t)r * SSM_W + c), sv = *(const u32x4*)(Z + (size_t)r * IN_W + ZSG + c);
                    const f32x4 a0 = acc[ai][bj][m][0] + b0, a1 = acc[ai][bj][m][1] + b1;
                    float o[8];
#pragma unroll
                    for (int j = 0; j < 4; ++j) { const unsigned yw = yv[j], sw = sv[j];
                        const float g0 = (j < 2) ? a0[2 * j] : a1[2 * j - 4], g1 = (j < 2) ? a0[2 * j + 1] : a1[2 * j - 3];
                        o[2 * j] = h_lo(yw) * sigmoidf_(g0) * siluf_(h_lo(sw)); o[2 * j + 1] = h_hi(yw) * sigmoidf_(g1) * siluf_(h_hi(sw)); }
                    u32x4 w; w.x = pk_f16(o[0], o[1]); w.y = pk_f16(o[2], o[3]); w.z = pk_f16(o[4], o[5]); w.w = pk_f16(o[6], o[7]);
                    *(u32x4*)(MIX + (size_t)r * MIX_W + 512 + c) = w; } }
    }
};
template <int MODE> struct EpiOut {
    static constexpr bool PERM = true, AFTER_DRAIN = false;
    const float* xin; float* xout; bf16_t* XB; float* sumsq;
    __device__ __forceinline__ void operator()(const f32x4 (&acc)[2][2][4][2], const Unit& u, int wr, int wc, int fr, int fq) const {
        const int row0 = u.pm * BM + wr * 64 + fr, col0 = u.c0 + wc * 64 + 8 * fq;
#pragma unroll
        for (int ai = 0; ai < 2; ++ai)
#pragma unroll
            for (int m = 0; m < 4; ++m) { const int r = row0 + ai * HALF + m * 16; const size_t off = (size_t)r * D_MODEL + col0; float ss = 0.f;
#pragma unroll
                for (int bj = 0; bj < 2; ++bj) { f32x4 x0, x1;
                    if (MODE == 0) { x0 = *(const f32x4*)(xin + off + bj * 32); x1 = *(const f32x4*)(xin + off + bj * 32 + 4); }
                    else { const u32x4 xv = *(const u32x4*)(XB + off + bj * 32); x0 = (f32x4){h_lo(xv.x), h_hi(xv.x), h_lo(xv.y), h_hi(xv.y)}; x1 = (f32x4){h_lo(xv.z), h_hi(xv.z), h_lo(xv.w), h_hi(xv.w)}; }
                    const f32x4 o0 = x0 + acc[ai][bj][m][0], o1 = x1 + acc[ai][bj][m][1];
                    if (MODE == 2) { *(f32x4*)(xout + off + bj * 32) = o0; *(f32x4*)(xout + off + bj * 32 + 4) = o1; }
                    else { u32x4 w; w.x = pk_f16(o0[0], o0[1]); w.y = pk_f16(o0[2], o0[3]); w.z = pk_f16(o1[0], o1[1]); w.w = pk_f16(o1[2], o1[3]); *(u32x4*)(XB + off + bj * 32) = w;
                        ss += ((o0[0] * o0[0] + o0[1] * o0[1]) + (o0[2] * o0[2] + o0[3] * o0[3])) + ((o1[0] * o1[0] + o1[1] * o1[1]) + (o1[2] * o1[2] + o1[3] * o1[3])); } }
                if (MODE != 2) { ss += __shfl_xor(ss, 16); ss += __shfl_xor(ss, 32);
                    if (fq == 0) sumsq[(size_t)r * 16 + (u.c0 >> 8) * 4 + wc] = ss; } }
    }
};
struct EpiMemF32 {
    static constexpr bool PERM = false, AFTER_DRAIN = false;
    float* C; int ldc; const float* rstd;
    __device__ __forceinline__ void operator()(const f32x4 (&acc)[2][2][4][2], const Unit& u, int wr, int wc, int fr, int fq) const {
        const int row0 = u.pm * BM + wr * 64 + fr, col0 = u.c0 + wc * 32 + 4 * fq;
#pragma unroll
        for (int ai = 0; ai < 2; ++ai)
#pragma unroll
            for (int m = 0; m < 4; ++m) { const int r = row0 + ai * HALF + m * 16; const float rs = rstd[r]; float* rowp = C + (size_t)r * ldc + col0;
#pragma unroll
                for (int bj = 0; bj < 2; ++bj)
#pragma unroll
                    for (int n = 0; n < 2; ++n) *(f32x4*)(rowp + bj * HALF + n * 16) = acc[ai][bj][m][n] * rs; }
    }
};

template <class Epi, class Sched, bool ALIGN_EPI>
__device__ __forceinline__ void gemm_phase(PG8_LAS unsigned char* lds, const Gemm g, const Sched& S, const Epi& E) {
    int tid = threadIdx.x; asm volatile("" : "+v"(tid)); const int wid = __builtin_amdgcn_readfirstlane(tid >> 6), lane = tid & 63, wr = wid >> 2, wc = wid & 3, fr = lane & 15, fq = lane >> 4;
    const int K = g.K, nt = K / BK;
    unsigned voffA[2], voffB[2];
#pragma unroll
    for (int i = 0; i < 2; ++i) { int R, C; stage_rc(tid * 16 + i * 8192, R, C); const int Rb = Epi::PERM ? (64 * (R >> 5) + perm32(R & 31)) : R;
        voffA[i] = (unsigned)(R * K + C) * 2u; voffB[i] = (unsigned)(Rb * K + C) * 2u; }
    const size_t kstep = (size_t)(BK * 2);
    const size_t hstep = (size_t)HALF * K * 2;
    const size_t tstep = 2 * hstep;
    const size_t bhs = Epi::PERM ? (size_t)32 * K * 2 : hstep;
    const unsigned ldsw = (unsigned)wid * 1024u;
    const int aoff = lds_byte(wr * 64 + fr, fq * 8), boff = lds_byte(wc * 32 + fr, fq * 8);
#define PG8_SA(b, h) (((b) * 2 + (h)) * HTB)
#define PG8_SB(b, h) ((4 + (b) * 2 + (h)) * HTB)
#define PG8_STAGE(bufoff, gbase, voff) do { _Pragma("unroll") for (int _i = 0; _i < 2; ++_i) \
        __builtin_amdgcn_global_load_lds((const unsigned*)((const char*)(gbase) + (voff)[_i]), (PG8_LAS unsigned*)(lds + (bufoff) + ldsw + _i * 8192), 16, 0, 0); } while (0)
#define PG8_LDA(dst, b, h) do { _Pragma("unroll") for (int m = 0; m < 4; ++m) _Pragma("unroll") for (int k = 0; k < 2; ++k) dst[m][k] = *(const PG8_LAS f16x8*)(lds + PG8_SA(b, h) + aoff + m * 2048 + k * 1024); } while (0)
#define PG8_LDB(dst, b, h) do { _Pragma("unroll") for (int n = 0; n < 2; ++n) _Pragma("unroll") for (int k = 0; k < 2; ++k) dst[n][k] = *(const PG8_LAS f16x8*)(lds + PG8_SB(b, h) + boff + n * 2048 + k * 1024); } while (0)
#define PG8_MMA(ai, bj, At, Bt) do { __builtin_amdgcn_s_setprio(1); _Pragma("unroll") for (int m = 0; m < 4; ++m) _Pragma("unroll") for (int n = 0; n < 2; ++n) _Pragma("unroll") for (int k = 0; k < 2; ++k) \
        acc[ai][bj][m][n] = __builtin_amdgcn_mfma_f32_16x16x32_f16(Bt[n][k], At[m][k], acc[ai][bj][m][n], 0, 0, 0); __builtin_amdgcn_s_setprio(0); } while (0)
#define PG8_WAIT_V(n) asm volatile("s_waitcnt vmcnt(" #n ")" ::: "memory")
#define PG8_WAIT_L(n) asm volatile("s_waitcnt lgkmcnt(" #n ")" ::: "memory")
#define PG8_BAR __builtin_amdgcn_s_barrier()
#define PG8_SCHED __builtin_amdgcn_sched_barrier(0)
    Unit cur, nxt; int ui = 0;
    if (!S.next(0, cur)) return;
    f32x4 acc[2][2][4][2];
#pragma unroll
    for (int a = 0; a < 2; ++a)
#pragma unroll
        for (int b = 0; b < 2; ++b)
#pragma unroll
            for (int m = 0; m < 4; ++m)
#pragma unroll
                for (int n = 0; n < 2; ++n) acc[a][b][m][n] = (f32x4){0.f, 0.f, 0.f, 0.f};
    f16x8 At[4][2], B0[2][2], B1[2][2];
    const char* cA = (const char*)g.A + (size_t)cur.pm * tstep; const char* cB = (const char*)g.Bt + (size_t)cur.c0 * K * 2;
    S.a_ready(cur);
    PG8_STAGE(PG8_SB(0, 0), cB, voffB); PG8_STAGE(PG8_SB(0, 1), cB + bhs, voffB); PG8_STAGE(PG8_SA(0, 0), cA, voffA); PG8_STAGE(PG8_SA(0, 1), cA + hstep, voffA);
    if (wr == 1) PG8_BAR;
    PG8_WAIT_V(2); PG8_BAR;
    PG8_STAGE(PG8_SB(1, 0), cB + kstep, voffB); PG8_STAGE(PG8_SA(1, 0), cA + kstep, voffA); PG8_STAGE(PG8_SB(1, 1), cB + bhs + kstep, voffB);
    PG8_WAIT_V(6); PG8_BAR;
    for (;;) {
        const bool has_next = S.next(ui + 1, nxt);
        const char* nA = has_next ? (const char*)g.A + (size_t)nxt.pm * tstep : cA; const char* nB = has_next ? (const char*)g.Bt + (size_t)nxt.c0 * K * 2 : cB;
        for (int t = 0; t < nt; t += 2) {
            const bool last = (t == nt - 2);
            const char* a1 = cA + (size_t)(t + 1) * kstep;
            const char* a2 = last ? nA : cA + (size_t)(t + 2) * kstep; const char* b2 = last ? nB : cB + (size_t)(t + 2) * kstep;
            const char* a3 = a2 + kstep; const char* b3 = b2 + kstep;
            if (last && has_next) S.a_ready(nxt);
            PG8_LDB(B0, 0, 0); PG8_LDB(B1, 0, 1); PG8_SCHED; PG8_LDA(At, 0, 0); PG8_STAGE(PG8_SA(1, 1), a1 + hstep, voffA);
            PG8_WAIT_V(8); PG8_WAIT_L(0); PG8_BAR; PG8_MMA(0, 0, At, B0); if (!cur.half) PG8_MMA(0, 1, At, B1); PG8_BAR; PG8_SCHED;
            PG8_LDA(At, 0, 1); PG8_STAGE(PG8_SB(0, 0), b2, voffB); PG8_STAGE(PG8_SB(0, 1), b2 + bhs, voffB); PG8_STAGE(PG8_SA(0, 0), a2, voffA);
            PG8_WAIT_V(8); PG8_WAIT_L(0); PG8_BAR; PG8_MMA(1, 0, At, B0); if (!cur.half) PG8_MMA(1, 1, At, B1); PG8_BAR; PG8_SCHED;
            PG8_LDB(B0, 1, 0); PG8_LDB(B1, 1, 1); PG8_SCHED; PG8_LDA(At, 1, 0); PG8_STAGE(PG8_SA(0, 1), a2 + hstep, voffA);
            PG8_WAIT_V(8); PG8_WAIT_L(0); PG8_BAR; PG8_MMA(0, 0, At, B0); if (!cur.half) PG8_MMA(0, 1, At, B1); PG8_BAR; PG8_SCHED;
            PG8_LDA(At, 1, 1); PG8_STAGE(PG8_SB(1, 0), b3, voffB); PG8_STAGE(PG8_SB(1, 1), b3 + bhs, voffB); PG8_STAGE(PG8_SA(1, 0), a3, voffA);
            PG8_WAIT_V(8); PG8_WAIT_L(0); PG8_BAR; PG8_MMA(1, 0, At, B0); if (!cur.half) PG8_MMA(1, 1, At, B1); PG8_BAR; PG8_SCHED;
        }
        if constexpr (ALIGN_EPI) { if (wr == 0) PG8_BAR; }
        E(acc, cur, wr, wc, fr, fq); S.done(cur);
        if (!has_next) break;
#pragma unroll
        for (int a = 0; a < 2; ++a)
#pragma unroll
            for (int b = 0; b < 2; ++b)
#pragma unroll
                for (int m = 0; m < 4; ++m)
#pragma unroll
                    for (int n = 0; n < 2; ++n) acc[a][b][m][n] = (f32x4){0.f, 0.f, 0.f, 0.f};
        cur = nxt; cA = nA; cB = nB; ++ui;
        if constexpr (ALIGN_EPI) { if (wr == 1) PG8_BAR; }
    }
    PG8_WAIT_V(0);
    if constexpr (!ALIGN_EPI) { if (wr == 0) PG8_BAR; }
    PG8_BAR;
#undef PG8_SA
#undef PG8_SB
#undef PG8_STAGE
#undef PG8_LDA
#undef PG8_LDB
#undef PG8_MMA
#undef PG8_WAIT_V
#undef PG8_WAIT_L
#undef PG8_BAR
#undef PG8_SCHED
}
}

constexpr int NWAVES = 8, NTHREADS = 512;
constexpr int LDS_BYTES = 155648;
constexpr int LDSCTL_OFF = 154624;
#define LAS __attribute__((address_space(3)))
typedef unsigned v4u __attribute__((ext_vector_type(4)));
typedef float f32x4 __attribute__((ext_vector_type(4)));

struct Params {
    const float* x; const float* mem; const int* pos; const float* norm_g; const float* w_in; const float* q_norm_g; const float* k_norm_g; const float* sinks;
    const float* lam_re; const float* lam_im; const float* log_dt; const float* b_re; const float* b_im; const float* c_re; const float* c_im; const float* d_skip;
    const float* w_glu; const float* b_glu; const float* mem_norm_g; const float* w_mem_kv; const float* xq_norm_g; const float* xk_norm_g; const float* w_out;
    float* out; unsigned char* ws;
};

__device__ __forceinline__ void p0_transpose_item(const float* W, int K, int N, const float* scale, bf16_t* WT, LAS float* scr, int item, int lane) {
    const int nblk = N / 64, kb = item / nblk, nb = item % nblk, k0 = 64 * kb, n0 = 64 * nb;
    const int lr = lane >> 4, lc = (lane & 15) * 4;
#pragma unroll 4
    for (int i = 0; i < 16; ++i) { const int kk = 4 * i + lr; const float sc = scale ? scale[k0 + kk] : 1.f; const f32x4 v = *(const f32x4*)(W + (size_t)(k0 + kk) * N + n0 + lc);
        LAS float* d = scr + kk * 65 + lc; d[0] = v[0] * sc; d[1] = v[1] * sc; d[2] = v[2] * sc; d[3] = v[3] * sc; }
    asm volatile("s_waitcnt lgkmcnt(0)" ::: "memory");
    const int c = lane & 7;
#pragma unroll
    for (int j = 0; j < 8; ++j) { const int n = (lane >> 3) + 8 * j; const LAS float* s = scr + (8 * c) * 65 + n;
        v4u o; o.x = pg8::pk_f16(s[0 * 65], s[1 * 65]); o.y = pg8::pk_f16(s[2 * 65], s[3 * 65]); o.z = pg8::pk_f16(s[4 * 65], s[5 * 65]); o.w = pg8::pk_f16(s[6 * 65], s[7 * 65]);
        *(v4u*)(WT + (size_t)(n0 + n) * K + k0 + 8 * c) = o; }
    asm volatile("s_waitcnt lgkmcnt(0)" ::: "memory");
}
__device__ __forceinline__ void phase_prep(const Params& P, LAS unsigned char* lds, int vcu, int G) {
    int tid = threadIdx.x; asm volatile("" : "+v"(tid)); const int lane = tid & 63, wave = __builtin_amdgcn_readfirstlane(tid >> 6);
    LAS float* scr = (LAS float*)(lds + wave * 16640);
    const int gw = vcu * NWAVES + wave, NGW = G * NWAVES;
    unsigned char* ws = P.ws;
    constexpr int I_IN = (D_MODEL / 64) * (IN_W / 64), I_OUT = (MIX_W / 64) * (D_MODEL / 64), I_GLU = (SSM_W / 64) * (SSM_W / 64), I_MEM = (D_MODEL / 64) * (1024 / 64);
    constexpr int I_LAYER = I_IN + I_OUT + I_GLU + I_MEM;
    for (int it = gw; it < DEPTH * I_LAYER; it += NGW) {
        const int l = it / I_LAYER; int r = it % I_LAYER;
        if (r < I_IN) { p0_transpose_item(P.w_in + (size_t)l * D_MODEL * IN_W, D_MODEL, IN_W, P.norm_g + l * D_MODEL, (bf16_t*)(ws + WS_WIN) + (size_t)l * IN_W * D_MODEL, scr, r, lane); continue; } r -= I_IN;
        if (r < I_OUT) { p0_transpose_item(P.w_out + (size_t)l * MIX_W * D_MODEL, MIX_W, D_MODEL, nullptr, (bf16_t*)(ws + WS_WOUT) + (size_t)l * D_MODEL * MIX_W, scr, r, lane); continue; } r -= I_OUT;
        if (r < I_GLU) { p0_transpose_item(P.w_glu + (size_t)l * SSM_W * SSM_W, SSM_W, SSM_W, nullptr, (bf16_t*)(ws + WS_WGLU) + (size_t)l * SSM_W * SSM_W, scr, r, lane); continue; } r -= I_GLU;
        p0_transpose_item(P.w_mem_kv + (size_t)l * D_MODEL * 1024, D_MODEL, 1024, P.mem_norm_g + l * D_MODEL, (bf16_t*)(ws + WS_WMEM) + (size_t)l * 1024 * D_MODEL, scr, r, lane);
    }
    for (int m = gw; m < MTOK + BATCH * N_MEM; m += NGW) {
        const bool is_x = m < MTOK; const int row = is_x ? m : m - MTOK;
        const f32x4* xr = (const f32x4*)((is_x ? P.x : P.mem) + (size_t)row * D_MODEL) + lane;
        bf16_t* ob = (bf16_t*)(ws + (is_x ? WS_XB : WS_MEMB)) + (size_t)row * D_MODEL;
        f32x4 v[4]; float s = 0.f;
#pragma unroll
        for (int j = 0; j < 4; ++j) { v[j] = xr[64 * j]; s += (v[j][0] * v[j][0] + v[j][1] * v[j][1]) + (v[j][2] * v[j][2] + v[j][3] * v[j][3]); }
        s = wave_sum(s);
#pragma unroll
        for (int j = 0; j < 4; ++j) { pg8::u32x2 w; w.x = pg8::pk_f16(v[j][0], v[j][1]); w.y = pg8::pk_f16(v[j][2], v[j][3]); *((pg8::u32x2*)ob + lane + 64 * j) = w; }
        if (is_x) { if (lane < 16) ((float*)(ws + WS_SUMSQ))[(size_t)row * 16 + lane] = (lane == 0) ? s : 0.f; }
        else if (lane == 0) ((float*)(ws + WS_MISC))[row] = rsqrtf(s * (1.f / D_MODEL) + EPS);
    }
    { bf16_t* tab = (bf16_t*)(ws + WS_ROPE);
      for (int idx = vcu * NTHREADS + tid; idx < MTOK * 32; idx += G * NTHREADS) { const int tok = idx >> 5, i = idx & 31;
          const float inv = powf(10000.0f, -(float)i / 32.0f); const float ang = (float)P.pos[tok] * inv; const double a = (double)ang;
          tab[tok * 64 + i] = f2bf((float)cos(a)); tab[tok * 64 + 32 + i] = f2bf((float)sin(a)); } }
}


typedef _Float16 f16x8 __attribute__((ext_vector_type(8)));
typedef float f32x16 __attribute__((ext_vector_type(16)));
__device__ __forceinline__ int crow(int r, int hi) { return (r & 3) + 8 * (r >> 2) + 4 * hi; }
__device__ __forceinline__ float hf(_Float16 h) { return (float)h; }
constexpr float LOG2E = 1.4426950408889634f;
__device__ __forceinline__ f16x8 pack8(const f32x16& p, int s) { f16x8 r;
#pragma unroll
    for (int j = 0; j < 8; ++j) r[j] = (_Float16)p[8 * s + j];
    return r; }


__device__ __forceinline__ void stage_tile(LAS unsigned char* st, int pitchB, int colOff, const f32x16& o, int c, int hi) {
#pragma unroll
    for (int r = 0; r < 16; ++r) *(LAS _Float16*)(st + crow(r, hi) * pitchB + (colOff + c) * 2) = (_Float16)o[r];
}
__device__ __forceinline__ float silu_fast(float x) { return x * __builtin_amdgcn_rcpf(1.f + __expf(-x)); }
constexpr int ATT_KF = 0, ATT_VF = 32768, ATT_ST = 65536;
__device__ __forceinline__ int opaque_tid() { int t = threadIdx.x; asm volatile("" : "+v"(t)); return t; }
__device__ __forceinline__ void attn_a_item(const Params& P, int layer, LAS unsigned char* lds, int item) {
    const int tid = opaque_tid(), lane = tid & 63, wave = __builtin_amdgcn_readfirstlane(tid >> 6);
    const int kvh = item & 1, blk = (item >> 1) & 31, b = item >> 6;
    const bf16_t* Z = (const bf16_t*)(P.ws + WS_Z); bf16_t* MIX = (bf16_t*)(P.ws + WS_MIX); const bf16_t* rope = (const bf16_t*)(P.ws + WS_ROPE);
    const float* kg = P.k_norm_g + layer * HD; const float* qg = P.q_norm_g + layer * HD;
    {
        const int key = tid >> 1, hh = tid & 1, tpos = blk * 128 - 128 + key; const bool valid = tpos >= 0;
        const int tok = b * SEQ + (valid ? tpos : 0);
        const bf16_t* zr = Z + (size_t)tok * IN_W;
        f16x8 x1[2], x2[2]; float ss = 0.f;
#pragma unroll
        for (int i = 0; i < 2; ++i) { const int c = 2 * hh + i; x1[i] = *(const f16x8*)(zr + ZK + kvh * HD + 8 * c); x2[i] = *(const f16x8*)(zr + ZK + kvh * HD + 32 + 8 * c);
#pragma unroll
            for (int j = 0; j < 8; ++j) { const float a = hf(x1[i][j]), c2 = hf(x2[i][j]); ss += a * a + c2 * c2; } }
        ss += __shfl_xor(ss, 1);
        const float rs = rsqrtf(ss * (1.f / HD) + EPS);
        const int kt = key >> 5, kl = key & 31;
#pragma unroll
        for (int i = 0; i < 2; ++i) { const int c = 2 * hh + i; f16x8 o1, o2;
#pragma unroll
            for (int j = 0; j < 8; ++j) { const int d = 8 * c + j; const float cs = bf2f(rope[(size_t)tok * 64 + d]), sn = bf2f(rope[(size_t)tok * 64 + 32 + d]);
                const float a = hf(x1[i][j]) * rs * kg[d], bb = hf(x2[i][j]) * rs * kg[32 + d];
                o1[j] = valid ? (_Float16)(a * cs - bb * sn) : (_Float16)0.f; o2[j] = valid ? (_Float16)(bb * cs + a * sn) : (_Float16)0.f; }
            { const int cc = c;     *(LAS f16x8*)(lds + ATT_KF + (((kt * 4 + (cc >> 1)) * 64) + kl + 32 * (cc & 1)) * 16) = o1; }
            { const int cc = c + 4; *(LAS f16x8*)(lds + ATT_KF + (((kt * 4 + (cc >> 1)) * 64) + kl + 32 * (cc & 1)) * 16) = o2; } }
        const int sK = kl >> 4, h2 = ((kl & 15) >> 2) & 1, jj = 4 * ((kl & 15) >> 3) + (kl & 3);
        LAS unsigned short* vb = (LAS unsigned short*)(lds + ATT_VF + ((((kt * 2 + hh) * 2 + sK) * 64) + 32 * h2) * 16 + 2 * jj);
#pragma unroll
        for (int i = 0; i < 4; ++i) { const v4u v = *(const v4u*)(zr + ZV + kvh * HD + 32 * hh + 8 * i);
#pragma unroll
            for (int j = 0; j < 8; ++j) { const unsigned wv = v[j >> 1]; vb[(8 * i + j) * 8] = valid ? (unsigned short)((j & 1) ? (wv >> 16) : (wv & 0xffffu)) : (unsigned short)0; } }
    }
    const int ql = lane & 31, hi = lane >> 5;
    f16x8 qfu[2][4];
#pragma unroll
    for (int ui = 0; ui < 2; ++ui) {
        const int head = 2 * (wave >> 2) + ui, w = wave & 3, hq = kvh * 4 + head;
        const int tq = b * SEQ + blk * 128 + 32 * w + ql;
        const bf16_t* zq = Z + (size_t)tq * IN_W + ZQ + hq * HD;
        f16x8 xq[4]; float ss = 0.f;
#pragma unroll
        for (int d0 = 0; d0 < 4; ++d0) { xq[d0] = *(const f16x8*)(zq + 16 * d0 + 8 * hi);
#pragma unroll
            for (int j = 0; j < 8; ++j) { const float a = hf(xq[d0][j]); ss += a * a; } }
        ss += __shfl_xor(ss, 32);
        const float rs = rsqrtf(ss * (1.f / HD) + EPS) * (0.125f * LOG2E);
#pragma unroll
        for (int d0 = 0; d0 < 2; ++d0)
#pragma unroll
            for (int j = 0; j < 8; ++j) { const int d = 16 * d0 + 8 * hi + j; const float cs = bf2f(rope[(size_t)tq * 64 + d]), sn = bf2f(rope[(size_t)tq * 64 + 32 + d]);
                const float a = hf(xq[d0][j]) * qg[d], bb = hf(xq[d0 + 2][j]) * qg[32 + d];
                qfu[ui][d0][j] = (_Float16)((a * cs - bb * sn) * rs); qfu[ui][d0 + 2][j] = (_Float16)((bb * cs + a * sn) * rs); }
    }
    __syncthreads();
#pragma unroll
    for (int ui = 0; ui < 2; ++ui) {
        const int head = 2 * (wave >> 2) + ui, w = wave & 3, hq = kvh * 4 + head;
        const f16x8* qf = qfu[ui];
        const int erow = lane >> 1, ehs = lane & 1; const size_t etok = (size_t)b * SEQ + blk * 128 + 32 * w + erow; const int ecol = hq * HD + 32 * ehs;
        v4u gv[4];
#pragma unroll
        for (int i = 0; i < 4; ++i) gv[i] = *(const v4u*)(Z + etok * IN_W + ZG + ecol + 8 * i);
        f32x16 p[5];
#pragma unroll
        for (int t = 0; t < 5; ++t) { const int kt = w + t; f32x16 acc = {};
#pragma unroll
            for (int d0 = 0; d0 < 4; ++d0) { const f16x8 kf = *(const LAS f16x8*)(lds + ATT_KF + ((kt * 4 + d0) * 64 + lane) * 16);
                acc = __builtin_amdgcn_mfma_f32_32x32x16_f16(kf, qf[d0], acc, 0, 0, 0); }
            p[t] = acc; }
        float mx = -INFINITY;
        int qlv = ql; asm volatile("" : "+v"(qlv));
#pragma unroll
        for (int t = 0; t < 5; ++t) { const bool tile_off = (blk == 0) && (w + t < 4);
#pragma unroll
            for (int r = 0; r < 16; ++r) { bool ok = !tile_off; if (t == 0) ok = ok && (crow(r, hi) > qlv); if (t == 4) ok = ok && (crow(r, hi) <= qlv);
                const float v = ok ? p[t][r] : -INFINITY; p[t][r] = v; mx = fmaxf(mx, v); } }
        mx = fmaxf(mx, __shfl_xor(mx, 32));
        const float sink2 = P.sinks[layer * NQH + hq] * LOG2E;
        mx = fmaxf(mx, sink2);
        float l = 0.f;
#pragma unroll
        for (int t = 0; t < 5; ++t)
#pragma unroll
            for (int r = 0; r < 16; ++r) { const float e = __builtin_amdgcn_exp2f(p[t][r] - mx); p[t][r] = e; l += e; }
        l += __shfl_xor(l, 32);
        l += __builtin_amdgcn_exp2f(sink2 - mx);
        const float linv = __builtin_amdgcn_rcpf(l);
        f32x16 o[2] = {};
#pragma unroll
        for (int t = 0; t < 5; ++t) { const int kt = w + t;
#pragma unroll
            for (int s2 = 0; s2 < 2; ++s2) { const f16x8 pa = pack8(p[t], s2);
#pragma unroll
                for (int db = 0; db < 2; ++db) { const f16x8 vf = *(const LAS f16x8*)(lds + ATT_VF + (((kt * 2 + db) * 2 + s2) * 64 + lane) * 16);
                    o[db] = __builtin_amdgcn_mfma_f32_32x32x16_f16(pa, vf, o[db], 0, 0, 0); } } }
        { LAS unsigned char* st = lds + ATT_ST + wave * 4608;
          stage_tile(st, 144, 0, o[0], ql, hi); stage_tile(st, 144, 32, o[1], ql, hi);
          const float li = __shfl(linv, erow);
#pragma unroll
          for (int i = 0; i < 4; ++i) { const v4u ov = *(const LAS v4u*)(st + erow * 144 + ehs * 64 + 16 * i); v4u w4;
#pragma unroll
              for (int j = 0; j < 4; ++j) w4[j] = pg8::pk_f16(pg8::h_lo(ov[j]) * li * silu_fast(pg8::h_lo(gv[i][j])), pg8::h_hi(ov[j]) * li * silu_fast(pg8::h_hi(gv[i][j])));
              *(v4u*)(MIX + etok * MIX_W + ecol + 8 * i) = w4; } }
    }
    __syncthreads();
}
__device__ __forceinline__ void phase_attn_a(const Params& P, int layer, LAS unsigned char* lds, int vcu, int G, int bx, bool defer) {
    if (defer) {
        if (bx < 128) attn_a_item(P, layer, lds, bx);
        else for (int j = 0; j < 3; ++j) attn_a_item(P, layer, lds, 128 + 3 * (bx - 128) + j);
        return; }
    for (int it = vcu; it < BATCH * 32 * NKVH; it += G) attn_a_item(P, layer, lds, it);
}

__device__ __forceinline__ void attn_c_item(const Params& P, int layer, LAS unsigned char* lds, int item) {
    const int tid = opaque_tid(), lane = tid & 63, wave = __builtin_amdgcn_readfirstlane(tid >> 6);
    const int sblk = item & 7, h = (item >> 3) & 3, b = item >> 5;
    const bf16_t* Z = (const bf16_t*)(P.ws + WS_Z); bf16_t* MIX = (bf16_t*)(P.ws + WS_MIX);
    const f16x8* KFg = (const f16x8*)(P.ws + WS_MK) + (size_t)((layer * BATCH + b) * XH + h) * (8 * 8 * 64);
    const f16x8* VFg = (const f16x8*)(P.ws + WS_MV) + (size_t)((layer * BATCH + b) * XH + h) * (8 * 4 * 2 * 64);
    const float* xqg = P.xq_norm_g + layer * XHD;
#pragma unroll
    for (int i = 0; i < 16; ++i) { const int f = wave * 16 + i; const f16x8* src = (f < 64 ? KFg + f * 64 : VFg + (f - 64) * 64) + lane;
        __builtin_amdgcn_global_load_lds((const unsigned*)src, (LAS unsigned*)(lds + f * 1024), 16, 0, 0); }
    asm volatile("s_waitcnt vmcnt(0)" ::: "memory");
    __syncthreads();
    const int ql = lane & 31, hi = lane >> 5;
    for (int ui = 0; ui < 2; ++ui) {
        const int qbase = b * SEQ + sblk * 512 + (wave * 2 + ui) * 32;
        const bf16_t* zq = Z + (size_t)(qbase + ql) * IN_W + ZXQ + h * XHD;
        f16x8 qf[8]; float ss = 0.f;
#pragma unroll
        for (int d0 = 0; d0 < 8; ++d0) { qf[d0] = *(const f16x8*)(zq + 16 * d0 + 8 * hi);
#pragma unroll
            for (int j = 0; j < 8; ++j) { const float a = hf(qf[d0][j]); ss += a * a; } }
        ss += __shfl_xor(ss, 32);
        const float rs = rsqrtf(ss * (1.f / XHD) + EPS) * (0.08838834764831845f * LOG2E);
#pragma unroll
        for (int d0 = 0; d0 < 8; ++d0)
#pragma unroll
            for (int j = 0; j < 8; ++j) qf[d0][j] = (_Float16)(hf(qf[d0][j]) * rs * xqg[16 * d0 + 8 * hi + j]);
        f16x8 pa[2][4][2]; float mh[2], lh[2];
#pragma unroll
        for (int hf2 = 0; hf2 < 2; ++hf2) {
            f32x16 p[4];
#pragma unroll
            for (int t = 0; t < 4; ++t) { const int kt = 4 * hf2 + t; f32x16 acc = {};
#pragma unroll
                for (int d0 = 0; d0 < 8; ++d0) acc = __builtin_amdgcn_mfma_f32_32x32x16_f16(*(const LAS f16x8*)(lds + ((kt * 8 + d0) * 64 + lane) * 16), qf[d0], acc, 0, 0, 0);
                p[t] = acc; asm volatile("" ::: "memory"); }
            float mx = -INFINITY;
#pragma unroll
            for (int t = 0; t < 4; ++t)
#pragma unroll
                for (int r = 0; r < 16; ++r) mx = fmaxf(mx, p[t][r]);
            mx = fmaxf(mx, __shfl_xor(mx, 32));
            float l = 0.f;
#pragma unroll
            for (int t = 0; t < 4; ++t) {
#pragma unroll
                for (int r = 0; r < 16; ++r) { const float e = __builtin_amdgcn_exp2f(p[t][r] - mx); p[t][r] = e; l += e; }
                pa[hf2][t][0] = pack8(p[t], 0); pa[hf2][t][1] = pack8(p[t], 1); }
            l += __shfl_xor(l, 32);
            mh[hf2] = mx; lh[hf2] = l;
        }
        const float mm = fmaxf(mh[0], mh[1]); const float e0 = __builtin_amdgcn_exp2f(mh[0] - mm), e1 = __builtin_amdgcn_exp2f(mh[1] - mm);
        const float linv = __builtin_amdgcn_rcpf(lh[0] * e0 + lh[1] * e1); const float f0 = e0 * linv, f1 = e1 * linv;
#pragma unroll
        for (int db = 0; db < 4; ++db) { f32x16 o0 = {}, o1 = {};
#pragma unroll
            for (int t = 0; t < 4; ++t) {
#pragma unroll
                for (int s2 = 0; s2 < 2; ++s2) { o0 = __builtin_amdgcn_mfma_f32_32x32x16_f16(pa[0][t][s2], *(const LAS f16x8*)(lds + 65536 + (((t * 4 + db) * 2 + s2) * 64 + lane) * 16), o0, 0, 0, 0);
                    o1 = __builtin_amdgcn_mfma_f32_32x32x16_f16(pa[1][t][s2], *(const LAS f16x8*)(lds + 65536 + ((((4 + t) * 4 + db) * 2 + s2) * 64 + lane) * 16), o1, 0, 0, 0); }
                asm volatile("" ::: "memory"); }
            { LAS unsigned char* st = lds + 131072 + wave * 2560; const int erow = lane >> 1, ehs = lane & 1;
              const size_t tok = (size_t)qbase + erow; const int col = h * XHD + 32 * db + 16 * ehs;
              const v4u ga = *(const v4u*)(Z + tok * IN_W + ZXG + col), gb = *(const v4u*)(Z + tok * IN_W + ZXG + col + 8);
              const float g0 = __shfl(f0, erow), g1 = __shfl(f1, erow);
              stage_tile(st, 80, 0, o0, ql, hi);
              const v4u a0 = *(const LAS v4u*)(st + erow * 80 + ehs * 32), a1 = *(const LAS v4u*)(st + erow * 80 + ehs * 32 + 16);
              asm volatile("" ::: "memory");
              stage_tile(st, 80, 0, o1, ql, hi);
              const v4u b0 = *(const LAS v4u*)(st + erow * 80 + ehs * 32), b1 = *(const LAS v4u*)(st + erow * 80 + ehs * 32 + 16);
              v4u w0, w1;
#pragma unroll
              for (int j = 0; j < 4; ++j) {
                  w0[j] = pg8::pk_f16((pg8::h_lo(a0[j]) * g0 + pg8::h_lo(b0[j]) * g1) * silu_fast(pg8::h_lo(ga[j])), (pg8::h_hi(a0[j]) * g0 + pg8::h_hi(b0[j]) * g1) * silu_fast(pg8::h_hi(ga[j])));
                  w1[j] = pg8::pk_f16((pg8::h_lo(a1[j]) * g0 + pg8::h_lo(b1[j]) * g1) * silu_fast(pg8::h_lo(gb[j])), (pg8::h_hi(a1[j]) * g0 + pg8::h_hi(b1[j]) * g1) * silu_fast(pg8::h_hi(gb[j]))); }
              *(v4u*)(MIX + tok * MIX_W + 1024 + col) = w0; *(v4u*)(MIX + tok * MIX_W + 1024 + col + 8) = w1; }
            asm volatile("" ::: "memory"); }
    }
    __syncthreads();
}
__device__ __forceinline__ void phase_attn_c(const Params& P, int layer, LAS unsigned char* lds, int vcu, int G) {
    for (int it = vcu; it < BATCH * XH * 8; it += G) attn_c_item(P, layer, lds, it);
}
__device__ __forceinline__ void phase_memfin(const Params& P, int vcu, int G) {
    const int tid = opaque_tid(), lane = tid & 63, wave = __builtin_amdgcn_readfirstlane(tid >> 6);
    const float* mkv = (const float*)(P.ws + WS_Y2);
    for (int it = vcu * NWAVES + wave; it < DEPTH * BATCH * N_MEM; it += G * NWAVES) {
        const int l = it / (BATCH * N_MEM), row = it % (BATCH * N_MEM), b = row / N_MEM, key = row % N_MEM;
        const float* r = mkv + (size_t)row * (DEPTH * 1024) + l * 1024; const float* xkg = P.xk_norm_g + l * XHD;
        const int kt = key >> 5, kl = key & 31, sK = kl >> 4, h2 = ((kl & 15) >> 2) & 1, jj = 4 * ((kl & 15) >> 3) + (kl & 3);
        for (int h = 0; h < XH; ++h) {
            bf16_t* KF = (bf16_t*)(P.ws + WS_MK) + (size_t)((l * BATCH + b) * XH + h) * (8 * 8 * 64 * 8);
            bf16_t* VF = (bf16_t*)(P.ws + WS_MV) + (size_t)((l * BATCH + b) * XH + h) * (8 * 4 * 2 * 64 * 8);
            float v[2]; v[0] = r[h * XHD + lane]; v[1] = r[h * XHD + 64 + lane];
            const float s = wave_sum(v[0] * v[0] + v[1] * v[1]); const float rs = rsqrtf(s * (1.f / XHD) + EPS);
#pragma unroll
            for (int e = 0; e < 2; ++e) { const int d = lane + 64 * e;
                KF[(size_t)((kt * 8 + (d >> 4)) * 64 + kl + 32 * ((d >> 3) & 1)) * 8 + (d & 7)] = f2bf(v[e] * rs * xkg[d]);
                VF[(size_t)(((kt * 4 + (d >> 5)) * 2 + sK) * 64 + (d & 31) + 32 * h2) * 8 + jj] = f2bf(r[512 + h * XHD + d]); }
        }
    }
}


constexpr size_t SSMC_WE = 0, SSMC_WC = 64 * 1024, SSMC_KJ = 128 * 1024, SSMC_STRIDE = 144 * 1024;
constexpr size_t WS_A16 = WS_MISC + 128 * 1024;
__device__ __forceinline__ void ssm_consts_item(const Params& P, LAS unsigned char* lds, int item) {
    const int tid = opaque_tid(); const int l = item / SSM_G, g = item % SSM_G;
    LAS float* apw = (LAS float*)lds;
    LAS float* bbar = apw + 17 * 64 * 2;
    LAS float* kj = bbar + 64 * 16 * 2;
    LAS float* cre = kj + 16 * 256; LAS float* cim = cre + 16 * 64;
    { const float* c_re_g = P.c_re + (size_t)(l * SSM_G + g) * SSM_CH * SSM_P; const float* c_im_g = P.c_im + (size_t)(l * SSM_G + g) * SSM_CH * SSM_P;
      for (int i = tid; i < 16 * 64; i += NTHREADS) { cre[i] = c_re_g[i]; cim[i] = c_im_g[i]; } }
    const LAS float* c_re = cre; const LAS float* c_im = cim;
    const double dt = exp((double)P.log_dt[l * SSM_G + g]);
    for (int i = tid; i < 17 * 64; i += NTHREADS) { const int j = i / 64, p = i % 64; const int gp = (l * SSM_G + g) * SSM_P + p;
        const double lr = P.lam_re[gp], li = P.lam_im[gp]; const double mag = exp(lr * dt * j); double sn, cs; sincos(li * dt * j, &sn, &cs);
        apw[i * 2] = (float)(mag * cs); apw[i * 2 + 1] = (float)(mag * sn); }
    for (int i = tid; i < 64 * 16; i += NTHREADS) { const int p = i / 16, c = i % 16; const int gp = (l * SSM_G + g) * SSM_P + p;
        const double lr = P.lam_re[gp], li = P.lam_im[gp]; const double mag = exp(lr * dt), ar = mag * cos(li * dt), ai = mag * sin(li * dt), den = lr * lr + li * li;
        const double fr = ((ar - 1.0) * lr + ai * li) / den, fi = (ai * lr - (ar - 1.0) * li) / den;
        const double br = P.b_re[(size_t)gp * SSM_CH + c], bi = P.b_im[(size_t)gp * SSM_CH + c];
        bbar[i * 2] = (float)(fr * br - fi * bi); bbar[i * 2 + 1] = (float)(fr * bi + fi * br); }
    __syncthreads();
    for (int i = tid; i < 16 * 256; i += NTHREADS) { const int j = i >> 8, co = (i >> 4) & 15, ci = i & 15; float acc = 0.f;
        for (int p = 0; p < 64; ++p) { const float er = apw[(j * 64 + p) * 2], ei = apw[(j * 64 + p) * 2 + 1], br = bbar[(p * 16 + ci) * 2], bi = bbar[(p * 16 + ci) * 2 + 1];
            const float wr = er * br - ei * bi, wi = er * bi + ei * br; acc += c_re[co * SSM_P + p] * wr - c_im[co * SSM_P + p] * wi; }
        if (j == 0 && co == ci) acc += P.d_skip[l * SSM_W + g * SSM_CH + co];
        kj[i] = acc; }
    __syncthreads();
    unsigned char* base = P.ws + WS_SSMP + (size_t)item * SSMC_STRIDE;
    bf16_t* WE = (bf16_t*)(base + SSMC_WE); bf16_t* WC = (bf16_t*)(base + SSMC_WC); bf16_t* KJ = (bf16_t*)(base + SSMC_KJ);
    for (int i = tid; i < 64 * 512; i += NTHREADS) { const int f = i >> 9, e = i & 511, ln = e >> 3, j = e & 7, mt = f >> 4, sx = f & 15, r = ln & 31, hh = ln >> 5;
        const int R = 32 * mt + r, p = R >> 1, ri = R & 1, ci = 8 * hh + j; const float er = apw[((15 - sx) * 64 + p) * 2], ei = apw[((15 - sx) * 64 + p) * 2 + 1], br = bbar[(p * 16 + ci) * 2], bi = bbar[(p * 16 + ci) * 2 + 1];
        WE[i] = f2bf(ri ? (er * bi + ei * br) : (er * br - ei * bi)); }
    for (int i = tid; i < 9216 / 2; i += NTHREADS) KJ[i] = (i < 16 * 256) ? f2bf(kj[i]) : (bf16_t)0;
    for (int i = tid; i < 64 * 512; i += NTHREADS) { const int f = i >> 9, e = i & 511, ln = e >> 3, j = e & 7, mt = f >> 3, kc = f & 7, r = ln & 31, hh = ln >> 5;
        const int t = 2 * mt + (r >> 4), co = r & 15, p = 8 * kc + 4 * hh + (j >> 1), ri = j & 1; const float er = apw[((t + 1) * 64 + p) * 2], ei = apw[((t + 1) * 64 + p) * 2 + 1];
        const float cr = c_re[co * SSM_P + p], cim = c_im[co * SSM_P + p]; WC[i] = f2bf(ri ? -(cr * ei + cim * er) : (cr * er - cim * ei)); }
    if (tid < 64) { float* a16 = (float*)(P.ws + WS_A16) + (size_t)(item * 64 + tid) * 4; a16[0] = apw[(16 * 64 + tid) * 2]; a16[1] = apw[(16 * 64 + tid) * 2 + 1];
        const int gp = (l * SSM_G + g) * SSM_P + tid; const double lr = P.lam_re[gp], li = P.lam_im[gp]; const double mag = exp(lr * dt * 512.0); double sn, cs; sincos(li * dt * 512.0, &sn, &cs);
        a16[2] = (float)(mag * cs); a16[3] = (float)(mag * sn); }
    __syncthreads();
}
__device__ __forceinline__ void phase_ssm_consts(const Params& P, LAS unsigned char* lds, int vcu, int G) {
    for (int it = vcu; it < DEPTH * SSM_G; it += G) ssm_consts_item(P, lds, it);
}
__device__ __forceinline__ float gelu_tanh_fast(float x) {
    const float u = 0.7978845608028654f * (x + 0.044715f * x * x * x); return x * __builtin_amdgcn_rcpf(1.f + __expf(-2.f * u)); }

constexpr int SSM_EH = 0, SSM_EHP = 272, SSM_WX = 69632, SSM_KJ = SSM_WX + 65536, SSM_CHS = SSM_KJ + 9216;
static_assert(SSM_CHS + 4096 <= LDSCTL_OFF, "ssm lds map");
__device__ __forceinline__ void ssm_item(const Params& P, int layer, LAS unsigned char* lds, int item) {
    const int tid = opaque_tid(), lane = tid & 63, wave = __builtin_amdgcn_readfirstlane(tid >> 6);
    const int g = item >> 3, b = item & 7;
    const bf16_t* Z = (const bf16_t*)(P.ws + WS_Z); bf16_t* Y2 = (bf16_t*)(P.ws + WS_Y2);
    const unsigned char* cbase = P.ws + WS_SSMP + (size_t)(layer * SSM_G + g) * SSMC_STRIDE;
    const int nl = lane & 31, hh = lane >> 5;
    typedef float f32x2v __attribute__((ext_vector_type(2)));
#pragma unroll
    for (int i = 0; i < 8; ++i) { const int f = wave * 8 + i;
        __builtin_amdgcn_global_load_lds((const unsigned*)(cbase + SSMC_WE + f * 1024 + lane * 16), (LAS unsigned*)(lds + SSM_WX + f * 1024), 16, 0, 0); }
    __builtin_amdgcn_global_load_lds((const unsigned*)(cbase + SSMC_KJ + wave * 1024 + lane * 16), (LAS unsigned*)(lds + SSM_KJ + wave * 1024), 16, 0, 0);
    if (wave == 0) __builtin_amdgcn_global_load_lds((const unsigned*)(cbase + SSMC_KJ + 8192 + lane * 16), (LAS unsigned*)(lds + SSM_KJ + 8192), 16, 0, 0);
    const int n = 32 * wave + nl;
    const bf16_t* up = Z + (size_t)(b * SEQ + 16 * n) * IN_W + ZU + g * SSM_CH + 8 * hh;
    f16x8 uf[16];
#pragma unroll
    for (int sx = 0; sx < 16; ++sx) uf[sx] = *(const f16x8*)(up + (size_t)sx * IN_W);
    const float* a16p = (const float*)(P.ws + WS_A16) + (size_t)((layer * SSM_G + g) * 64 + lane) * 4;
    const float a16r = a16p[0], a16i = a16p[1], a5r = a16p[2], a5i = a16p[3];
    asm volatile("s_waitcnt vmcnt(0)" ::: "memory");
    __syncthreads();
    {
        f32x16 ae[4] = {};
#pragma unroll
        for (int sx = 0; sx < 16; ++sx) {
#pragma unroll
            for (int mt = 0; mt < 4; ++mt) ae[mt] = __builtin_amdgcn_mfma_f32_32x32x16_f16(*(const LAS f16x8*)(lds + SSM_WX + ((mt * 16 + sx) * 64 + lane) * 16), uf[sx], ae[mt], 0, 0, 0);
            if ((sx & 1) == 1) asm volatile("" ::: "memory"); }
#pragma unroll
        for (int mt = 0; mt < 4; ++mt)
#pragma unroll
            for (int r = 0; r < 16; r += 2) { const int p = 16 * mt + (crow(r, hh) >> 1);
                *(LAS unsigned*)(lds + SSM_EH + n * SSM_EHP + 4 * p) = pg8::pk_f16(ae[mt][r], ae[mt][r + 1]); }
    }
    __syncthreads();
#pragma unroll
    for (int i = 0; i < 8; ++i) { const int f = wave * 8 + i;
        __builtin_amdgcn_global_load_lds((const unsigned*)(cbase + SSMC_WC + f * 1024 + lane * 16), (LAS unsigned*)(lds + SSM_WX + f * 1024), 16, 0, 0); }
    {
        LAS unsigned char* eh = lds + SSM_EH + (32 * wave) * SSM_EHP + 4 * lane;
        float sr = 0.f, si = 0.f;
#pragma unroll 8
        for (int k = 0; k < 32; ++k) { const unsigned ev = *(const LAS unsigned*)(eh + k * SSM_EHP); const float er = pg8::h_lo(ev), ei = pg8::h_hi(ev);
            const float nr = a16r * sr - a16i * si + er, ni = a16r * si + a16i * sr + ei; sr = nr; si = ni; }
        LAS f32x2v* chs = (LAS f32x2v*)(lds + SSM_CHS);
        chs[wave * 64 + lane] = (f32x2v){sr, si};
        __syncthreads();
        float cr = 0.f, ci = 0.f;
        for (int v = 0; v < wave; ++v) { const f32x2v sv = chs[v * 64 + lane]; const float nr = a5r * cr - a5i * ci + sv.x, ni = a5r * ci + a5i * cr + sv.y; cr = nr; ci = ni; }
        sr = cr; si = ci;
#pragma unroll 8
        for (int k = 0; k < 32; ++k) { const unsigned ev = *(const LAS unsigned*)(eh + k * SSM_EHP); const float er = pg8::h_lo(ev), ei = pg8::h_hi(ev);
            *(LAS unsigned*)(eh + k * SSM_EHP) = pg8::pk_f16(sr, si);
            const float nr = a16r * sr - a16i * si + er, ni = a16r * si + a16i * sr + ei; sr = nr; si = ni; }
    }
    asm volatile("s_waitcnt vmcnt(0)" ::: "memory");
    __syncthreads();
    const int rhi = nl >> 4, co = nl & 15;
    const LAS unsigned char* kjl = lds + SSM_KJ + co * 32 + hh * 16;
#pragma unroll
    for (int mh = 0; mh < 2; ++mh) {
        f32x16 ay[4] = {};
#pragma unroll
        for (int sx = 0; sx < 16; ++sx) {
#pragma unroll
            for (int i = 0; i < 4; ++i) { const int mt = 4 * mh + i; const int lag0 = 2 * mt - sx;
                if (lag0 + 1 >= 0) { const int lag = lag0 + rhi; const int row = (lag0 >= 0) ? lag : (rhi ? 0 : 16);
                    ay[i] = __builtin_amdgcn_mfma_f32_32x32x16_f16(*(const LAS f16x8*)(kjl + row * 512), uf[sx], ay[i], 0, 0, 0); } }
            if ((sx & 1) == 1) asm volatile("" ::: "memory"); }
#pragma unroll
        for (int kc = 0; kc < 8; ++kc) { const f16x8 hfr = *(const LAS f16x8*)(lds + SSM_EH + n * SSM_EHP + 32 * kc + 16 * hh);
#pragma unroll
            for (int i = 0; i < 4; ++i) { const int mt = 4 * mh + i;
                ay[i] = __builtin_amdgcn_mfma_f32_32x32x16_f16(*(const LAS f16x8*)(lds + SSM_WX + ((mt * 8 + kc) * 64 + lane) * 16), hfr, ay[i], 0, 0, 0); }
            if ((kc & 1) == 1) asm volatile("" ::: "memory"); }
#pragma unroll
        for (int i = 0; i < 4; ++i) { const int mt = 4 * mh + i;
#pragma unroll
            for (int q = 0; q < 4; ++q) { const int t = 2 * mt + (q >> 1), co0 = 8 * (q & 1) + 4 * hh;
                pg8::u32x2 w; w.x = pg8::pk_f16(gelu_tanh_fast(ay[i][4 * q]), gelu_tanh_fast(ay[i][4 * q + 1])); w.y = pg8::pk_f16(gelu_tanh_fast(ay[i][4 * q + 2]), gelu_tanh_fast(ay[i][4 * q + 3]));
                *(pg8::u32x2*)(Y2 + (size_t)(b * SEQ + 16 * n + t) * SSM_W + g * SSM_CH + co0) = w; } }
    }
    __syncthreads();
}
__device__ __forceinline__ void phase_ssm(const Params& P, int layer, LAS unsigned char* lds, int vcu, int G) {
    for (int it = vcu; it < SSM_G * BATCH; it += G) ssm_item(P, layer, lds, it);
}


#define XB_TMO      128
#define XB_XCNT(j)  (256  + 64 * (j))
#define XB_XSUB(j)  (1280 + 64 * (j))
#define XB_XGEN(j)  (2304 + 64 * (j))
#define XB_TOP      3328
#define XB_TOPGEN   3392
#define XCD_BAR_WORDS 3456
#define XB_SPIN_CAP (1u << 18)
__device__ __forceinline__ unsigned xb_ld(unsigned* p)              { return __hip_atomic_load(p, __ATOMIC_RELAXED, __HIP_MEMORY_SCOPE_AGENT); }
__device__ __forceinline__ unsigned xb_add(unsigned* p, unsigned v) { return __hip_atomic_fetch_add(p, v, __ATOMIC_RELAXED, __HIP_MEMORY_SCOPE_AGENT); }
__device__ __forceinline__ unsigned xb_xcc_id() { return (unsigned)__builtin_amdgcn_s_getreg((3 << 11) | 20) & 0xFu; }
#define XB_SPIN(cond, bar) do { unsigned _sp = 0; while (cond) { __builtin_amdgcn_s_sleep(1); \
    if ((++_sp & 255u) == 0u) { if (xb_ld(&(bar)[XB_TMO])) break; if (_sp > XB_SPIN_CAP) { atomicAdd(&(bar)[XB_TMO], 1u); break; } } } } while (0)
struct XcdBarrier { unsigned* bar; unsigned x; volatile LAS unsigned* st; };
__device__ __forceinline__ XcdBarrier xcd_barrier_post(unsigned* bar, volatile LAS unsigned* st) {
    XcdBarrier b; b.bar = bar; b.x = xb_xcc_id(); b.st = st;
    if (threadIdx.x == 0) (void)xb_add(&bar[XB_XCNT(b.x)], 1u);
    return b;
}
__device__ __forceinline__ void xcd_barrier_complete(unsigned* bar, unsigned x, unsigned& nloc, unsigned& nx) {
    const unsigned G = gridDim.x * gridDim.y * gridDim.z;
    unsigned sum, cnt, mine, sp = 0u;
    for (;;) {
        sum = 0u; cnt = 0u; mine = 0u;
#pragma unroll
        for (unsigned j = 0; j < 16; ++j) { const unsigned c = xb_ld(&bar[XB_XCNT(j)]); sum += c; cnt += (c > 0u) ? 1u : 0u; mine = (j == x) ? c : mine; }
        if (sum == G) break;
        __builtin_amdgcn_s_sleep(1);
        if ((++sp & 255u) == 0u) { if (xb_ld(&bar[XB_TMO])) break; if (sp > XB_SPIN_CAP) { atomicAdd(&bar[XB_TMO], 1u); break; } }
    }
    nloc = mine > 0u ? mine : 1u; nx = cnt > 0u ? cnt : 1u;
}
__device__ __forceinline__ void xcd_barrier(const XcdBarrier& b) {
    asm volatile("s_waitcnt vmcnt(0)" ::: "memory");
    __syncthreads();
    if (threadIdx.x == 0) {
        unsigned* bar = b.bar;
        __builtin_amdgcn_s_waitcnt(0);
        unsigned nloc = b.st[0], nx = b.st[1];
        if (nloc == 0u) { xcd_barrier_complete(bar, b.x, nloc, nx); b.st[0] = nloc; b.st[1] = nx; }
        const unsigned old = xb_add(&bar[XB_XSUB(b.x)], 1u);
        const unsigned gen = old / nloc;
        if (old + 1u == (gen + 1u) * nloc) {
            __builtin_amdgcn_fence(__ATOMIC_RELEASE, "agent");
            asm volatile("s_waitcnt vmcnt(0)" ::: "memory");
            const unsigned og = xb_add(&bar[XB_TOP], 1u);
            const unsigned tg = og / nx;
            if (og + 1u == (tg + 1u) * nx) xb_add(&bar[XB_TOPGEN], 1u);
            else XB_SPIN(xb_ld(&bar[XB_TOPGEN]) == tg, bar);
            __builtin_amdgcn_fence(__ATOMIC_ACQUIRE, "agent");
            xb_add(&bar[XB_XGEN(b.x)], 1u);
            asm volatile("s_waitcnt vmcnt(0)" ::: "memory");
        } else {
            XB_SPIN(xb_ld(&bar[XB_XGEN(b.x)]) == gen, bar);
            __builtin_amdgcn_fence(__ATOMIC_ACQUIRE, "agent");
            asm volatile("s_waitcnt vmcnt(0)" ::: "memory");
        }
    }
    __syncthreads();
}
constexpr size_t WS_CTL = WS_MISC + 512 * 1024;
constexpr int CTL_BYTES = 16384;

constexpr int DEFER_TILE = 8;
__device__ __forceinline__ bool defer_mode(int layer, int G) { return layer > 0 && G == 256; }
__device__ __forceinline__ void run_inproj(const Params& P, int layer, LAS unsigned char* lds, int G, int bx) {
    unsigned char* ws = P.ws;
    pg8::Gemm g{(const bf16_t*)(ws + WS_XB), (const bf16_t*)(ws + WS_WIN) + (size_t)layer * IN_W * D_MODEL, MTOK, IN_W, D_MODEL};
    pg8::EpiZ E{(bf16_t*)(ws + WS_Z), (const float*)(ws + WS_SUMSQ)};
    if (defer_mode(layer, G)) { pg8::SkipOrder S; S.init2(g.M, g.N, G, bx, DEFER_TILE); pg8::gemm_phase<pg8::EpiZ, pg8::SkipOrder, true>(lds, g, S, E); }
    else { pg8::StaticOrder S; S.init(g.M, g.N, G, bx); pg8::gemm_phase<pg8::EpiZ, pg8::StaticOrder, true>(lds, g, S, E); }
}
__device__ __forceinline__ void run_inproj_tail(const Params& P, int layer, LAS unsigned char* lds, int G, int bx) {
    if (!defer_mode(layer, G)) return;
    unsigned char* ws = P.ws;
    pg8::Gemm g{(const bf16_t*)(ws + WS_XB), (const bf16_t*)(ws + WS_WIN) + (size_t)layer * IN_W * D_MODEL, MTOK, IN_W, D_MODEL};
    pg8::EpiZ E{(bf16_t*)(ws + WS_Z), (const float*)(ws + WS_SUMSQ)};
    pg8::DeferOrder S; S.init(g.M, G, bx, DEFER_TILE); pg8::gemm_phase<pg8::EpiZ, pg8::DeferOrder, true>(lds, g, S, E);
}
__device__ __forceinline__ void run_glu(const Params& P, int layer, LAS unsigned char* lds, int G, int bx) {
    unsigned char* ws = P.ws;
    pg8::Gemm g{(const bf16_t*)(ws + WS_Y2), (const bf16_t*)(ws + WS_WGLU) + (size_t)layer * SSM_W * SSM_W, MTOK, SSM_W, SSM_W}; pg8::StaticOrder S; S.init(g.M, g.N, G, bx);
    pg8::EpiGlu E{(const bf16_t*)(ws + WS_Y2), (const bf16_t*)(ws + WS_Z), P.b_glu + layer * SSM_W, (bf16_t*)(ws + WS_MIX)};
    pg8::gemm_phase<pg8::EpiGlu, pg8::StaticOrder, true>(lds, g, S, E);
}
__device__ __forceinline__ void run_outproj(const Params& P, int layer, LAS unsigned char* lds, int G, int bx) {
    unsigned char* ws = P.ws;
    pg8::Gemm g{(const bf16_t*)(ws + WS_MIX), (const bf16_t*)(ws + WS_WOUT) + (size_t)layer * D_MODEL * MIX_W, MTOK, D_MODEL, MIX_W}; pg8::StaticOrder S; S.init(g.M, g.N, G, bx);
    if (layer == 0) { pg8::EpiOut<0> E{P.x, P.out, (bf16_t*)(ws + WS_XB), (float*)(ws + WS_SUMSQ)}; pg8::gemm_phase<pg8::EpiOut<0>, pg8::StaticOrder, true>(lds, g, S, E); }
    else if (layer + 1 < DEPTH) { pg8::EpiOut<1> E{P.x, P.out, (bf16_t*)(ws + WS_XB), (float*)(ws + WS_SUMSQ)}; pg8::gemm_phase<pg8::EpiOut<1>, pg8::StaticOrder, true>(lds, g, S, E); }
    else { pg8::EpiOut<2> E{P.x, P.out, (bf16_t*)(ws + WS_XB), (float*)(ws + WS_SUMSQ)}; pg8::gemm_phase<pg8::EpiOut<2>, pg8::StaticOrder, true>(lds, g, S, E); }
}
__device__ __forceinline__ void run_memgemm(const Params& P, LAS unsigned char* lds, int G, int bx) {
    unsigned char* ws = P.ws;
    pg8::Gemm g{(const bf16_t*)(ws + WS_MEMB), (const bf16_t*)(ws + WS_WMEM), BATCH * N_MEM, DEPTH * 1024, D_MODEL}; pg8::MemTailOrder S; S.init(g.M, g.N, G, bx, ((MTOK / 256) * (IN_W / 256)) % G);
    pg8::EpiMemF32 E{(float*)(ws + WS_Y2), DEPTH * 1024, (const float*)(ws + WS_MISC)};
    pg8::gemm_phase<pg8::EpiMemF32, pg8::MemTailOrder, true>(lds, g, S, E);
}


template <class T> __device__ __forceinline__ T* as_global(unsigned long long v) { return (T*)(__attribute__((address_space(1))) T*)v; }
__device__ __forceinline__ Params load_params() {
    typedef const volatile unsigned long long __attribute__((address_space(4)))* kp_t;
    kp_t kp = (kp_t)__builtin_amdgcn_kernarg_segment_ptr();
    Params q;
    q.x = as_global<const float>(kp[0]); q.mem = as_global<const float>(kp[1]); q.pos = as_global<const int>(kp[2]); q.norm_g = as_global<const float>(kp[3]);
    q.w_in = as_global<const float>(kp[4]); q.q_norm_g = as_global<const float>(kp[5]); q.k_norm_g = as_global<const float>(kp[6]); q.sinks = as_global<const float>(kp[7]);
    q.lam_re = as_global<const float>(kp[8]); q.lam_im = as_global<const float>(kp[9]); q.log_dt = as_global<const float>(kp[10]); q.b_re = as_global<const float>(kp[11]);
    q.b_im = as_global<const float>(kp[12]); q.c_re = as_global<const float>(kp[13]); q.c_im = as_global<const float>(kp[14]); q.d_skip = as_global<const float>(kp[15]);
    q.w_glu = as_global<const float>(kp[16]); q.b_glu = as_global<const float>(kp[17]); q.mem_norm_g = as_global<const float>(kp[18]); q.w_mem_kv = as_global<const float>(kp[19]);
    q.xq_norm_g = as_global<const float>(kp[20]); q.xk_norm_g = as_global<const float>(kp[21]); q.w_out = as_global<const float>(kp[22]);
    q.out = as_global<float>(kp[23]); q.ws = as_global<unsigned char>(kp[24]);
    return q;
}
static_assert(sizeof(Params) == 25 * 8, "Params is 25 pointers");
__global__ void __launch_bounds__(NTHREADS, 2) k_mega(Params Parg) {
    extern __shared__ __attribute__((aligned(16))) unsigned char lds_raw[];
    LAS unsigned char* lds = (LAS unsigned char*)lds_raw;
    const int G = gridDim.x, bx = blockIdx.x; const int vcu = (G % 8 == 0) ? (bx % 8) * (G / 8) + bx / 8 : bx;
    for (int u = threadIdx.x; u < (LDS_BYTES - LDSCTL_OFF) / 4; u += NTHREADS) ((LAS unsigned*)(lds + LDSCTL_OFF))[u] = 0u;
    __syncthreads();
    (void)xcd_barrier_post((unsigned*)(Parg.ws + WS_CTL), (volatile LAS unsigned*)(lds + LDSCTL_OFF));
#define GRID_BARRIER() do { XcdBarrier bar_; { const Params Pb = load_params(); bar_.bar = (unsigned*)(Pb.ws + WS_CTL); } unsigned xq_ = xb_xcc_id(); asm volatile("" : "+s"(xq_)); bar_.x = xq_; bar_.st = (volatile LAS unsigned*)(lds + LDSCTL_OFF); xcd_barrier(bar_); } while (0)
    { const Params P = load_params(); phase_prep(P, lds, vcu, G); } __syncthreads();
    { const Params P = load_params(); phase_ssm_consts(P, lds, vcu, G); }
    GRID_BARRIER();
    { const Params P = load_params(); run_inproj(P, 0, lds, G, bx); }
    { const Params P = load_params(); run_memgemm(P, lds, G, bx); }
    GRID_BARRIER();
    { const Params P = load_params(); phase_memfin(P, vcu, G); }
    GRID_BARRIER();
#pragma unroll 1
    for (int layer = 0; layer < DEPTH; ++layer) {
        { const Params P = load_params(); run_inproj_tail(P, layer, lds, G, bx); }
        { const Params P = load_params(); phase_attn_a(P, layer, lds, vcu, G, bx, defer_mode(layer, G)); }
        { const Params P = load_params(); phase_attn_c(P, layer, lds, vcu, G); }
        { const Params P = load_params(); phase_ssm(P, layer, lds, vcu, G); }
        GRID_BARRIER();
        { const Params P = load_params(); run_glu(P, layer, lds, G, bx); }
        GRID_BARRIER();
        { const Params P = load_params(); run_outproj(P, layer, lds, G, bx); }
        if (layer + 1 < DEPTH) { GRID_BARRIER(); { const Params P = load_params(); run_inproj(P, layer + 1, lds, G, bx); } GRID_BARRIER(); }
    }
}

extern "C" void kernel_launch(void* const* d_in, const int* in_sizes, int n_in, void* d_out, int out_size, void* d_ws, size_t ws_size, hipStream_t stream) {
    if (ws_size < WS_END || n_in != 23) return;
    Params P{};
    P.x = (const float*)d_in[0]; P.mem = (const float*)d_in[1]; P.pos = (const int*)d_in[2]; P.norm_g = (const float*)d_in[3]; P.w_in = (const float*)d_in[4];
    P.q_norm_g = (const float*)d_in[5]; P.k_norm_g = (const float*)d_in[6]; P.sinks = (const float*)d_in[7]; P.lam_re = (const float*)d_in[8]; P.lam_im = (const float*)d_in[9];
    P.log_dt = (const float*)d_in[10]; P.b_re = (const float*)d_in[11]; P.b_im = (const float*)d_in[12]; P.c_re = (const float*)d_in[13]; P.c_im = (const float*)d_in[14];
    P.d_skip = (const float*)d_in[15]; P.w_glu = (const float*)d_in[16]; P.b_glu = (const float*)d_in[17]; P.mem_norm_g = (const float*)d_in[18]; P.w_mem_kv = (const float*)d_in[19];
    P.xq_norm_g = (const float*)d_in[20]; P.xk_norm_g = (const float*)d_in[21]; P.w_out = (const float*)d_in[22];
    P.out = (float*)d_out; P.ws = (unsigned char*)d_ws;
    static int coop_grid = 0;
    if (coop_grid == 0) {
        int dev = 0, cus = 0, per_cu = 0; hipGetDevice(&dev); hipDeviceGetAttribute(&cus, hipDeviceAttributeMultiprocessorCount, dev);
        (void)hipFuncSetAttribute((const void*)k_mega, hipFuncAttributeMaxDynamicSharedMemorySize, LDS_BYTES);
        if (hipOccupancyMaxActiveBlocksPerMultiprocessor(&per_cu, (const void*)k_mega, NTHREADS, LDS_BYTES) != hipSuccess || per_cu < 1) { fprintf(stderr, "kernel_launch: occupancy query says %d blocks/CU\n", per_cu); (void)hipGetLastError(); per_cu = 1; }
        if (per_cu > 1) per_cu = 1;
        coop_grid = (cus > 0 ? cus : 256) * per_cu;
    }
    (void)hipMemsetAsync((char*)d_ws + WS_CTL, 0, CTL_BYTES, stream);
    { void* args[] = {(void*)&P}; hipError_t e = hipLaunchCooperativeKernel((const void*)k_mega, dim3(coop_grid), dim3(NTHREADS), args, LDS_BYTES, stream);
      if (e != hipSuccess) fprintf(stderr, "cooperative launch failed: %s (grid %d)\n", hipGetErrorString(e), coop_grid); }
}
```

```cpp
#include <hip/hip_runtime.h>
#include <cstdio>
#include <stdint.h>
#include <math.h>

constexpr int D_MODEL = 1024, BATCH = 8, SEQ = 4096, DEPTH = 4, MTOK = BATCH * SEQ;
constexpr int HD = 64, NQH = 8, NKVH = 2, WINDOW = 128;
constexpr int SSM_CH = 16, SSM_G = 32, SSM_P = 64, SSM_W = 512, N_MEM = 256, XH = 4, XHD = 128;
constexpr int MIX_W = 1536, IN_W = 3328;
constexpr int ZQ = 0, ZK = 512, ZV = 640, ZG = 768, ZU = 1280, ZSG = 1792, ZXQ = 2304, ZXG = 2816;
constexpr float EPS = 1e-6f;

typedef unsigned short bf16_t;
__device__ __forceinline__ bf16_t f2bf(float f) { _Float16 h = (_Float16)f; return __builtin_bit_cast(unsigned short, h); }
__device__ __forceinline__ float bf2f(bf16_t h) { return (float)__builtin_bit_cast(_Float16, h); }
__device__ __forceinline__ float sigmoidf_(float x) { return __builtin_amdgcn_rcpf(1.f + __expf(-x)); }
__device__ __forceinline__ float siluf_(float x) { return x * sigmoidf_(x); }
__device__ __forceinline__ float gelu_tanh(float x) { const float c = 0.7978845608028654f; float u = c * (x + 0.044715f * x * x * x); return 0.5f * x * (1.f + tanhf(u)); }
__device__ __forceinline__ float wave_sum(float v) {
#pragma unroll
    for (int o = 1; o < 64; o <<= 1) v += __shfl_xor(v, o);
    return v;
}

constexpr size_t MiB = 1u << 20;
constexpr size_t WS_Z = 0;
constexpr size_t WS_MIX = 208 * MiB;
constexpr size_t WS_XB = 304 * MiB;
constexpr size_t WS_Y2 = 368 * MiB;
constexpr size_t WS_WIN = 400 * MiB;
constexpr size_t WS_WOUT = 426 * MiB;
constexpr size_t WS_WGLU = 438 * MiB;
constexpr size_t WS_WMEM = 440 * MiB;
constexpr size_t WS_MEMB = 448 * MiB;
constexpr size_t WS_MK = 452 * MiB;
constexpr size_t WS_MV = 460 * MiB;
constexpr size_t WS_ROPE = 468 * MiB;
constexpr size_t WS_SSMP = 476 * MiB;
constexpr size_t WS_SUMSQ = 508 * MiB;
constexpr size_t WS_MISC = 510 * MiB;
constexpr size_t WS_END = 511 * MiB;


namespace pg8 {
#define PG8_LAS __attribute__((address_space(3)))
typedef _Float16 f16x8 __attribute__((ext_vector_type(8)));
typedef _Float16 f16x2 __attribute__((ext_vector_type(2)));
typedef float f32x4 __attribute__((ext_vector_type(4)));
typedef unsigned u32x4 __attribute__((ext_vector_type(4)));
typedef unsigned u32x2 __attribute__((ext_vector_type(2)));
constexpr int BM = 256, BK = 64, HALF = 128, HTB = HALF * BK * 2, STAGE_BYTES = 8 * HTB, NXCD = 8, WGM = 8;
__host__ __device__ __forceinline__ int lds_byte(int r, int c) { const int st = (r >> 4) * 2 + (c >> 5), rr = r & 15, cc = c & 31, ob = rr * 64 + cc * 2; return st * 1024 + (ob ^ (((ob >> 9) & 1) << 5)); }
__host__ __device__ __forceinline__ void stage_rc(int b, int& R, int& C) { const int st = b / 1024, sb = b % 1024, swz = sb ^ (((sb >> 9) & 1) << 5); R = (st >> 1) * 16 + swz / 64; C = (st & 1) * 32 + (swz % 64) / 2; }
__host__ __device__ __forceinline__ int perm32(int rho) { const int n = rho >> 4, i = rho & 15; return 8 * (i >> 2) + 4 * n + (i & 3); }
struct Unit { int pm, pn, c0, half; };
struct Gemm { const bf16_t* A; const bf16_t* Bt; int M, N, K; };
struct StaticOrder {
    int nM, nN, nwg, G, c;
    __host__ __device__ void init(int M, int N, int G_, int c_) { nM = M / BM; nN = N / BM; nwg = nM * nN; G = G_; c = c_; }
    __host__ __device__ bool next(int i, Unit& u) const {
        const long L = (long)i * G + c; if (L >= nwg) return false;
        int wgid = (int)L; { const int q = nwg / NXCD, r = nwg % NXCD, xcd = wgid % NXCD, off = wgid / NXCD; wgid = (xcd < r ? xcd * (q + 1) : r * (q + 1) + (xcd - r) * q) + off; }
        const int nig = WGM * nN, gid = wgid / nig, fm = gid * WGM, gsz = (nM - fm) < WGM ? (nM - fm) : WGM;
        u.pm = fm + ((wgid % nig) % gsz); u.pn = (wgid % nig) / gsz; u.c0 = u.pn * BM; u.half = 0; return true;
    }
    __device__ __forceinline__ void a_ready(const Unit&) const {}
    __device__ __forceinline__ void done(const Unit&) const {}
};
struct TailOrder : StaticOrder {
    __host__ __device__ bool next(int i, Unit& u) const {
        const int full = nwg / G, left = nwg - full * G;
        if (i < full || 2 * left > G) return StaticOrder::next(i, u);
        if (i > full || c >= 2 * left) return false;
        StaticOrder t = *this; t.c = c >> 1;
        (void)t.StaticOrder::next(full, u);
        u.c0 += 128 * (c & 1); u.half = 1; return true;
    }
};
struct SkipOrder : StaticOrder {
    int skip;
    __host__ __device__ void init2(int M, int N, int G_, int c_, int skip_) { init(M, N - BM, G_, c_); skip = skip_; }
    __host__ __device__ bool next(int i, Unit& u) const { if (!StaticOrder::next(i, u)) return false; if (u.pn >= skip) { u.pn += 1; u.c0 = u.pn * BM; } return true; }
};
struct DeferOrder {
    int nM, pn, G, c;
    __host__ __device__ void init(int M, int G_, int c_, int pn_) { nM = M / BM; G = G_; c = c_; pn = pn_; }
    __host__ __device__ bool next(int i, Unit& u) const { const int L = i * G + c; if (L >= nM) return false; u.pm = L; u.pn = pn; u.c0 = pn * BM; u.half = 0; return true; }
    __device__ __forceinline__ void a_ready(const Unit&) const {}
    __device__ __forceinline__ void done(const Unit&) const {}
};
struct MemTailOrder {
    int k, stride, nM, nwg;
    __host__ __device__ void init(int M, int N, int G, int c, int first) { nM = M / BM; nwg = nM * (N / BM); k = c - first; stride = G - first; }
    __host__ __device__ bool next(int i, Unit& u) const {
        if (k < 0) return false;
        const int L = i * stride + k; if (L >= nwg) return false;
        u.pm = L % nM; u.pn = L / nM; u.c0 = u.pn * BM; u.half = 0; return true;
    }
    __device__ __forceinline__ void a_ready(const Unit&) const {}
    __device__ __forceinline__ void done(const Unit&) const {}
};
__device__ __forceinline__ unsigned pk_f16(float lo, float hi) { f16x2 v = {(_Float16)lo, (_Float16)hi}; return __builtin_bit_cast(unsigned, v); }
__device__ __forceinline__ float h_lo(unsigned w) { return (float)__builtin_bit_cast(_Float16, (unsigned short)(w & 0xffffu)); }
__device__ __forceinline__ float h_hi(unsigned w) { return (float)__builtin_bit_cast(_Float16, (unsigned short)(w >> 16)); }

struct EpiZ {
    static constexpr bool PERM = true, AFTER_DRAIN = false;
    bf16_t* Z; const float* sumsq; const bf16_t* rope; const float* qg; const float* kg;
    __device__ __forceinline__ void operator()(const f32x4 (&acc)[2][2][4][2], const Unit& u, int wr, int wc, int fr, int fq) const {
        const int row0 = u.pm * BM + wr * 64 + fr, cw = u.c0 + wc * 64, col0 = cw + 8 * fq;
        const bool is_q = cw < ZK, is_k = (cw >= ZK) && (cw < ZV), is_gate = (cw >= ZG && cw < ZU) || (cw >= ZSG && cw < ZXQ) || (cw >= ZXG);
        f32x4 g0a = {1.f, 1.f, 1.f, 1.f}, g0b = g0a, g1a = g0a, g1b = g0a; float qs = 1.f;
        if (is_q || is_k) { const float* g = is_q ? qg : kg; g0a = *(const f32x4*)(g + 8 * fq); g0b = *(const f32x4*)(g + 8 * fq + 4); g1a = *(const f32x4*)(g + 32 + 8 * fq); g1b = *(const f32x4*)(g + 36 + 8 * fq);
            if (is_q) qs = 0.125f * 1.4426950408889634f; }
#pragma unroll
        for (int ai = 0; ai < 2; ++ai)
#pragma unroll
            for (int m = 0; m < 4; ++m) { const int r = row0 + ai * HALF + m * 16;
                const f32x4* sp = (const f32x4*)(sumsq + (size_t)r * 16); const f32x4 s0 = sp[0], s1 = sp[1], s2 = sp[2], s3 = sp[3];
                const float ss = ((s0[0] + s0[1]) + (s0[2] + s0[3])) + ((s1[0] + s1[1]) + (s1[2] + s1[3])) + ((s2[0] + s2[1]) + (s2[2] + s2[3])) + ((s3[0] + s3[1]) + (s3[2] + s3[3]));
                const float rs = rsqrtf(ss * (1.f / D_MODEL) + EPS);
                f32x4 a0 = acc[ai][0][m][0] * rs, a1 = acc[ai][0][m][1] * rs, b0 = acc[ai][1][m][0] * rs, b1 = acc[ai][1][m][1] * rs;
                if (is_q || is_k) {
                    float hs = ((a0[0] * a0[0] + a0[1] * a0[1]) + (a0[2] * a0[2] + a0[3] * a0[3])) + ((a1[0] * a1[0] + a1[1] * a1[1]) + (a1[2] * a1[2] + a1[3] * a1[3]))
                             + ((b0[0] * b0[0] + b0[1] * b0[1]) + (b0[2] * b0[2] + b0[3] * b0[3])) + ((b1[0] * b1[0] + b1[1] * b1[1]) + (b1[2] * b1[2] + b1[3] * b1[3]));
                    hs += __shfl_xor(hs, 16); hs += __shfl_xor(hs, 32);
                    const float rn = rsqrtf(hs * (1.f / HD) + EPS);
                    const u32x4 cv = *(const u32x4*)(rope + (size_t)r * 64 + 8 * fq), sv = *(const u32x4*)(rope + (size_t)r * 64 + 32 + 8 * fq);
                    a0 = a0 * g0a * rn; a1 = a1 * g0b * rn; b0 = b0 * g1a * rn; b1 = b1 * g1b * rn;
                    const f32x4 c0 = {h_lo(cv.x), h_hi(cv.x), h_lo(cv.y), h_hi(cv.y)}, c1 = {h_lo(cv.z), h_hi(cv.z), h_lo(cv.w), h_hi(cv.w)};
                    const f32x4 n0 = {h_lo(sv.x), h_hi(sv.x), h_lo(sv.y), h_hi(sv.y)}, n1 = {h_lo(sv.z), h_hi(sv.z), h_lo(sv.w), h_hi(sv.w)};
                    const f32x4 ra0 = (a0 * c0 - b0 * n0) * qs, ra1 = (a1 * c1 - b1 * n1) * qs, rb0 = (b0 * c0 + a0 * n0) * qs, rb1 = (b1 * c1 + a1 * n1) * qs;
                    a0 = ra0; a1 = ra1; b0 = rb0; b1 = rb1;
                } else if (is_gate) {
#pragma unroll
                    for (int j = 0; j < 4; ++j) { a0[j] = a0[j] * sigmoidf_(a0[j]); a1[j] = a1[j] * sigmoidf_(a1[j]); b0[j] = b0[j] * sigmoidf_(b0[j]); b1[j] = b1[j] * sigmoidf_(b1[j]); }
                }
                bf16_t* rowp = Z + (size_t)r * IN_W + col0;
                u32x4 w; w.x = pk_f16(a0[0], a0[1]); w.y = pk_f16(a0[2], a0[3]); w.z = pk_f16(a1[0], a1[1]); w.w = pk_f16(a1[2], a1[3]); *(u32x4*)(rowp) = w;
                w.x = pk_f16(b0[0], b0[1]); w.y = pk_f16(b0[2], b0[3]); w.z = pk_f16(b1[0], b1[1]); w.w = pk_f16(b1[2], b1[3]); *(u32x4*)(rowp + 32) = w; }
    }
};
struct EpiGlu {
    static constexpr bool PERM = true, AFTER_DRAIN = false;
    const bf16_t* Y2; const bf16_t* Z; const float* bg; bf16_t* MIX;
    __device__ __forceinline__ void operator()(const f32x4 (&acc)[2][2][4][2], const Unit& u, int wr, int wc, int fr, int fq) const {
        const int row0 = u.pm * BM + wr * 64 + fr, col0 = u.c0 + wc * 64 + 8 * fq;
#pragma unroll
        for (int bj = 0; bj < 2; ++bj) { const int c = col0 + bj * 32;
            const f32x4 b0 = *(const f32x4*)(bg + c), b1 = *(const f32x4*)(bg + c + 4);
#pragma unroll
            for (int ai = 0; ai < 2; ++ai)
#pragma unroll
                for (int m = 0; m < 4; ++m) { const int r = row0 + ai * HALF + m * 16;
                    const u32x4 yv = *(const u32x4*)(Y2 + (size_t)r * SSM_W + c), sv = *(const u32x4*)(Z + (size_t)r * IN_W + ZSG + c);
                    const f32x4 a0 = acc[ai][bj][m][0] + b0, a1 = acc[ai][bj][m][1] + b1;
                    float o[8];
#pragma unroll
                    for (int j = 0; j < 4; ++j) { const unsigned yw = yv[j], sw = sv[j];
                        const float g0 = (j < 2) ? a0[2 * j] : a1[2 * j - 4], g1 = (j < 2) ? a0[2 * j + 1] : a1[2 * j - 3];
                        o[2 * j] = h_lo(yw) * sigmoidf_(g0) * h_lo(sw); o[2 * j + 1] = h_hi(yw) * sigmoidf_(g1) * h_hi(sw); }
                    u32x4 w; w.x = pk_f16(o[0], o[1]); w.y = pk_f16(o[2], o[3]); w.z = pk_f16(o[4], o[5]); w.w = pk_f16(o[6], o[7]);
                    *(u32x4*)(MIX + (size_t)r * MIX_W + 512 + c) = w; } }
    }
};
template <int MODE> struct EpiOut {
    static constexpr bool PERM = true, AFTER_DRAIN = false;
    const float* xin; float* xout; bf16_t* XB; float* sumsq;
    __device__ __forceinline__ void operator()(const f32x4 (&acc)[2][2][4][2], const Unit& u, int wr, int wc, int fr, int fq) const {
        const int row0 = u.pm * BM + wr * 64 + fr, col0 = u.c0 + wc * 64 + 8 * fq;
#pragma unroll
        for (int ai = 0; ai < 2; ++ai)
#pragma unroll
            for (int m = 0; m < 4; ++m) { const int r = row0 + ai * HALF + m * 16; const size_t off = (size_t)r * D_MODEL + col0; float ss = 0.f;
#pragma unroll
                for (int bj = 0; bj < 2; ++bj) { f32x4 x0, x1;
                    if (MODE == 0) { x0 = *(const f32x4*)(xin + off + bj * 32); x1 = *(const f32x4*)(xin + off + bj * 32 + 4); }
                    else { const u32x4 xv = *(const u32x4*)(XB + off + bj * 32); x0 = (f32x4){h_lo(xv.x), h_hi(xv.x), h_lo(xv.y), h_hi(xv.y)}; x1 = (f32x4){h_lo(xv.z), h_hi(xv.z), h_lo(xv.w), h_hi(xv.w)}; }
                    const f32x4 o0 = x0 + acc[ai][bj][m][0], o1 = x1 + acc[ai][bj][m][1];
                    if (MODE == 2) { *(f32x4*)(xout + off + bj * 32) = o0; *(f32x4*)(xout + off + bj * 32 + 4) = o1; }
                    else { u32x4 w; w.x = pk_f16(o0[0], o0[1]); w.y = pk_f16(o0[2], o0[3]); w.z = pk_f16(o1[0], o1[1]); w.w = pk_f16(o1[2], o1[3]); *(u32x4*)(XB + off + bj * 32) = w;
                        ss += ((o0[0] * o0[0] + o0[1] * o0[1]) + (o0[2] * o0[2] + o0[3] * o0[3])) + ((o1[0] * o1[0] + o1[1] * o1[1]) + (o1[2] * o1[2] + o1[3] * o1[3])); } }
                if (MODE != 2) { ss += __shfl_xor(ss, 16); ss += __shfl_xor(ss, 32);
                    if (fq == 0) sumsq[(size_t)r * 16 + (u.c0 >> 8) * 4 + wc] = ss; } }
    }
};
struct EpiMemF32 {
    static constexpr bool PERM = false, AFTER_DRAIN = false;
    float* C; int ldc; const float* rstd;
    __device__ __forceinline__ void operator()(const f32x4 (&acc)[2][2][4][2], const Unit& u, int wr, int wc, int fr, int fq) const {
        const int row0 = u.pm * BM + wr * 64 + fr, col0 = u.c0 + wc * 32 + 4 * fq;
#pragma unroll
        for (int ai = 0; ai < 2; ++ai)
#pragma unroll
            for (int m = 0; m < 4; ++m) { const int r = row0 + ai * HALF + m * 16; const float rs = rstd[r]; float* rowp = C + (size_t)r * ldc + col0;
#pragma unroll
                for (int bj = 0; bj < 2; ++bj)
#pragma unroll
                    for (int n = 0; n < 2; ++n) *(f32x4*)(rowp + bj * HALF + n * 16) = acc[ai][bj][m][n] * rs; }
    }
};

template <class Epi, class Sched, bool ALIGN_EPI>
__device__ __forceinline__ void gemm_phase(PG8_LAS unsigned char* lds, const Gemm g, const Sched& S, const Epi& E) {
    int tid = threadIdx.x; asm volatile("" : "+v"(tid)); const int wid = __builtin_amdgcn_readfirstlane(tid >> 6), lane = tid & 63, wr = wid >> 2, wc = wid & 3, fr = lane & 15, fq = lane >> 4;
    const int K = g.K, nt = K / BK;
    unsigned voffA[2], voffB[2];
#pragma unroll
    for (int i = 0; i < 2; ++i) { int R, C; stage_rc(tid * 16 + i * 8192, R, C); const int Rb = Epi::PERM ? (64 * (R >> 5) + perm32(R & 31)) : R;
        voffA[i] = (unsigned)(R * K + C) * 2u; voffB[i] = (unsigned)(Rb * K + C) * 2u; }
    const size_t kstep = (size_t)(BK * 2);
    const size_t hstep = (size_t)HALF * K * 2;
    const size_t tstep = 2 * hstep;
    const size_t bhs = Epi::PERM ? (size_t)32 * K * 2 : hstep;
    const unsigned ldsw = (unsigned)wid * 1024u;
    const int aoff = lds_byte(wr * 64 + fr, fq * 8), boff = lds_byte(wc * 32 + fr, fq * 8);
#define PG8_SA(b, h) (((b) * 2 + (h)) * HTB)
#define PG8_SB(b, h) ((4 + (b) * 2 + (h)) * HTB)
#define PG8_STAGE(bufoff, gbase, voff) do { _Pragma("unroll") for (int _i = 0; _i < 2; ++_i) \
        __builtin_amdgcn_global_load_lds((const unsigned*)((const char*)(gbase) + (voff)[_i]), (PG8_LAS unsigned*)(lds + (bufoff) + ldsw + _i * 8192), 16, 0, 0); } while (0)
#define PG8_LDA(dst, b, h) do { _Pragma("unroll") for (int m = 0; m < 4; ++m) _Pragma("unroll") for (int k = 0; k < 2; ++k) dst[m][k] = *(const PG8_LAS f16x8*)(lds + PG8_SA(b, h) + aoff + m * 2048 + k * 1024); } while (0)
#define PG8_LDB(dst, b, h) do { _Pragma("unroll") for (int n = 0; n < 2; ++n) _Pragma("unroll") for (int k = 0; k < 2; ++k) dst[n][k] = *(const PG8_LAS f16x8*)(lds + PG8_SB(b, h) + boff + n * 2048 + k * 1024); } while (0)
#define PG8_MMA(ai, bj, At, Bt) do { __builtin_amdgcn_s_setprio(1); _Pragma("unroll") for (int m = 0; m < 4; ++m) _Pragma("unroll") for (int n = 0; n < 2; ++n) _Pragma("unroll") for (int k = 0; k < 2; ++k) \
        acc[ai][bj][m][n] = __builtin_amdgcn_mfma_f32_16x16x32_f16(Bt[n][k], At[m][k], acc[ai][bj][m][n], 0, 0, 0); __builtin_amdgcn_s_setprio(0); } while (0)
#define PG8_WAIT_V(n) asm volatile("s_waitcnt vmcnt(" #n ")" ::: "memory")
#define PG8_WAIT_L(n) asm volatile("s_waitcnt lgkmcnt(" #n ")" ::: "memory")
#define PG8_BAR __builtin_amdgcn_s_barrier()
#define PG8_SCHED __builtin_amdgcn_sched_barrier(0)
    Unit cur, nxt; int ui = 0;
    if (!S.next(0, cur)) return;
    f32x4 acc[2][2][4][2];
#pragma unroll
    for (int a = 0; a < 2; ++a)
#pragma unroll
        for (int b = 0; b < 2; ++b)
#pragma unroll
            for (int m = 0; m < 4; ++m)
#pragma unroll
                for (int n = 0; n < 2; ++n) acc[a][b][m][n] = (f32x4){0.f, 0.f, 0.f, 0.f};
    f16x8 At[4][2], B0[2][2], B1[2][2];
    const char* cA = (const char*)g.A + (size_t)cur.pm * tstep; const char* cB = (const char*)g.Bt + (size_t)cur.c0 * K * 2;
    S.a_ready(cur);
    PG8_STAGE(PG8_SB(0, 0), cB, voffB); PG8_STAGE(PG8_SB(0, 1), cB + bhs, voffB); PG8_STAGE(PG8_SA(0, 0), cA, voffA); PG8_STAGE(PG8_SA(0, 1), cA + hstep, voffA);
    if (wr == 1) PG8_BAR;
    PG8_WAIT_V(2); PG8_BAR;
    PG8_STAGE(PG8_SB(1, 0), cB + kstep, voffB); PG8_STAGE(PG8_SA(1, 0), cA + kstep, voffA); PG8_STAGE(PG8_SB(1, 1), cB + bhs + kstep, voffB);
    PG8_WAIT_V(6); PG8_BAR;
    for (;;) {
        const bool has_next = S.next(ui + 1, nxt);
        const char* nA = has_next ? (const char*)g.A + (size_t)nxt.pm * tstep : cA; const char* nB = has_next ? (const char*)g.Bt + (size_t)nxt.c0 * K * 2 : cB;
        for (int t = 0; t < nt; t += 2) {
            const bool last = (t == nt - 2);
            const char* a1 = cA + (size_t)(t + 1) * kstep;
            const char* a2 = last ? nA : cA + (size_t)(t + 2) * kstep; const char* b2 = last ? nB : cB + (size_t)(t + 2) * kstep;
            const char* a3 = a2 + kstep; const char* b3 = b2 + kstep;
            if (last && has_next) S.a_ready(nxt);
            PG8_LDB(B0, 0, 0); PG8_LDB(B1, 0, 1); PG8_SCHED; PG8_LDA(At, 0, 0); PG8_STAGE(PG8_SA(1, 1), a1 + hstep, voffA);
            PG8_WAIT_V(8); PG8_WAIT_L(0); PG8_BAR; PG8_MMA(0, 0, At, B0); if (!cur.half) PG8_MMA(0, 1, At, B1); PG8_BAR; PG8_SCHED;
            PG8_LDA(At, 0, 1); PG8_STAGE(PG8_SB(0, 0), b2, voffB); PG8_STAGE(PG8_SB(0, 1), b2 + bhs, voffB); PG8_STAGE(PG8_SA(0, 0), a2, voffA);
            PG8_WAIT_V(8); PG8_WAIT_L(0); PG8_BAR; PG8_MMA(1, 0, At, B0); if (!cur.half) PG8_MMA(1, 1, At, B1); PG8_BAR; PG8_SCHED;
            PG8_LDB(B0, 1, 0); PG8_LDB(B1, 1, 1); PG8_SCHED; PG8_LDA(At, 1, 0); PG8_STAGE(PG8_SA(0, 1), a2 + hstep, voffA);
            PG8_WAIT_V(8); PG8_WAIT_L(0); PG8_BAR; PG8_MMA(0, 0, At, B0); if (!cur.half) PG8_MMA(0, 1, At, B1); PG8_BAR; PG8_SCHED;
            PG8_LDA(At, 1, 1); PG8_STAGE(PG8_SB(1, 0), b3, voffB); PG8_STAGE(PG8_SB(1, 1), b3 + bhs, voffB); PG8_STAGE(PG8_SA(1, 0), a3, voffA);
            PG8_WAIT_V(8); PG8_WAIT_L(0); PG8_BAR; PG8_MMA(1, 0, At, B0); if (!cur.half) PG8_MMA(1, 1, At, B1); PG8_BAR; PG8_SCHED;
        }
        if constexpr (ALIGN_EPI) { if (wr == 0) PG8_BAR; }
        E(acc, cur, wr, wc, fr, fq); S.done(cur);
        if (!has_next) break;
#pragma unroll
        for (int a = 0; a < 2; ++a)
#pragma unroll
            for (int b = 0; b < 2; ++b)
#pragma unroll
                for (int m = 0; m < 4; ++m)
#pragma unroll
                    for (int n = 0; n < 2; ++n) acc[a][b][m][n] = (f32x4){0.f, 0.f, 0.f, 0.f};
        cur = nxt; cA = nA; cB = nB; ++ui;
        if constexpr (ALIGN_EPI) { if (wr == 1) PG8_BAR; }
    }
    PG8_WAIT_V(0);
    if constexpr (!ALIGN_EPI) { if (wr == 0) PG8_BAR; }
    PG8_BAR;
#undef PG8_SA
#undef PG8_SB
#undef PG8_STAGE
#undef PG8_LDA
#undef PG8_LDB
#undef PG8_MMA
#undef PG8_WAIT_V
#undef PG8_WAIT_L
#undef PG8_BAR
#undef PG8_SCHED
}
}

constexpr int NWAVES = 8, NTHREADS = 512;
constexpr int LDS_BYTES = 155648;
constexpr int LDSCTL_OFF = 154624;
#define LAS __attribute__((address_space(3)))
typedef unsigned v4u __attribute__((ext_vector_type(4)));
typedef float f32x4 __attribute__((ext_vector_type(4)));

struct Params {
    const float* x; const float* mem; const int* pos; const float* norm_g; const float* w_in; const float* q_norm_g; const float* k_norm_g; const float* sinks;
    const float* lam_re; const float* lam_im; const float* log_dt; const float* b_re; const float* b_im; const float* c_re; const float* c_im; const float* d_skip;
    const float* w_glu; const float* b_glu; const float* mem_norm_g; const float* w_mem_kv; const float* xq_norm_g; const float* xk_norm_g; const float* w_out;
    float* out; unsigned char* ws;
};

__device__ __forceinline__ void p0_transpose_item(const float* W, int K, int N, const float* scale, bf16_t* WT, LAS float* scr, int item, int lane) {
    const int nblk = N / 64, kb = item / nblk, nb = item % nblk, k0 = 64 * kb, n0 = 64 * nb;
    const int lr = lane >> 4, lc = (lane & 15) * 4;
#pragma unroll 4
    for (int i = 0; i < 16; ++i) { const int kk = 4 * i + lr; const float sc = scale ? scale[k0 + kk] : 1.f; const f32x4 v = *(const f32x4*)(W + (size_t)(k0 + kk) * N + n0 + lc);
        LAS float* d = scr + kk * 65 + lc; d[0] = v[0] * sc; d[1] = v[1] * sc; d[2] = v[2] * sc; d[3] = v[3] * sc; }
    asm volatile("s_waitcnt lgkmcnt(0)" ::: "memory");
    const int c = lane & 7;
#pragma unroll
    for (int j = 0; j < 8; ++j) { const int n = (lane >> 3) + 8 * j; const LAS float* s = scr + (8 * c) * 65 + n;
        v4u o; o.x = pg8::pk_f16(s[0 * 65], s[1 * 65]); o.y = pg8::pk_f16(s[2 * 65], s[3 * 65]); o.z = pg8::pk_f16(s[4 * 65], s[5 * 65]); o.w = pg8::pk_f16(s[6 * 65], s[7 * 65]);
        *(v4u*)(WT + (size_t)(n0 + n) * K + k0 + 8 * c) = o; }
    asm volatile("s_waitcnt lgkmcnt(0)" ::: "memory");
}
__device__ __forceinline__ void phase_prep(const Params& P, LAS unsigned char* lds, int vcu, int G) {
    int tid = threadIdx.x; asm volatile("" : "+v"(tid)); const int lane = tid & 63, wave = __builtin_amdgcn_readfirstlane(tid >> 6);
    LAS float* scr = (LAS float*)(lds + wave * 16640);
    const int gw = vcu * NWAVES + wave, NGW = G * NWAVES;
    unsigned char* ws = P.ws;
    constexpr int I_IN = (D_MODEL / 64) * (IN_W / 64), I_OUT = (MIX_W / 64) * (D_MODEL / 64), I_GLU = (SSM_W / 64) * (SSM_W / 64), I_MEM = (D_MODEL / 64) * (1024 / 64);
    constexpr int I_LAYER = I_IN + I_OUT + I_GLU + I_MEM;
    for (int it = gw; it < DEPTH * I_LAYER; it += NGW) {
        const int l = it / I_LAYER; int r = it % I_LAYER;
        if (r < I_IN) { p0_transpose_item(P.w_in + (size_t)l * D_MODEL * IN_W, D_MODEL, IN_W, P.norm_g + l * D_MODEL, (bf16_t*)(ws + WS_WIN) + (size_t)l * IN_W * D_MODEL, scr, r, lane); continue; } r -= I_IN;
        if (r < I_OUT) { p0_transpose_item(P.w_out + (size_t)l * MIX_W * D_MODEL, MIX_W, D_MODEL, nullptr, (bf16_t*)(ws + WS_WOUT) + (size_t)l * D_MODEL * MIX_W, scr, r, lane); continue; } r -= I_OUT;
        if (r < I_GLU) { p0_transpose_item(P.w_glu + (size_t)l * SSM_W * SSM_W, SSM_W, SSM_W, nullptr, (bf16_t*)(ws + WS_WGLU) + (size_t)l * SSM_W * SSM_W, scr, r, lane); continue; } r -= I_GLU;
        p0_transpose_item(P.w_mem_kv + (size_t)l * D_MODEL * 1024, D_MODEL, 1024, P.mem_norm_g + l * D_MODEL, (bf16_t*)(ws + WS_WMEM) + (size_t)l * 1024 * D_MODEL, scr, r, lane);
    }
    for (int m = gw; m < MTOK + BATCH * N_MEM; m += NGW) {
        const bool is_x = m < MTOK; const int row = is_x ? m : m - MTOK;
        const f32x4* xr = (const f32x4*)((is_x ? P.x : P.mem) + (size_t)row * D_MODEL) + lane;
        bf16_t* ob = (bf16_t*)(ws + (is_x ? WS_XB : WS_MEMB)) + (size_t)row * D_MODEL;
        f32x4 v[4]; float s = 0.f;
#pragma unroll
        for (int j = 0; j < 4; ++j) { v[j] = xr[64 * j]; s += (v[j][0] * v[j][0] + v[j][1] * v[j][1]) + (v[j][2] * v[j][2] + v[j][3] * v[j][3]); }
        s = wave_sum(s);
#pragma unroll
        for (int j = 0; j < 4; ++j) { pg8::u32x2 w; w.x = pg8::pk_f16(v[j][0], v[j][1]); w.y = pg8::pk_f16(v[j][2], v[j][3]); *((pg8::u32x2*)ob + lane + 64 * j) = w; }
        if (is_x) { if (lane < 16) ((float*)(ws + WS_SUMSQ))[(size_t)row * 16 + lane] = (lane == 0) ? s : 0.f; }
        else if (lane == 0) ((float*)(ws + WS_MISC))[row] = rsqrtf(s * (1.f / D_MODEL) + EPS);
    }
    { bf16_t* tab = (bf16_t*)(ws + WS_ROPE);
      for (int idx = vcu * NTHREADS + tid; idx < MTOK * 32; idx += G * NTHREADS) { const int tok = idx >> 5, i = idx & 31;
          const float inv = powf(10000.0f, -(float)i / 32.0f); const float ang = (float)P.pos[tok] * inv; const double a = (double)ang;
          tab[tok * 64 + i] = f2bf((float)cos(a)); tab[tok * 64 + 32 + i] = f2bf((float)sin(a)); } }
}


typedef _Float16 f16x8 __attribute__((ext_vector_type(8)));
typedef float f32x16 __attribute__((ext_vector_type(16)));
__device__ __forceinline__ int crow(int r, int hi) { return (r & 3) + 8 * (r >> 2) + 4 * hi; }
__device__ __forceinline__ float hf(_Float16 h) { return (float)h; }
constexpr float LOG2E = 1.4426950408889634f;
__device__ __forceinline__ f16x8 pack8(const f32x16& p, int s) { f16x8 r;
#pragma unroll
    for (int j = 0; j < 8; ++j) r[j] = (_Float16)p[8 * s + j];
    return r; }


__device__ __forceinline__ void stage_tile(LAS unsigned char* st, int pitchB, int colOff, const f32x16& o, int c, int hi) {
#pragma unroll
    for (int r = 0; r < 16; ++r) *(LAS _Float16*)(st + crow(r, hi) * pitchB + (colOff + c) * 2) = (_Float16)o[r];
}
__device__ __forceinline__ float silu_fast(float x) { return x * __builtin_amdgcn_rcpf(1.f + __expf(-x)); }
constexpr int ATT_KF = 0, ATT_VF = 32768, ATT_ST = 65536;
__device__ __forceinline__ int opaque_tid() { int t = threadIdx.x; asm volatile("" : "+v"(t)); return t; }
__device__ __forceinline__ void attn_a_item(const Params& P, int layer, LAS unsigned char* lds, int item) {
    const int tid = opaque_tid(), lane = tid & 63, wave = __builtin_amdgcn_readfirstlane(tid >> 6);
    const int kvh = item & 1, blk = (item >> 1) & 31, b = item >> 6;
    const bf16_t* Z = (const bf16_t*)(P.ws + WS_Z); bf16_t* MIX = (bf16_t*)(P.ws + WS_MIX); const bf16_t* rope = (const bf16_t*)(P.ws + WS_ROPE);
    const float* kg = P.k_norm_g + layer * HD; const float* qg = P.q_norm_g + layer * HD;
    {
        const int key = tid >> 1, hh = tid & 1, tpos = blk * 128 - 128 + key; const bool valid = tpos >= 0;
        const int tok = b * SEQ + (valid ? tpos : 0);
        const bf16_t* zr = Z + (size_t)tok * IN_W;
        const int kt = key >> 5, kl = key & 31;
#pragma unroll
        for (int i = 0; i < 2; ++i) { const int c = 2 * hh + i;
            f16x8 o1 = *(const f16x8*)(zr + ZK + kvh * HD + 8 * c), o2 = *(const f16x8*)(zr + ZK + kvh * HD + 32 + 8 * c);
            if (!valid) { o1 = (f16x8){0, 0, 0, 0, 0, 0, 0, 0}; o2 = o1; }
            { const int cc = c;     *(LAS f16x8*)(lds + ATT_KF + (((kt * 4 + (cc >> 1)) * 64) + kl + 32 * (cc & 1)) * 16) = o1; }
            { const int cc = c + 4; *(LAS f16x8*)(lds + ATT_KF + (((kt * 4 + (cc >> 1)) * 64) + kl + 32 * (cc & 1)) * 16) = o2; } }
        const int sK = kl >> 4, h2 = ((kl & 15) >> 2) & 1, jj = 4 * ((kl & 15) >> 3) + (kl & 3);
        LAS unsigned short* vb = (LAS unsigned short*)(lds + ATT_VF + ((((kt * 2 + hh) * 2 + sK) * 64) + 32 * h2) * 16 + 2 * jj);
#pragma unroll
        for (int i = 0; i < 4; ++i) { const v4u v = *(const v4u*)(zr + ZV + kvh * HD + 32 * hh + 8 * i);
#pragma unroll
            for (int j = 0; j < 8; ++j) { const unsigned wv = v[j >> 1]; vb[(8 * i + j) * 8] = valid ? (unsigned short)((j & 1) ? (wv >> 16) : (wv & 0xffffu)) : (unsigned short)0; } }
    }
    const int ql = lane & 31, hi = lane >> 5;
    f16x8 qfu[2][4];
#pragma unroll
    for (int ui = 0; ui < 2; ++ui) {
        const int head = 2 * (wave >> 2) + ui, w = wave & 3, hq = kvh * 4 + head;
        const int tq = b * SEQ + blk * 128 + 32 * w + ql;
        const bf16_t* zq = Z + (size_t)tq * IN_W + ZQ + hq * HD;
#pragma unroll
        for (int d0 = 0; d0 < 4; ++d0) qfu[ui][d0] = *(const f16x8*)(zq + 16 * d0 + 8 * hi);
    }
    __syncthreads();
#pragma unroll
    for (int ui = 0; ui < 2; ++ui) {
        const int head = 2 * (wave >> 2) + ui, w = wave & 3, hq = kvh * 4 + head;
        const f16x8* qf = qfu[ui];
        const int erow = lane >> 1, ehs = lane & 1; const size_t etok = (size_t)b * SEQ + blk * 128 + 32 * w + erow; const int ecol = hq * HD + 32 * ehs;
        v4u gv[4];
#pragma unroll
        for (int i = 0; i < 4; ++i) gv[i] = *(const v4u*)(Z + etok * IN_W + ZG + ecol + 8 * i);
        f32x16 p[5];
#pragma unroll
        for (int t = 0; t < 5; ++t) { const int kt = w + t; f32x16 acc = {};
#pragma unroll
            for (int d0 = 0; d0 < 4; ++d0) { const f16x8 kf = *(const LAS f16x8*)(lds + ATT_KF + ((kt * 4 + d0) * 64 + lane) * 16);
                acc = __builtin_amdgcn_mfma_f32_32x32x16_f16(kf, qf[d0], acc, 0, 0, 0); }
            p[t] = acc; }
        float mx = -INFINITY;
        int qlv = ql; asm volatile("" : "+v"(qlv));
#pragma unroll
        for (int t = 0; t < 5; ++t) { const bool tile_off = (blk == 0) && (w + t < 4);
#pragma unroll
            for (int r = 0; r < 16; ++r) { bool ok = !tile_off; if (t == 0) ok = ok && (crow(r, hi) > qlv); if (t == 4) ok = ok && (crow(r, hi) <= qlv);
                const float v = ok ? p[t][r] : -INFINITY; p[t][r] = v; mx = fmaxf(mx, v); } }
        mx = fmaxf(mx, __shfl_xor(mx, 32));
        const float sink2 = P.sinks[layer * NQH + hq] * LOG2E;
        mx = fmaxf(mx, sink2);
        float l = 0.f;
#pragma unroll
        for (int t = 0; t < 5; ++t)
#pragma unroll
            for (int r = 0; r < 16; ++r) { const float e = __builtin_amdgcn_exp2f(p[t][r] - mx); p[t][r] = e; l += e; }
        l += __shfl_xor(l, 32);
        l += __builtin_amdgcn_exp2f(sink2 - mx);
        const float linv = __builtin_amdgcn_rcpf(l);
        f32x16 o[2] = {};
#pragma unroll
        for (int t = 0; t < 5; ++t) { const int kt = w + t;
#pragma unroll
            for (int s2 = 0; s2 < 2; ++s2) { const f16x8 pa = pack8(p[t], s2);
#pragma unroll
                for (int db = 0; db < 2; ++db) { const f16x8 vf = *(const LAS f16x8*)(lds + ATT_VF + (((kt * 2 + db) * 2 + s2) * 64 + lane) * 16);
                    o[db] = __builtin_amdgcn_mfma_f32_32x32x16_f16(pa, vf, o[db], 0, 0, 0); } } }
        { LAS unsigned char* st = lds + ATT_ST + wave * 4608;
          stage_tile(st, 144, 0, o[0], ql, hi); stage_tile(st, 144, 32, o[1], ql, hi);
          const float li = __shfl(linv, erow);
#pragma unroll
          for (int i = 0; i < 4; ++i) { const v4u ov = *(const LAS v4u*)(st + erow * 144 + ehs * 64 + 16 * i); v4u w4;
#pragma unroll
              for (int j = 0; j < 4; ++j) w4[j] = pg8::pk_f16(pg8::h_lo(ov[j]) * li * pg8::h_lo(gv[i][j]), pg8::h_hi(ov[j]) * li * pg8::h_hi(gv[i][j]));
              *(v4u*)(MIX + etok * MIX_W + ecol + 8 * i) = w4; } }
    }
    __syncthreads();
}
__device__ __forceinline__ void phase_attn_a(const Params& P, int layer, LAS unsigned char* lds, int vcu, int G, int bx, bool defer) {
    if (defer) {
        if (bx < 128) attn_a_item(P, layer, lds, bx);
        else for (int j = 0; j < 3; ++j) attn_a_item(P, layer, lds, 128 + 3 * (bx - 128) + j);
        return; }
    for (int it = vcu; it < BATCH * 32 * NKVH; it += G) attn_a_item(P, layer, lds, it);
}

__device__ __forceinline__ void attn_c_item(const Params& P, int layer, LAS unsigned char* lds, int item) {
    const int tid = opaque_tid(), lane = tid & 63, wave = __builtin_amdgcn_readfirstlane(tid >> 6);
    const int sblk = item & 7, h = (item >> 3) & 3, b = item >> 5;
    const bf16_t* Z = (const bf16_t*)(P.ws + WS_Z); bf16_t* MIX = (bf16_t*)(P.ws + WS_MIX);
    const f16x8* KFg = (const f16x8*)(P.ws + WS_MK) + (size_t)((layer * BATCH + b) * XH + h) * (8 * 8 * 64);
    const f16x8* VFg = (const f16x8*)(P.ws + WS_MV) + (size_t)((layer * BATCH + b) * XH + h) * (8 * 4 * 2 * 64);
    const float* xqg = P.xq_norm_g + layer * XHD;
#pragma unroll
    for (int i = 0; i < 16; ++i) { const int f = wave * 16 + i; const f16x8* src = (f < 64 ? KFg + f * 64 : VFg + (f - 64) * 64) + lane;
        __builtin_amdgcn_global_load_lds((const unsigned*)src, (LAS unsigned*)(lds + f * 1024), 16, 0, 0); }
    asm volatile("s_waitcnt vmcnt(0)" ::: "memory");
    __syncthreads();
    const int ql = lane & 31, hi = lane >> 5;
    for (int ui = 0; ui < 2; ++ui) {
        const int qbase = b * SEQ + sblk * 512 + (wave * 2 + ui) * 32;
        const bf16_t* zq = Z + (size_t)(qbase + ql) * IN_W + ZXQ + h * XHD;
        f16x8 qf[8]; float ss = 0.f;
#pragma unroll
        for (int d0 = 0; d0 < 8; ++d0) { qf[d0] = *(const f16x8*)(zq + 16 * d0 + 8 * hi);
#pragma unroll
            for (int j = 0; j < 8; ++j) { const float a = hf(qf[d0][j]); ss += a * a; } }
        ss += __shfl_xor(ss, 32);
        const float rs = rsqrtf(ss * (1.f / XHD) + EPS) * (0.08838834764831845f * LOG2E);
#pragma unroll
        for (int d0 = 0; d0 < 8; ++d0)
#pragma unroll
            for (int j = 0; j < 8; ++j) qf[d0][j] = (_Float16)(hf(qf[d0][j]) * rs * xqg[16 * d0 + 8 * hi + j]);
        f16x8 pa[2][4][2]; float mh[2], lh[2];
#pragma unroll
        for (int hf2 = 0; hf2 < 2; ++hf2) {
            f32x16 p[4];
#pragma unroll
            for (int t = 0; t < 4; ++t) { const int kt = 4 * hf2 + t; f32x16 acc = {};
#pragma unroll
                for (int d0 = 0; d0 < 8; ++d0) acc = __builtin_amdgcn_mfma_f32_32x32x16_f16(*(const LAS f16x8*)(lds + ((kt * 8 + d0) * 64 + lane) * 16), qf[d0], acc, 0, 0, 0);
                p[t] = acc; asm volatile("" ::: "memory"); }
            float mx = -INFINITY;
#pragma unroll
            for (int t = 0; t < 4; ++t)
#pragma unroll
                for (int r = 0; r < 16; ++r) mx = fmaxf(mx, p[t][r]);
            mx = fmaxf(mx, __shfl_xor(mx, 32));
            float l = 0.f;
#pragma unroll
            for (int t = 0; t < 4; ++t) {
#pragma unroll
                for (int r = 0; r < 16; ++r) { const float e = __builtin_amdgcn_exp2f(p[t][r] - mx); p[t][r] = e; l += e; }
                pa[hf2][t][0] = pack8(p[t], 0); pa[hf2][t][1] = pack8(p[t], 1); }
            l += __shfl_xor(l, 32);
            mh[hf2] = mx; lh[hf2] = l;
        }
        const float mm = fmaxf(mh[0], mh[1]); const float e0 = __builtin_amdgcn_exp2f(mh[0] - mm), e1 = __builtin_amdgcn_exp2f(mh[1] - mm);
        const float linv = __builtin_amdgcn_rcpf(lh[0] * e0 + lh[1] * e1); const float f0 = e0 * linv, f1 = e1 * linv;
#pragma unroll
        for (int db = 0; db < 4; ++db) { f32x16 o0 = {}, o1 = {};
#pragma unroll
            for (int t = 0; t < 4; ++t) {
#pragma unroll
                for (int s2 = 0; s2 < 2; ++s2) { o0 = __builtin_amdgcn_mfma_f32_32x32x16_f16(pa[0][t][s2], *(const LAS f16x8*)(lds + 65536 + (((t * 4 + db) * 2 + s2) * 64 + lane) * 16), o0, 0, 0, 0);
                    o1 = __builtin_amdgcn_mfma_f32_32x32x16_f16(pa[1][t][s2], *(const LAS f16x8*)(lds + 65536 + ((((4 + t) * 4 + db) * 2 + s2) * 64 + lane) * 16), o1, 0, 0, 0); }
                asm volatile("" ::: "memory"); }
            { LAS unsigned char* st = lds + 131072 + wave * 2560; const int erow = lane >> 1, ehs = lane & 1;
              const size_t tok = (size_t)qbase + erow; const int col = h * XHD + 32 * db + 16 * ehs;
              const v4u ga = *(const v4u*)(Z + tok * IN_W + ZXG + col), gb = *(const v4u*)(Z + tok * IN_W + ZXG + col + 8);
              const float g0 = __shfl(f0, erow), g1 = __shfl(f1, erow);
              stage_tile(st, 80, 0, o0, ql, hi);
              const v4u a0 = *(const LAS v4u*)(st + erow * 80 + ehs * 32), a1 = *(const LAS v4u*)(st + erow * 80 + ehs * 32 + 16);
              asm volatile("" ::: "memory");
              stage_tile(st, 80, 0, o1, ql, hi);
              const v4u b0 = *(const LAS v4u*)(st + erow * 80 + ehs * 32), b1 = *(const LAS v4u*)(st + erow * 80 + ehs * 32 + 16);
              v4u w0, w1;
#pragma unroll
              for (int j = 0; j < 4; ++j) {
                  w0[j] = pg8::pk_f16((pg8::h_lo(a0[j]) * g0 + pg8::h_lo(b0[j]) * g1) * pg8::h_lo(ga[j]), (pg8::h_hi(a0[j]) * g0 + pg8::h_hi(b0[j]) * g1) * pg8::h_hi(ga[j]));
                  w1[j] = pg8::pk_f16((pg8::h_lo(a1[j]) * g0 + pg8::h_lo(b1[j]) * g1) * pg8::h_lo(gb[j]), (pg8::h_hi(a1[j]) * g0 + pg8::h_hi(b1[j]) * g1) * pg8::h_hi(gb[j])); }
              *(v4u*)(MIX + tok * MIX_W + 1024 + col) = w0; *(v4u*)(MIX + tok * MIX_W + 1024 + col + 8) = w1; }
            asm volatile("" ::: "memory"); }
    }
    __syncthreads();
}
__device__ __forceinline__ void phase_attn_c(const Params& P, int layer, LAS unsigned char* lds, int vcu, int G) {
    for (int it = vcu; it < BATCH * XH * 8; it += G) attn_c_item(P, layer, lds, it);
}
__device__ __forceinline__ void phase_memfin(const Params& P, int vcu, int G) {
    const int tid = opaque_tid(), lane = tid & 63, wave = __builtin_amdgcn_readfirstlane(tid >> 6);
    const float* mkv = (const float*)(P.ws + WS_Y2);
    for (int it = vcu * NWAVES + wave; it < DEPTH * BATCH * N_MEM; it += G * NWAVES) {
        const int l = it / (BATCH * N_MEM), row = it % (BATCH * N_MEM), b = row / N_MEM, key = row % N_MEM;
        const float* r = mkv + (size_t)row * (DEPTH * 1024) + l * 1024; const float* xkg = P.xk_norm_g + l * XHD;
        const int kt = key >> 5, kl = key & 31, sK = kl >> 4, h2 = ((kl & 15) >> 2) & 1, jj = 4 * ((kl & 15) >> 3) + (kl & 3);
        for (int h = 0; h < XH; ++h) {
            bf16_t* KF = (bf16_t*)(P.ws + WS_MK) + (size_t)((l * BATCH + b) * XH + h) * (8 * 8 * 64 * 8);
            bf16_t* VF = (bf16_t*)(P.ws + WS_MV) + (size_t)((l * BATCH + b) * XH + h) * (8 * 4 * 2 * 64 * 8);
            float v[2]; v[0] = r[h * XHD + lane]; v[1] = r[h * XHD + 64 + lane];
            const float s = wave_sum(v[0] * v[0] + v[1] * v[1]); const float rs = rsqrtf(s * (1.f / XHD) + EPS);
#pragma unroll
            for (int e = 0; e < 2; ++e) { const int d = lane + 64 * e;
                KF[(size_t)((kt * 8 + (d >> 4)) * 64 + kl + 32 * ((d >> 3) & 1)) * 8 + (d & 7)] = f2bf(v[e] * rs * xkg[d]);
                VF[(size_t)(((kt * 4 + (d >> 5)) * 2 + sK) * 64 + (d & 31) + 32 * h2) * 8 + jj] = f2bf(r[512 + h * XHD + d]); }
        }
    }
}


constexpr size_t SSMC_WE = 0, SSMC_WC = 64 * 1024, SSMC_KJ = 128 * 1024, SSMC_STRIDE = 144 * 1024;
constexpr size_t WS_A16 = WS_MISC + 128 * 1024;
__device__ __forceinline__ void ssm_consts_item(const Params& P, LAS unsigned char* lds, int item) {
    const int tid = opaque_tid(); const int l = item / SSM_G, g = item % SSM_G;
    LAS float* apw = (LAS float*)lds;
    LAS float* bbar = apw + 17 * 64 * 2;
    LAS float* kj = bbar + 64 * 16 * 2;
    LAS float* cre = kj + 16 * 256; LAS float* cim = cre + 16 * 64;
    { const float* c_re_g = P.c_re + (size_t)(l * SSM_G + g) * SSM_CH * SSM_P; const float* c_im_g = P.c_im + (size_t)(l * SSM_G + g) * SSM_CH * SSM_P;
      for (int i = tid; i < 16 * 64; i += NTHREADS) { cre[i] = c_re_g[i]; cim[i] = c_im_g[i]; } }
    const LAS float* c_re = cre; const LAS float* c_im = cim;
    const double dt = exp((double)P.log_dt[l * SSM_G + g]);
    for (int i = tid; i < 17 * 64; i += NTHREADS) { const int j = i / 64, p = i % 64; const int gp = (l * SSM_G + g) * SSM_P + p;
        const double lr = P.lam_re[gp], li = P.lam_im[gp]; const double mag = exp(lr * dt * j); double sn, cs; sincos(li * dt * j, &sn, &cs);
        apw[i * 2] = (float)(mag * cs); apw[i * 2 + 1] = (float)(mag * sn); }
    for (int i = tid; i < 64 * 16; i += NTHREADS) { const int p = i / 16, c = i % 16; const int gp = (l * SSM_G + g) * SSM_P + p;
        const double lr = P.lam_re[gp], li = P.lam_im[gp]; const double mag = exp(lr * dt), ar = mag * cos(li * dt), ai = mag * sin(li * dt), den = lr * lr + li * li;
        const double fr = ((ar - 1.0) * lr + ai * li) / den, fi = (ai * lr - (ar - 1.0) * li) / den;
        const double br = P.b_re[(size_t)gp * SSM_CH + c], bi = P.b_im[(size_t)gp * SSM_CH + c];
        bbar[i * 2] = (float)(fr * br - fi * bi); bbar[i * 2 + 1] = (float)(fr * bi + fi * br); }
    __syncthreads();
    for (int i = tid; i < 16 * 256; i += NTHREADS) { const int j = i >> 8, co = (i >> 4) & 15, ci = i & 15; float acc = 0.f;
        for (int p = 0; p < 64; ++p) { const float er = apw[(j * 64 + p) * 2], ei = apw[(j * 64 + p) * 2 + 1], br = bbar[(p * 16 + ci) * 2], bi = bbar[(p * 16 + ci) * 2 + 1];
            const float wr = er * br - ei * bi, wi = er * bi + ei * br; acc += c_re[co * SSM_P + p] * wr - c_im[co * SSM_P + p] * wi; }
        if (j == 0 && co == ci) acc += P.d_skip[l * SSM_W + g * SSM_CH + co];
        kj[i] = acc; }
    __syncthreads();
    unsigned char* base = P.ws + WS_SSMP + (size_t)item * SSMC_STRIDE;
    bf16_t* WE = (bf16_t*)(base + SSMC_WE); bf16_t* WC = (bf16_t*)(base + SSMC_WC); bf16_t* KJ = (bf16_t*)(base + SSMC_KJ);
    for (int i = tid; i < 64 * 512; i += NTHREADS) { const int f = i >> 9, e = i & 511, ln = e >> 3, j = e & 7, mt = f >> 4, sx = f & 15, r = ln & 31, hh = ln >> 5;
        const int R = 32 * mt + r, p = R >> 1, ri = R & 1, ci = 8 * hh + j; const float er = apw[((15 - sx) * 64 + p) * 2], ei = apw[((15 - sx) * 64 + p) * 2 + 1], br = bbar[(p * 16 + ci) * 2], bi = bbar[(p * 16 + ci) * 2 + 1];
        WE[i] = f2bf(ri ? (er * bi + ei * br) : (er * br - ei * bi)); }
    for (int i = tid; i < 9216 / 2; i += NTHREADS) KJ[i] = (i < 16 * 256) ? f2bf(kj[i]) : (bf16_t)0;
    for (int i = tid; i < 64 * 512; i += NTHREADS) { const int f = i >> 9, e = i & 511, ln = e >> 3, j = e & 7, mt = f >> 3, kc = f & 7, r = ln & 31, hh = ln >> 5;
        const int t = 2 * mt + (r >> 4), co = r & 15, p = 8 * kc + 4 * hh + (j >> 1), ri = j & 1; const float er = apw[((t + 1) * 64 + p) * 2], ei = apw[((t + 1) * 64 + p) * 2 + 1];
        const float cr = c_re[co * SSM_P + p], cim = c_im[co * SSM_P + p]; WC[i] = f2bf(ri ? -(cr * ei + cim * er) : (cr * er - cim * ei)); }
    if (tid < 64) { float* a16 = (float*)(P.ws + WS_A16) + (size_t)(item * 64 + tid) * 4; a16[0] = apw[(16 * 64 + tid) * 2]; a16[1] = apw[(16 * 64 + tid) * 2 + 1];
        const int gp = (l * SSM_G + g) * SSM_P + tid; const double lr = P.lam_re[gp], li = P.lam_im[gp]; const double mag = exp(lr * dt * 512.0); double sn, cs; sincos(li * dt * 512.0, &sn, &cs);
        a16[2] = (float)(mag * cs); a16[3] = (float)(mag * sn); }
    __syncthreads();
}
__device__ __forceinline__ void phase_ssm_consts(const Params& P, LAS unsigned char* lds, int vcu, int G) {
    for (int it = vcu; it < DEPTH * SSM_G; it += G) ssm_consts_item(P, lds, it);
}
__device__ __forceinline__ float gelu_tanh_fast(float x) {
    const float u = 0.7978845608028654f * (x + 0.044715f * x * x * x); return x * __builtin_amdgcn_rcpf(1.f + __expf(-2.f * u)); }

constexpr int SSM_EH = 0, SSM_EHP = 272, SSM_WX = 69632, SSM_KJ = SSM_WX + 65536, SSM_CHS = SSM_KJ + 9216;
static_assert(SSM_CHS + 4096 <= LDSCTL_OFF, "ssm lds map");
__device__ __forceinline__ void ssm_item(const Params& P, int layer, LAS unsigned char* lds, int item) {
    const int tid = opaque_tid(), lane = tid & 63, wave = __builtin_amdgcn_readfirstlane(tid >> 6);
    const int g = item >> 3, b = item & 7;
    const bf16_t* Z = (const bf16_t*)(P.ws + WS_Z); bf16_t* Y2 = (bf16_t*)(P.ws + WS_Y2);
    const unsigned char* cbase = P.ws + WS_SSMP + (size_t)(layer * SSM_G + g) * SSMC_STRIDE;
    const int nl = lane & 31, hh = lane >> 5;
    typedef float f32x2v __attribute__((ext_vector_type(2)));
#pragma unroll
    for (int i = 0; i < 8; ++i) { const int f = wave * 8 + i;
        __builtin_amdgcn_global_load_lds((const unsigned*)(cbase + SSMC_WE + f * 1024 + lane * 16), (LAS unsigned*)(lds + SSM_WX + f * 1024), 16, 0, 0); }
    __builtin_amdgcn_global_load_lds((const unsigned*)(cbase + SSMC_KJ + wave * 1024 + lane * 16), (LAS unsigned*)(lds + SSM_KJ + wave * 1024), 16, 0, 0);
    if (wave == 0) __builtin_amdgcn_global_load_lds((const unsigned*)(cbase + SSMC_KJ + 8192 + lane * 16), (LAS unsigned*)(lds + SSM_KJ + 8192), 16, 0, 0);
    const int n = 32 * wave + nl;
    const bf16_t* up = Z + (size_t)(b * SEQ + 16 * n) * IN_W + ZU + g * SSM_CH + 8 * hh;
    f16x8 uf[16];
#pragma unroll
    for (int sx = 0; sx < 16; ++sx) uf[sx] = *(const f16x8*)(up + (size_t)sx * IN_W);
    const float* a16p = (const float*)(P.ws + WS_A16) + (size_t)((layer * SSM_G + g) * 64 + lane) * 4;
    const float a16r = a16p[0], a16i = a16p[1], a5r = a16p[2], a5i = a16p[3];
    asm volatile("s_waitcnt vmcnt(0)" ::: "memory");
    __syncthreads();
    {
        f32x16 ae[4] = {};
#pragma unroll
        for (int sx = 0; sx < 16; ++sx) {
#pragma unroll
            for (int mt = 0; mt < 4; ++mt) ae[mt] = __builtin_amdgcn_mfma_f32_32x32x16_f16(*(const LAS f16x8*)(lds + SSM_WX + ((mt * 16 + sx) * 64 + lane) * 16), uf[sx], ae[mt], 0, 0, 0);
            if ((sx & 1) == 1) asm volatile("" ::: "memory"); }
#pragma unroll
        for (int mt = 0; mt < 4; ++mt)
#pragma unroll
            for (int r = 0; r < 16; r += 2) { const int p = 16 * mt + (crow(r, hh) >> 1);
                *(LAS unsigned*)(lds + SSM_EH + n * SSM_EHP + 4 * p) = pg8::pk_f16(ae[mt][r], ae[mt][r + 1]); }
    }
    __syncthreads();
#pragma unroll
    for (int i = 0; i < 8; ++i) { const int f = wave * 8 + i;
        __builtin_amdgcn_global_load_lds((const unsigned*)(cbase + SSMC_WC + f * 1024 + lane * 16), (LAS unsigned*)(lds + SSM_WX + f * 1024), 16, 0, 0); }
    {
        LAS unsigned char* eh = lds + SSM_EH + (32 * wave) * SSM_EHP + 4 * lane;
        float sr = 0.f, si = 0.f;
#pragma unroll 8
        for (int k = 0; k < 32; ++k) { const unsigned ev = *(const LAS unsigned*)(eh + k * SSM_EHP); const float er = pg8::h_lo(ev), ei = pg8::h_hi(ev);
            const float nr = a16r * sr - a16i * si + er, ni = a16r * si + a16i * sr + ei; sr = nr; si = ni; }
        LAS f32x2v* chs = (LAS f32x2v*)(lds + SSM_CHS);
        chs[wave * 64 + lane] = (f32x2v){sr, si};
        __syncthreads();
        float cr = 0.f, ci = 0.f;
        for (int v = 0; v < wave; ++v) { const f32x2v sv = chs[v * 64 + lane]; const float nr = a5r * cr - a5i * ci + sv.x, ni = a5r * ci + a5i * cr + sv.y; cr = nr; ci = ni; }
        sr = cr; si = ci;
#pragma unroll 8
        for (int k = 0; k < 32; ++k) { const unsigned ev = *(const LAS unsigned*)(eh + k * SSM_EHP); const float er = pg8::h_lo(ev), ei = pg8::h_hi(ev);
            *(LAS unsigned*)(eh + k * SSM_EHP) = pg8::pk_f16(sr, si);
            const float nr = a16r * sr - a16i * si + er, ni = a16r * si + a16i * sr + ei; sr = nr; si = ni; }
    }
    asm volatile("s_waitcnt vmcnt(0)" ::: "memory");
    __syncthreads();
    const int rhi = nl >> 4, co = nl & 15;
    const LAS unsigned char* kjl = lds + SSM_KJ + co * 32 + hh * 16;
#pragma unroll
    for (int mh = 0; mh < 2; ++mh) {
        f32x16 ay[4] = {};
#pragma unroll
        for (int sx = 0; sx < 16; ++sx) {
#pragma unroll
            for (int i = 0; i < 4; ++i) { const int mt = 4 * mh + i; const int lag0 = 2 * mt - sx;
                if (lag0 + 1 >= 0) { const int lag = lag0 + rhi; const int row = (lag0 >= 0) ? lag : (rhi ? 0 : 16);
                    ay[i] = __builtin_amdgcn_mfma_f32_32x32x16_f16(*(const LAS f16x8*)(kjl + row * 512), uf[sx], ay[i], 0, 0, 0); } }
            if ((sx & 1) == 1) asm volatile("" ::: "memory"); }
#pragma unroll
        for (int kc = 0; kc < 8; ++kc) { const f16x8 hfr = *(const LAS f16x8*)(lds + SSM_EH + n * SSM_EHP + 32 * kc + 16 * hh);
#pragma unroll
            for (int i = 0; i < 4; ++i) { const int mt = 4 * mh + i;
                ay[i] = __builtin_amdgcn_mfma_f32_32x32x16_f16(*(const LAS f16x8*)(lds + SSM_WX + ((mt * 8 + kc) * 64 + lane) * 16), hfr, ay[i], 0, 0, 0); }
            if ((kc & 1) == 1) asm volatile("" ::: "memory"); }
#pragma unroll
        for (int i = 0; i < 4; ++i) { const int mt = 4 * mh + i;
#pragma unroll
            for (int q = 0; q < 4; ++q) { const int t = 2 * mt + (q >> 1), co0 = 8 * (q & 1) + 4 * hh;
                pg8::u32x2 w; w.x = pg8::pk_f16(gelu_tanh_fast(ay[i][4 * q]), gelu_tanh_fast(ay[i][4 * q + 1])); w.y = pg8::pk_f16(gelu_tanh_fast(ay[i][4 * q + 2]), gelu_tanh_fast(ay[i][4 * q + 3]));
                *(pg8::u32x2*)(Y2 + (size_t)(b * SEQ + 16 * n + t) * SSM_W + g * SSM_CH + co0) = w; } }
    }
    __syncthreads();
}
__device__ __forceinline__ void phase_ssm(const Params& P, int layer, LAS unsigned char* lds, int vcu, int G) {
    for (int it = vcu; it < SSM_G * BATCH; it += G) ssm_item(P, layer, lds, it);
}


#define XB_TMO      128
#define XB_XCNT(j)  (256  + 64 * (j))
#define XB_XSUB(j)  (1280 + 64 * (j))
#define XB_XGEN(j)  (2304 + 64 * (j))
#define XB_TOP      3328
#define XB_TOPGEN   3392
#define XCD_BAR_WORDS 3456
#define XB_SPIN_CAP (1u << 18)
__device__ __forceinline__ unsigned xb_ld(unsigned* p)              { return __hip_atomic_load(p, __ATOMIC_RELAXED, __HIP_MEMORY_SCOPE_AGENT); }
__device__ __forceinline__ unsigned xb_add(unsigned* p, unsigned v) { return __hip_atomic_fetch_add(p, v, __ATOMIC_RELAXED, __HIP_MEMORY_SCOPE_AGENT); }
__device__ __forceinline__ unsigned xb_xcc_id() { return (unsigned)__builtin_amdgcn_s_getreg((3 << 11) | 20) & 0xFu; }
#define XB_SPIN(cond, bar) do { unsigned _sp = 0; while (cond) { __builtin_amdgcn_s_sleep(1); \
    if ((++_sp & 255u) == 0u) { if (xb_ld(&(bar)[XB_TMO])) break; if (_sp > XB_SPIN_CAP) { atomicAdd(&(bar)[XB_TMO], 1u); break; } } } } while (0)
struct XcdBarrier { unsigned* bar; unsigned x; volatile LAS unsigned* st; };
__device__ __forceinline__ XcdBarrier xcd_barrier_post(unsigned* bar, volatile LAS unsigned* st) {
    XcdBarrier b; b.bar = bar; b.x = xb_xcc_id(); b.st = st;
    if (threadIdx.x == 0) (void)xb_add(&bar[XB_XCNT(b.x)], 1u);
    return b;
}
__device__ __forceinline__ void xcd_barrier_complete(unsigned* bar, unsigned x, unsigned& nloc, unsigned& nx) {
    const unsigned G = gridDim.x * gridDim.y * gridDim.z;
    unsigned sum, cnt, mine, sp = 0u;
    for (;;) {
        sum = 0u; cnt = 0u; mine = 0u;
#pragma unroll
        for (unsigned j = 0; j < 16; ++j) { const unsigned c = xb_ld(&bar[XB_XCNT(j)]); sum += c; cnt += (c > 0u) ? 1u : 0u; mine = (j == x) ? c : mine; }
        if (sum == G) break;
        __builtin_amdgcn_s_sleep(1);
        if ((++sp & 255u) == 0u) { if (xb_ld(&bar[XB_TMO])) break; if (sp > XB_SPIN_CAP) { atomicAdd(&bar[XB_TMO], 1u); break; } }
    }
    nloc = mine > 0u ? mine : 1u; nx = cnt > 0u ? cnt : 1u;
}
__device__ __forceinline__ void xcd_barrier(const XcdBarrier& b) {
    asm volatile("s_waitcnt vmcnt(0)" ::: "memory");
    __syncthreads();
    if (threadIdx.x == 0) {
        unsigned* bar = b.bar;
        __builtin_amdgcn_s_waitcnt(0);
        unsigned nloc = b.st[0], nx = b.st[1];
        if (nloc == 0u) { xcd_barrier_complete(bar, b.x, nloc, nx); b.st[0] = nloc; b.st[1] = nx; }
        const unsigned old = xb_add(&bar[XB_XSUB(b.x)], 1u);
        const unsigned gen = old / nloc;
        if (old + 1u == (gen + 1u) * nloc) {
            __builtin_amdgcn_fence(__ATOMIC_RELEASE, "agent");
            asm volatile("s_waitcnt vmcnt(0)" ::: "memory");
            const unsigned og = xb_add(&bar[XB_TOP], 1u);
            const unsigned tg = og / nx;
            if (og + 1u == (tg + 1u) * nx) xb_add(&bar[XB_TOPGEN], 1u);
            else XB_SPIN(xb_ld(&bar[XB_TOPGEN]) == tg, bar);
            __builtin_amdgcn_fence(__ATOMIC_ACQUIRE, "agent");
            xb_add(&bar[XB_XGEN(b.x)], 1u);
            asm volatile("s_waitcnt vmcnt(0)" ::: "memory");
        } else {
            XB_SPIN(xb_ld(&bar[XB_XGEN(b.x)]) == gen, bar);
            __builtin_amdgcn_fence(__ATOMIC_ACQUIRE, "agent");
            asm volatile("s_waitcnt vmcnt(0)" ::: "memory");
        }
    }
    __syncthreads();
}
constexpr size_t WS_CTL = WS_MISC + 512 * 1024;
constexpr int CTL_BYTES = 16384;

constexpr int DEFER_TILE = 8;
__device__ __forceinline__ bool defer_mode(int layer, int G) { return layer > 0 && G == 256; }
__device__ __forceinline__ void run_inproj(const Params& P, int layer, LAS unsigned char* lds, int G, int bx) {
    unsigned char* ws = P.ws;
    pg8::Gemm g{(const bf16_t*)(ws + WS_XB), (const bf16_t*)(ws + WS_WIN) + (size_t)layer * IN_W * D_MODEL, MTOK, IN_W, D_MODEL};
    pg8::EpiZ E{(bf16_t*)(ws + WS_Z), (const float*)(ws + WS_SUMSQ), (const bf16_t*)(ws + WS_ROPE), P.q_norm_g + layer * HD, P.k_norm_g + layer * HD};
    if (defer_mode(layer, G)) { pg8::SkipOrder S; S.init2(g.M, g.N, G, bx, DEFER_TILE); pg8::gemm_phase<pg8::EpiZ, pg8::SkipOrder, true>(lds, g, S, E); }
    else { pg8::StaticOrder S; S.init(g.M, g.N, G, bx); pg8::gemm_phase<pg8::EpiZ, pg8::StaticOrder, true>(lds, g, S, E); }
}
__device__ __forceinline__ void run_inproj_tail(const Params& P, int layer, LAS unsigned char* lds, int G, int bx) {
    if (!defer_mode(layer, G)) return;
    unsigned char* ws = P.ws;
    pg8::Gemm g{(const bf16_t*)(ws + WS_XB), (const bf16_t*)(ws + WS_WIN) + (size_t)layer * IN_W * D_MODEL, MTOK, IN_W, D_MODEL};
    pg8::EpiZ E{(bf16_t*)(ws + WS_Z), (const float*)(ws + WS_SUMSQ), (const bf16_t*)(ws + WS_ROPE), P.q_norm_g + layer * HD, P.k_norm_g + layer * HD};
    pg8::DeferOrder S; S.init(g.M, G, bx, DEFER_TILE); pg8::gemm_phase<pg8::EpiZ, pg8::DeferOrder, true>(lds, g, S, E);
}
__device__ __forceinline__ void run_glu(const Params& P, int layer, LAS unsigned char* lds, int G, int bx) {
    unsigned char* ws = P.ws;
    pg8::Gemm g{(const bf16_t*)(ws + WS_Y2), (const bf16_t*)(ws + WS_WGLU) + (size_t)layer * SSM_W * SSM_W, MTOK, SSM_W, SSM_W}; pg8::StaticOrder S; S.init(g.M, g.N, G, bx);
    pg8::EpiGlu E{(const bf16_t*)(ws + WS_Y2), (const bf16_t*)(ws + WS_Z), P.b_glu + layer * SSM_W, (bf16_t*)(ws + WS_MIX)};
    pg8::gemm_phase<pg8::EpiGlu, pg8::StaticOrder, true>(lds, g, S, E);
}
__device__ __forceinline__ void run_outproj(const Params& P, int layer, LAS unsigned char* lds, int G, int bx) {
    unsigned char* ws = P.ws;
    pg8::Gemm g{(const bf16_t*)(ws + WS_MIX), (const bf16_t*)(ws + WS_WOUT) + (size_t)layer * D_MODEL * MIX_W, MTOK, D_MODEL, MIX_W}; pg8::StaticOrder S; S.init(g.M, g.N, G, bx);
    if (layer == 0) { pg8::EpiOut<0> E{P.x, P.out, (bf16_t*)(ws + WS_XB), (float*)(ws + WS_SUMSQ)}; pg8::gemm_phase<pg8::EpiOut<0>, pg8::StaticOrder, true>(lds, g, S, E); }
    else if (layer + 1 < DEPTH) { pg8::EpiOut<1> E{P.x, P.out, (bf16_t*)(ws + WS_XB), (float*)(ws + WS_SUMSQ)}; pg8::gemm_phase<pg8::EpiOut<1>, pg8::StaticOrder, true>(lds, g, S, E); }
    else { pg8::EpiOut<2> E{P.x, P.out, (bf16_t*)(ws + WS_XB), (float*)(ws + WS_SUMSQ)}; pg8::gemm_phase<pg8::EpiOut<2>, pg8::StaticOrder, true>(lds, g, S, E); }
}
__device__ __forceinline__ void run_memgemm(const Params& P, LAS unsigned char* lds, int G, int bx) {
    unsigned char* ws = P.ws;
    pg8::Gemm g{(const bf16_t*)(ws + WS_MEMB), (const bf16_t*)(ws + WS_WMEM), BATCH * N_MEM, DEPTH * 1024, D_MODEL}; pg8::MemTailOrder S; S.init(g.M, g.N, G, bx, ((MTOK / 256) * (IN_W / 256)) % G);
    pg8::EpiMemF32 E{(float*)(ws + WS_Y2), DEPTH * 1024, (const float*)(ws + WS_MISC)};
    pg8::gemm_phase<pg8::EpiMemF32, pg8::MemTailOrder, true>(lds, g, S, E);
}


template <class T> __device__ __forceinline__ T* as_global(unsigned long long v) { return (T*)(__attribute__((address_space(1))) T*)v; }
__device__ __forceinline__ Params load_params() {
    typedef const volatile unsigned long long __attribute__((address_space(4)))* kp_t;
    kp_t kp = (kp_t)__builtin_amdgcn_kernarg_segment_ptr();
    Params q;
    q.x = as_global<const float>(kp[0]); q.mem = as_global<const float>(kp[1]); q.pos = as_global<const int>(kp[2]); q.norm_g = as_global<const float>(kp[3]);
    q.w_in = as_global<const float>(kp[4]); q.q_norm_g = as_global<const float>(kp[5]); q.k_norm_g = as_global<const float>(kp[6]); q.sinks = as_global<const float>(kp[7]);
    q.lam_re = as_global<const float>(kp[8]); q.lam_im = as_global<const float>(kp[9]); q.log_dt = as_global<const float>(kp[10]); q.b_re = as_global<const float>(kp[11]);
    q.b_im = as_global<const float>(kp[12]); q.c_re = as_global<const float>(kp[13]); q.c_im = as_global<const float>(kp[14]); q.d_skip = as_global<const float>(kp[15]);
    q.w_glu = as_global<const float>(kp[16]); q.b_glu = as_global<const float>(kp[17]); q.mem_norm_g = as_global<const float>(kp[18]); q.w_mem_kv = as_global<const float>(kp[19]);
    q.xq_norm_g = as_global<const float>(kp[20]); q.xk_norm_g = as_global<const float>(kp[21]); q.w_out = as_global<const float>(kp[22]);
    q.out = as_global<float>(kp[23]); q.ws = as_global<unsigned char>(kp[24]);
    return q;
}
static_assert(sizeof(Params) == 25 * 8, "Params is 25 pointers");
__global__ void __launch_bounds__(NTHREADS, 2) k_mega(Params Parg) {
    extern __shared__ __attribute__((aligned(16))) unsigned char lds_raw[];
    LAS unsigned char* lds = (LAS unsigned char*)lds_raw;
    const int G = gridDim.x, bx = blockIdx.x; const int vcu = (G % 8 == 0) ? (bx % 8) * (G / 8) + bx / 8 : bx;
    for (int u = threadIdx.x; u < (LDS_BYTES - LDSCTL_OFF) / 4; u += NTHREADS) ((LAS unsigned*)(lds + LDSCTL_OFF))[u] = 0u;
    __syncthreads();
    (void)xcd_barrier_post((unsigned*)(Parg.ws + WS_CTL), (volatile LAS unsigned*)(lds + LDSCTL_OFF));
#define GRID_BARRIER() do { XcdBarrier bar_; { const Params Pb = load_params(); bar_.bar = (unsigned*)(Pb.ws + WS_CTL); } unsigned xq_ = xb_xcc_id(); asm volatile("" : "+s"(xq_)); bar_.x = xq_; bar_.st = (volatile LAS unsigned*)(lds + LDSCTL_OFF); xcd_barrier(bar_); } while (0)
    { const Params P = load_params(); phase_prep(P, lds, vcu, G); } __syncthreads();
    { const Params P = load_params(); phase_ssm_consts(P, lds, vcu, G); }
    GRID_BARRIER();
    { const Params P = load_params(); run_inproj(P, 0, lds, G, bx); }
    { const Params P = load_params(); run_memgemm(P, lds, G, bx); }
    GRID_BARRIER();
    { const Params P = load_params(); phase_memfin(P, vcu, G); }
    GRID_BARRIER();
#pragma unroll 1
    for (int layer = 0; layer < DEPTH; ++layer) {
        { const Params P = load_params(); run_inproj_tail(P, layer, lds, G, bx); }
        { const Params P = load_params(); phase_attn_a(P, layer, lds, vcu, G, bx, defer_mode(layer, G)); }
        { const Params P = load_params(); phase_attn_c(P, layer, lds, vcu, G); }
        { const Params P = load_params(); phase_ssm(P, layer, lds, vcu, G); }
        GRID_BARRIER();
        { const Params P = load_params(); run_glu(P, layer, lds, G, bx); }
        GRID_BARRIER();
        { const Params P = load_params(); run_outproj(P, layer, lds, G, bx); }
        if (layer + 1 < DEPTH) { GRID_BARRIER(); { const Params P = load_params(); run_inproj(P, layer + 1, lds, G, bx); } GRID_BARRIER(); }
    }
}

extern "C" void kernel_launch(void* const* d_in, const int* in_sizes, int n_in, void* d_out, int out_size, void* d_ws, size_t ws_size, hipStream_t stream) {
    if (ws_size < WS_END || n_in != 23) return;
    Params P{};
    P.x = (const float*)d_in[0]; P.mem = (const float*)d_in[1]; P.pos = (const int*)d_in[2]; P.norm_g = (const float*)d_in[3]; P.w_in = (const float*)d_in[4];
    P.q_norm_g = (const float*)d_in[5]; P.k_norm_g = (const float*)d_in[6]; P.sinks = (const float*)d_in[7]; P.lam_re = (const float*)d_in[8]; P.lam_im = (const float*)d_in[9];
    P.log_dt = (const float*)d_in[10]; P.b_re = (const float*)d_in[11]; P.b_im = (const float*)d_in[12]; P.c_re = (const float*)d_in[13]; P.c_im = (const float*)d_in[14];
    P.d_skip = (const float*)d_in[15]; P.w_glu = (const float*)d_in[16]; P.b_glu = (const float*)d_in[17]; P.mem_norm_g = (const float*)d_in[18]; P.w_mem_kv = (const float*)d_in[19];
    P.xq_norm_g = (const float*)d_in[20]; P.xk_norm_g = (const float*)d_in[21]; P.w_out = (const float*)d_in[22];
    P.out = (float*)d_out; P.ws = (unsigned char*)d_ws;
    static int coop_grid = 0;
    if (coop_grid == 0) {
        int dev = 0, cus = 0, per_cu = 0; hipGetDevice(&dev); hipDeviceGetAttribute(&cus, hipDeviceAttributeMultiprocessorCount, dev);
        (void)hipFuncSetAttribute((const void*)k_mega, hipFuncAttributeMaxDynamicSharedMemorySize, LDS_BYTES);
        if (hipOccupancyMaxActiveBlocksPerMultiprocessor(&per_cu, (const void*)k_mega, NTHREADS, LDS_BYTES) != hipSuccess || per_cu < 1) { fprintf(stderr, "kernel_launch: occupancy query says %d blocks/CU\n", per_cu); (void)hipGetLastError(); per_cu = 1; }
        if (per_cu > 1) per_cu = 1;
        coop_grid = (cus > 0 ? cus : 256) * per_cu;
    }
    (void)hipMemsetAsync((char*)d_ws + WS_CTL, 0, CTL_BYTES, stream);
    { void* args[] = {(void*)&P}; hipError_t e = hipLaunchCooperativeKernel((const void*)k_mega, dim3(coop_grid), dim3(NTHREADS), args, LDS_BYTES, stream);
      if (e != hipSuccess) fprintf(stderr, "cooperative launch failed: %s (grid %d)\n", hipGetErrorString(e), coop_grid); }
}
```

```cpp
#include <hip/hip_runtime.h>
#include <cstdio>
#include <stdint.h>
#include <math.h>

constexpr int D_MODEL = 1024, BATCH = 8, SEQ = 4096, DEPTH = 4, MTOK = BATCH * SEQ;
constexpr int HD = 64, NQH = 8, NKVH = 2, WINDOW = 128;
constexpr int SSM_CH = 16, SSM_G = 32, SSM_P = 64, SSM_W = 512, N_MEM = 256, XH = 4, XHD = 128;
constexpr int MIX_W = 1536, IN_W = 3328;
constexpr int ZQ = 0, ZK = 512, ZV = 640, ZG = 768, ZU = 1280, ZSG = 1792, ZXQ = 2304, ZXG = 2816;
constexpr float EPS = 1e-6f;

typedef unsigned short bf16_t;
__device__ __forceinline__ bf16_t f2bf(float f) { _Float16 h = (_Float16)f; return __builtin_bit_cast(unsigned short, h); }
__device__ __forceinline__ float bf2f(bf16_t h) { return (float)__builtin_bit_cast(_Float16, h); }
__device__ __forceinline__ float sigmoidf_(float x) { return __builtin_amdgcn_rcpf(1.f + __expf(-x)); }
__device__ __forceinline__ float siluf_(float x) { return x * sigmoidf_(x); }
__device__ __forceinline__ float gelu_tanh(float x) { const float c = 0.7978845608028654f; float u = c * (x + 0.044715f * x * x * x); return 0.5f * x * (1.f + tanhf(u)); }
__device__ __forceinline__ float wave_sum(float v) {
#pragma unroll
    for (int o = 1; o < 64; o <<= 1) v += __shfl_xor(v, o);
    return v;
}

constexpr size_t MiB = 1u << 20;
constexpr size_t WS_Z = 0;
constexpr size_t WS_MIX = 208 * MiB;
constexpr size_t WS_XB = 304 * MiB;
constexpr size_t WS_Y2 = 368 * MiB;
constexpr size_t WS_WIN = 400 * MiB;
constexpr size_t WS_WOUT = 426 * MiB;
constexpr size_t WS_WGLU = 438 * MiB;
constexpr size_t WS_WMEM = 440 * MiB;
constexpr size_t WS_MEMB = 448 * MiB;
constexpr size_t WS_MK = 452 * MiB;
constexpr size_t WS_MV = 460 * MiB;
constexpr size_t WS_ROPE = 468 * MiB;
constexpr size_t WS_SSMP = 476 * MiB;
constexpr size_t WS_SUMSQ = 508 * MiB;
constexpr size_t WS_MISC = 510 * MiB;
constexpr size_t WS_END = 511 * MiB;


namespace pg8 {
#define PG8_LAS __attribute__((address_space(3)))
typedef _Float16 f16x8 __attribute__((ext_vector_type(8)));
typedef _Float16 f16x2 __attribute__((ext_vector_type(2)));
typedef float f32x4 __attribute__((ext_vector_type(4)));
typedef unsigned u32x4 __attribute__((ext_vector_type(4)));
typedef unsigned u32x2 __attribute__((ext_vector_type(2)));
constexpr int BM = 256, BK = 64, HALF = 128, HTB = HALF * BK * 2, STAGE_BYTES = 8 * HTB, NXCD = 8, WGM = 8;
__host__ __device__ __forceinline__ int lds_byte(int r, int c) { const int st = (r >> 4) * 2 + (c >> 5), rr = r & 15, cc = c & 31, ob = rr * 64 + cc * 2; return st * 1024 + (ob ^ (((ob >> 9) & 1) << 5)); }
__host__ __device__ __forceinline__ void stage_rc(int b, int& R, int& C) { const int st = b / 1024, sb = b % 1024, swz = sb ^ (((sb >> 9) & 1) << 5); R = (st >> 1) * 16 + swz / 64; C = (st & 1) * 32 + (swz % 64) / 2; }
__host__ __device__ __forceinline__ int perm32(int rho) { const int n = rho >> 4, i = rho & 15; return 8 * (i >> 2) + 4 * n + (i & 3); }
struct Unit { int pm, pn, c0, half; };
struct Gemm { const bf16_t* A; const bf16_t* Bt; int M, N, K; };
struct StaticOrder {
    int nM, nN, nwg, G, c;
    __host__ __device__ void init(int M, int N, int G_, int c_) { nM = M / BM; nN = N / BM; nwg = nM * nN; G = G_; c = c_; }
    __host__ __device__ bool next(int i, Unit& u) const {
        const long L = (long)i * G + c; if (L >= nwg) return false;
        int wgid = (int)L; { const int q = nwg / NXCD, r = nwg % NXCD, xcd = wgid % NXCD, off = wgid / NXCD; wgid = (xcd < r ? xcd * (q + 1) : r * (q + 1) + (xcd - r) * q) + off; }
        const int nig = WGM * nN, gid = wgid / nig, fm = gid * WGM, gsz = (nM - fm) < WGM ? (nM - fm) : WGM;
        u.pm = fm + ((wgid % nig) % gsz); u.pn = (wgid % nig) / gsz; u.c0 = u.pn * BM; u.half = 0; return true;
    }
    __device__ __forceinline__ void a_ready(const Unit&) const {}
    __device__ __forceinline__ void done(const Unit&) const {}
};
struct TailOrder : StaticOrder {
    __host__ __device__ bool next(int i, Unit& u) const {
        const int full = nwg / G, left = nwg - full * G;
        if (i < full || 2 * left > G) return StaticOrder::next(i, u);
        if (i > full || c >= 2 * left) return false;
        StaticOrder t = *this; t.c = c >> 1;
        (void)t.StaticOrder::next(full, u);
        u.c0 += 128 * (c & 1); u.half = 1; return true;
    }
};
struct SkipOrder : StaticOrder {
    int skip;
    __host__ __device__ void init2(int M, int N, int G_, int c_, int skip_) { init(M, N - BM, G_, c_); skip = skip_; }
    __host__ __device__ bool next(int i, Unit& u) const { if (!StaticOrder::next(i, u)) return false; if (u.pn >= skip) { u.pn += 1; u.c0 = u.pn * BM; } return true; }
};
struct DeferOrder {
    int nM, pn, G, c;
    __host__ __device__ void init(int M, int G_, int c_, int pn_) { nM = M / BM; G = G_; c = c_; pn = pn_; }
    __host__ __device__ bool next(int i, Unit& u) const { const int L = i * G + c; if (L >= nM) return false; u.pm = L; u.pn = pn; u.c0 = pn * BM; u.half = 0; return true; }
    __device__ __forceinline__ void a_ready(const Unit&) const {}
    __device__ __forceinline__ void done(const Unit&) const {}
};
struct MemTailOrder {
    int k, stride, nM, nwg;
    __host__ __device__ void init(int M, int N, int G, int c, int first) { nM = M / BM; nwg = nM * (N / BM); k = c - first; stride = G - first; }
    __host__ __device__ bool next(int i, Unit& u) const {
        if (k < 0) return false;
        const int L = i * stride + k; if (L >= nwg) return false;
        u.pm = L % nM; u.pn = L / nM; u.c0 = u.pn * BM; u.half = 0; return true;
    }
    __device__ __forceinline__ void a_ready(const Unit&) const {}
    __device__ __forceinline__ void done(const Unit&) const {}
};
__device__ __forceinline__ unsigned pk_f16(float lo, float hi) { f16x2 v = {(_Float16)lo, (_Float16)hi}; return __builtin_bit_cast(unsigned, v); }
__device__ __forceinline__ float h_lo(unsigned w) { return (float)__builtin_bit_cast(_Float16, (unsigned short)(w & 0xffffu)); }
__device__ __forceinline__ float h_hi(unsigned w) { return (float)__builtin_bit_cast(_Float16, (unsigned short)(w >> 16)); }

struct EpiZ {
    static constexpr bool PERM = true, AFTER_DRAIN = false;
    bf16_t* Z; const float* sumsq; const bf16_t* rope; const float* qg; const float* kg;
    __device__ __forceinline__ void operator()(const f32x4 (&acc)[2][2][4][2], const Unit& u, int wr, int wc, int fr, int fq) const {
        const int row0 = u.pm * BM + wr * 64 + fr, cw = u.c0 + wc * 64, col0 = cw + 8 * fq;
        const bool is_q = cw < ZK, is_k = (cw >= ZK) && (cw < ZV), is_gate = (cw >= ZG && cw < ZU) || (cw >= ZSG && cw < ZXQ) || (cw >= ZXG);
        f32x4 g0a = {1.f, 1.f, 1.f, 1.f}, g0b = g0a, g1a = g0a, g1b = g0a; float qs = 1.f;
        if (is_q || is_k) { const float* g = is_q ? qg : kg; g0a = *(const f32x4*)(g + 8 * fq); g0b = *(const f32x4*)(g + 8 * fq + 4); g1a = *(const f32x4*)(g + 32 + 8 * fq); g1b = *(const f32x4*)(g + 36 + 8 * fq);
            if (is_q) qs = 0.125f * 1.4426950408889634f; }
#pragma unroll
        for (int ai = 0; ai < 2; ++ai)
#pragma unroll
            for (int m = 0; m < 4; ++m) { const int r = row0 + ai * HALF + m * 16;
                const f32x4* sp = (const f32x4*)(sumsq + (size_t)r * 16); const f32x4 s0 = sp[0], s1 = sp[1], s2 = sp[2], s3 = sp[3];
                const float ss = ((s0[0] + s0[1]) + (s0[2] + s0[3])) + ((s1[0] + s1[1]) + (s1[2] + s1[3])) + ((s2[0] + s2[1]) + (s2[2] + s2[3])) + ((s3[0] + s3[1]) + (s3[2] + s3[3]));
                const float rs = rsqrtf(ss * (1.f / D_MODEL) + EPS);
                f32x4 a0 = acc[ai][0][m][0] * rs, a1 = acc[ai][0][m][1] * rs, b0 = acc[ai][1][m][0] * rs, b1 = acc[ai][1][m][1] * rs;
                if (is_q || is_k) {
                    float hs = ((a0[0] * a0[0] + a0[1] * a0[1]) + (a0[2] * a0[2] + a0[3] * a0[3])) + ((a1[0] * a1[0] + a1[1] * a1[1]) + (a1[2] * a1[2] + a1[3] * a1[3]))
                             + ((b0[0] * b0[0] + b0[1] * b0[1]) + (b0[2] * b0[2] + b0[3] * b0[3])) + ((b1[0] * b1[0] + b1[1] * b1[1]) + (b1[2] * b1[2] + b1[3] * b1[3]));
                    hs += __shfl_xor(hs, 16); hs += __shfl_xor(hs, 32);
                    const float rn = rsqrtf(hs * (1.f / HD) + EPS);
                    const u32x4 cv = *(const u32x4*)(rope + (size_t)r * 64 + 8 * fq), sv = *(const u32x4*)(rope + (size_t)r * 64 + 32 + 8 * fq);
                    a0 = a0 * g0a * rn; a1 = a1 * g0b * rn; b0 = b0 * g1a * rn; b1 = b1 * g1b * rn;
                    const f32x4 c0 = {h_lo(cv.x), h_hi(cv.x), h_lo(cv.y), h_hi(cv.y)}, c1 = {h_lo(cv.z), h_hi(cv.z), h_lo(cv.w), h_hi(cv.w)};
                    const f32x4 n0 = {h_lo(sv.x), h_hi(sv.x), h_lo(sv.y), h_hi(sv.y)}, n1 = {h_lo(sv.z), h_hi(sv.z), h_lo(sv.w), h_hi(sv.w)};
                    const f32x4 ra0 = (a0 * c0 - b0 * n0) * qs, ra1 = (a1 * c1 - b1 * n1) * qs, rb0 = (b0 * c0 + a0 * n0) * qs, rb1 = (b1 * c1 + a1 * n1) * qs;
                    a0 = ra0; a1 = ra1; b0 = rb0; b1 = rb1;
                } else if (is_gate) {
#pragma unroll
                    for (int j = 0; j < 4; ++j) { a0[j] = a0[j] * sigmoidf_(a0[j]); a1[j] = a1[j] * sigmoidf_(a1[j]); b0[j] = b0[j] * sigmoidf_(b0[j]); b1[j] = b1[j] * sigmoidf_(b1[j]); }
                }
                bf16_t* rowp = Z + (size_t)r * IN_W + col0;
                u32x4 w; w.x = pk_f16(a0[0], a0[1]); w.y = pk_f16(a0[2], a0[3]); w.z = pk_f16(a1[0], a1[1]); w.w = pk_f16(a1[2], a1[3]); *(u32x4*)(rowp) = w;
                w.x = pk_f16(b0[0], b0[1]); w.y = pk_f16(b0[2], b0[3]); w.z = pk_f16(b1[0], b1[1]); w.w = pk_f16(b1[2], b1[3]); *(u32x4*)(rowp + 32) = w; }
    }
};
struct EpiGlu {
    static constexpr bool PERM = true, AFTER_DRAIN = false;
    const bf16_t* Y2; const bf16_t* Z; const float* bg; bf16_t* MIX;
    __device__ __forceinline__ void operator()(const f32x4 (&acc)[2][2][4][2], const Unit& u, int wr, int wc, int fr, int fq) const {
        const int row0 = u.pm * BM + wr * 64 + fr, col0 = u.c0 + wc * 64 + 8 * fq;
#pragma unroll
        for (int bj = 0; bj < 2; ++bj) { const int c = col0 + bj * 32;
            const f32x4 b0 = *(const f32x4*)(bg + c), b1 = *(const f32x4*)(bg + c + 4);
#pragma unroll
            for (int ai = 0; ai < 2; ++ai)
#pragma unroll
                for (int m = 0; m < 4; ++m) { const int r = row0 + ai * HALF + m * 16;
                    const u32x4 yv = *(const u32x4*)(Y2 + (size_t)r * SSM_W + c), sv = *(const u32x4*)(Z + (size_t)r * IN_W + ZSG + c);
                    const f32x4 a0 = acc[ai][bj][m][0] + b0, a1 = acc[ai][bj][m][1] + b1;
                    float o[8];
#pragma unroll
                    for (int j = 0; j < 4; ++j) { const unsigned yw = yv[j], sw = sv[j];
                        const float g0 = (j < 2) ? a0[2 * j] : a1[2 * j - 4], g1 = (j < 2) ? a0[2 * j + 1] : a1[2 * j - 3];
                        o[2 * j] = h_lo(yw) * sigmoidf_(g0) * h_lo(sw); o[2 * j + 1] = h_hi(yw) * sigmoidf_(g1) * h_hi(sw); }
                    u32x4 w; w.x = pk_f16(o[0], o[1]); w.y = pk_f16(o[2], o[3]); w.z = pk_f16(o[4], o[5]); w.w = pk_f16(o[6], o[7]);
                    *(u32x4*)(MIX + (size_t)r * MIX_W + 512 + c) = w; } }
    }
};
template <int MODE> struct EpiOut {
    static constexpr bool PERM = true, AFTER_DRAIN = false;
    const float* xin; float* xout; bf16_t* XB; float* sumsq;
    __device__ __forceinline__ void operator()(const f32x4 (&acc)[2][2][4][2], const Unit& u, int wr, int wc, int fr, int fq) const {
        const int row0 = u.pm * BM + wr * 64 + fr, col0 = u.c0 + wc * 64 + 8 * fq;
#pragma unroll
        for (int ai = 0; ai < 2; ++ai)
#pragma unroll
            for (int m = 0; m < 4; ++m) { const int r = row0 + ai * HALF + m * 16; const size_t off = (size_t)r * D_MODEL + col0; float ss = 0.f;
#pragma unroll
                for (int bj = 0; bj < 2; ++bj) { f32x4 x0, x1;
                    if (MODE == 0) { x0 = *(const f32x4*)(xin + off + bj * 32); x1 = *(const f32x4*)(xin + off + bj * 32 + 4); }
                    else { const u32x4 xv = *(const u32x4*)(XB + off + bj * 32); x0 = (f32x4){h_lo(xv.x), h_hi(xv.x), h_lo(xv.y), h_hi(xv.y)}; x1 = (f32x4){h_lo(xv.z), h_hi(xv.z), h_lo(xv.w), h_hi(xv.w)}; }
                    const f32x4 o0 = x0 + acc[ai][bj][m][0], o1 = x1 + acc[ai][bj][m][1];
                    if (MODE == 2) { *(f32x4*)(xout + off + bj * 32) = o0; *(f32x4*)(xout + off + bj * 32 + 4) = o1; }
                    else { u32x4 w; w.x = pk_f16(o0[0], o0[1]); w.y = pk_f16(o0[2], o0[3]); w.z = pk_f16(o1[0], o1[1]); w.w = pk_f16(o1[2], o1[3]); *(u32x4*)(XB + off + bj * 32) = w;
                        ss += ((o0[0] * o0[0] + o0[1] * o0[1]) + (o0[2] * o0[2] + o0[3] * o0[3])) + ((o1[0] * o1[0] + o1[1] * o1[1]) + (o1[2] * o1[2] + o1[3] * o1[3])); } }
                if (MODE != 2) { ss += __shfl_xor(ss, 16); ss += __shfl_xor(ss, 32);
                    if (fq == 0) sumsq[(size_t)r * 16 + (u.c0 >> 8) * 4 + wc] = ss; } }
    }
};
struct EpiMemF32 {
    static constexpr bool PERM = false, AFTER_DRAIN = false;
    float* C; int ldc; const float* rstd;
    __device__ __forceinline__ void operator()(const f32x4 (&acc)[2][2][4][2], const Unit& u, int wr, int wc, int fr, int fq) const {
        const int row0 = u.pm * BM + wr * 64 + fr, col0 = u.c0 + wc * 32 + 4 * fq;
#pragma unroll
        for (int ai = 0; ai < 2; ++ai)
#pragma unroll
            for (int m = 0; m < 4; ++m) { const int r = row0 + ai * HALF + m * 16; const float rs = rstd[r]; float* rowp = C + (size_t)r * ldc + col0;
#pragma unroll
                for (int bj = 0; bj < 2; ++bj)
#pragma unroll
                    for (int n = 0; n < 2; ++n) *(f32x4*)(rowp + bj * HALF + n * 16) = acc[ai][bj][m][n] * rs; }
    }
};

template <class Epi, class Sched, bool ALIGN_EPI>
__device__ __forceinline__ void gemm_phase(PG8_LAS unsigned char* lds, const Gemm g, const Sched& S, const Epi& E) {
    int tid = threadIdx.x; asm volatile("" : "+v"(tid)); const int wid = __builtin_amdgcn_readfirstlane(tid >> 6), lane = tid & 63, wr = wid >> 2, wc = wid & 3, fr = lane & 15, fq = lane >> 4;
    const int K = g.K, nt = K / BK;
    unsigned voffA[2], voffB[2];
#pragma unroll
    for (int i = 0; i < 2; ++i) { int R, C; stage_rc(tid * 16 + i * 8192, R, C); const int Rb = Epi::PERM ? (64 * (R >> 5) + perm32(R & 31)) : R;
        voffA[i] = (unsigned)(R * K + C) * 2u; voffB[i] = (unsigned)(Rb * K + C) * 2u; }
    const size_t kstep = (size_t)(BK * 2);
    const size_t hstep = (size_t)HALF * K * 2;
    const size_t tstep = 2 * hstep;
    const size_t bhs = Epi::PERM ? (size_t)32 * K * 2 : hstep;
    const unsigned ldsw = (unsigned)wid * 1024u;
    const int aoff = lds_byte(wr * 64 + fr, fq * 8), boff = lds_byte(wc * 32 + fr, fq * 8);
#define PG8_SA(b, h) (((b) * 2 + (h)) * HTB)
#define PG8_SB(b, h) ((4 + (b) * 2 + (h)) * HTB)
#define PG8_STAGE(bufoff, gbase, voff) do { _Pragma("unroll") for (int _i = 0; _i < 2; ++_i) \
        __builtin_amdgcn_global_load_lds((const unsigned*)((const char*)(gbase) + (voff)[_i]), (PG8_LAS unsigned*)(lds + (bufoff) + ldsw + _i * 8192), 16, 0, 0); } while (0)
#define PG8_LDA(dst, b, h) do { _Pragma("unroll") for (int m = 0; m < 4; ++m) _Pragma("unroll") for (int k = 0; k < 2; ++k) dst[m][k] = *(const PG8_LAS f16x8*)(lds + PG8_SA(b, h) + aoff + m * 2048 + k * 1024); } while (0)
#define PG8_LDB(dst, b, h) do { _Pragma("unroll") for (int n = 0; n < 2; ++n) _Pragma("unroll") for (int k = 0; k < 2; ++k) dst[n][k] = *(const PG8_LAS f16x8*)(lds + PG8_SB(b, h) + boff + n * 2048 + k * 1024); } while (0)
#define PG8_MMA(ai, bj, At, Bt) do { __builtin_amdgcn_s_setprio(1); _Pragma("unroll") for (int m = 0; m < 4; ++m) _Pragma("unroll") for (int n = 0; n < 2; ++n) _Pragma("unroll") for (int k = 0; k < 2; ++k) \
        acc[ai][bj][m][n] = __builtin_amdgcn_mfma_f32_16x16x32_f16(Bt[n][k], At[m][k], acc[ai][bj][m][n], 0, 0, 0); __builtin_amdgcn_s_setprio(0); } while (0)
#define PG8_WAIT_V(n) asm volatile("s_waitcnt vmcnt(" #n ")" ::: "memory")
#define PG8_WAIT_L(n) asm volatile("s_waitcnt lgkmcnt(" #n ")" ::: "memory")
#define PG8_BAR __builtin_amdgcn_s_barrier()
#define PG8_SCHED __builtin_amdgcn_sched_barrier(0)
    Unit cur, nxt; int ui = 0;
    if (!S.next(0, cur)) return;
    f32x4 acc[2][2][4][2];
#pragma unroll
    for (int a = 0; a < 2; ++a)
#pragma unroll
        for (int b = 0; b < 2; ++b)
#pragma unroll
            for (int m = 0; m < 4; ++m)
#pragma unroll
                for (int n = 0; n < 2; ++n) acc[a][b][m][n] = (f32x4){0.f, 0.f, 0.f, 0.f};
    f16x8 At[4][2], B0[2][2], B1[2][2];
    const char* cA = (const char*)g.A + (size_t)cur.pm * tstep; const char* cB = (const char*)g.Bt + (size_t)cur.c0 * K * 2;
    S.a_ready(cur);
    PG8_STAGE(PG8_SB(0, 0), cB, voffB); PG8_STAGE(PG8_SB(0, 1), cB + bhs, voffB); PG8_STAGE(PG8_SA(0, 0), cA, voffA); PG8_STAGE(PG8_SA(0, 1), cA + hstep, voffA);
    if (wr == 1) PG8_BAR;
    PG8_WAIT_V(2); PG8_BAR;
    PG8_STAGE(PG8_SB(1, 0), cB + kstep, voffB); PG8_STAGE(PG8_SA(1, 0), cA + kstep, voffA); PG8_STAGE(PG8_SB(1, 1), cB + bhs + kstep, voffB);
    PG8_WAIT_V(6); PG8_BAR;
    for (;;) {
        const bool has_next = S.next(ui + 1, nxt);
        const char* nA = has_next ? (const char*)g.A + (size_t)nxt.pm * tstep : cA; const char* nB = has_next ? (const char*)g.Bt + (size_t)nxt.c0 * K * 2 : cB;
        for (int t = 0; t < nt; t += 2) {
            const bool last = (t == nt - 2);
            const char* a1 = cA + (size_t)(t + 1) * kstep;
            const char* a2 = last ? nA : cA + (size_t)(t + 2) * kstep; const char* b2 = last ? nB : cB + (size_t)(t + 2) * kstep;
            const char* a3 = a2 + kstep; const char* b3 = b2 + kstep;
            if (last && has_next) S.a_ready(nxt);
            PG8_LDB(B0, 0, 0); PG8_LDB(B1, 0, 1); PG8_SCHED; PG8_LDA(At, 0, 0); PG8_STAGE(PG8_SA(1, 1), a1 + hstep, voffA);
            PG8_WAIT_V(8); PG8_WAIT_L(0); PG8_BAR; PG8_MMA(0, 0, At, B0); if (!cur.half) PG8_MMA(0, 1, At, B1); PG8_BAR; PG8_SCHED;
            PG8_LDA(At, 0, 1); PG8_STAGE(PG8_SB(0, 0), b2, voffB); PG8_STAGE(PG8_SB(0, 1), b2 + bhs, voffB); PG8_STAGE(PG8_SA(0, 0), a2, voffA);
            PG8_WAIT_V(8); PG8_WAIT_L(0); PG8_BAR; PG8_MMA(1, 0, At, B0); if (!cur.half) PG8_MMA(1, 1, At, B1); PG8_BAR; PG8_SCHED;
            PG8_LDB(B0, 1, 0); PG8_LDB(B1, 1, 1); PG8_SCHED; PG8_LDA(At, 1, 0); PG8_STAGE(PG8_SA(0, 1), a2 + hstep, voffA);
            PG8_WAIT_V(8); PG8_WAIT_L(0); PG8_BAR; PG8_MMA(0, 0, At, B0); if (!cur.half) PG8_MMA(0, 1, At, B1); PG8_BAR; PG8_SCHED;
            PG8_LDA(At, 1, 1); PG8_STAGE(PG8_SB(1, 0), b3, voffB); PG8_STAGE(PG8_SB(1, 1), b3 + bhs, voffB); PG8_STAGE(PG8_SA(1, 0), a3, voffA);
            PG8_WAIT_V(8); PG8_WAIT_L(0); PG8_BAR; PG8_MMA(1, 0, At, B0); if (!cur.half) PG8_MMA(1, 1, At, B1); PG8_BAR; PG8_SCHED;
        }
        if constexpr (ALIGN_EPI) { if (wr == 0) PG8_BAR; }
        E(acc, cur, wr, wc, fr, fq); S.done(cur);
        if (!has_next) break;
#pragma unroll
        for (int a = 0; a < 2; ++a)
#pragma unroll
            for (int b = 0; b < 2; ++b)
#pragma unroll
                for (int m = 0; m < 4; ++m)
#pragma unroll
                    for (int n = 0; n < 2; ++n) acc[a][b][m][n] = (f32x4){0.f, 0.f, 0.f, 0.f};
        cur = nxt; cA = nA; cB = nB; ++ui;
        if constexpr (ALIGN_EPI) { if (wr == 1) PG8_BAR; }
    }
    PG8_WAIT_V(0);
    if constexpr (!ALIGN_EPI) { if (wr == 0) PG8_BAR; }
    PG8_BAR;
#undef PG8_SA
#undef PG8_SB
#undef PG8_STAGE
#undef PG8_LDA
#undef PG8_LDB
#undef PG8_MMA
#undef PG8_WAIT_V
#undef PG8_WAIT_L
#undef PG8_BAR
#undef PG8_SCHED
}
}

constexpr int NWAVES = 8, NTHREADS = 512;
constexpr int LDS_BYTES = 155648;
constexpr int LDSCTL_OFF = 154624;
#define LAS __attribute__((address_space(3)))
typedef unsigned v4u __attribute__((ext_vector_type(4)));
typedef float f32x4 __attribute__((ext_vector_type(4)));

struct Params {
    const float* x; const float* mem; const int* pos; const float* norm_g; const float* w_in; const float* q_norm_g; const float* k_norm_g; const float* sinks;
    const float* lam_re; const float* lam_im; const float* log_dt; const float* b_re; const float* b_im; const float* c_re; const float* c_im; const float* d_skip;
    const float* w_glu; const float* b_glu; const float* mem_norm_g; const float* w_mem_kv; const float* xq_norm_g; const float* xk_norm_g; const float* w_out;
    float* out; unsigned char* ws;
};

__device__ __forceinline__ void p0_transpose_item(const float* W, int K, int N, const float* scale, bf16_t* WT, LAS float* scr, int item, int lane) {
    const int nblk = N / 64, kb = item / nblk, nb = item % nblk, k0 = 64 * kb, n0 = 64 * nb;
    const int lr = lane >> 4, lc = (lane & 15) * 4;
#pragma unroll 4
    for (int i = 0; i < 16; ++i) { const int kk = 4 * i + lr; const float sc = scale ? scale[k0 + kk] : 1.f; const f32x4 v = *(const f32x4*)(W + (size_t)(k0 + kk) * N + n0 + lc);
        LAS float* d = scr + kk * 65 + lc; d[0] = v[0] * sc; d[1] = v[1] * sc; d[2] = v[2] * sc; d[3] = v[3] * sc; }
    asm volatile("s_waitcnt lgkmcnt(0)" ::: "memory");
    const int c = lane & 7;
#pragma unroll
    for (int j = 0; j < 8; ++j) { const int n = (lane >> 3) + 8 * j; const LAS float* s = scr + (8 * c) * 65 + n;
        v4u o; o.x = pg8::pk_f16(s[0 * 65], s[1 * 65]); o.y = pg8::pk_f16(s[2 * 65], s[3 * 65]); o.z = pg8::pk_f16(s[4 * 65], s[5 * 65]); o.w = pg8::pk_f16(s[6 * 65], s[7 * 65]);
        *(v4u*)(WT + (size_t)(n0 + n) * K + k0 + 8 * c) = o; }
    asm volatile("s_waitcnt lgkmcnt(0)" ::: "memory");
}
__device__ __forceinline__ void phase_prep(const Params& P, LAS unsigned char* lds, int vcu, int G) {
    int tid = threadIdx.x; asm volatile("" : "+v"(tid)); const int lane = tid & 63, wave = __builtin_amdgcn_readfirstlane(tid >> 6);
    LAS float* scr = (LAS float*)(lds + wave * 16640);
    const int gw = vcu * NWAVES + wave, NGW = G * NWAVES;
    unsigned char* ws = P.ws;
    constexpr int I_IN = (D_MODEL / 64) * (IN_W / 64), I_OUT = (MIX_W / 64) * (D_MODEL / 64), I_GLU = (SSM_W / 64) * (SSM_W / 64), I_MEM = (D_MODEL / 64) * (1024 / 64);
    constexpr int I_LAYER = I_IN + I_OUT + I_GLU + I_MEM;
    for (int it = gw; it < DEPTH * I_LAYER; it += NGW) {
        const int l = it / I_LAYER; int r = it % I_LAYER;
        if (r < I_IN) { p0_transpose_item(P.w_in + (size_t)l * D_MODEL * IN_W, D_MODEL, IN_W, P.norm_g + l * D_MODEL, (bf16_t*)(ws + WS_WIN) + (size_t)l * IN_W * D_MODEL, scr, r, lane); continue; } r -= I_IN;
        if (r < I_OUT) { p0_transpose_item(P.w_out + (size_t)l * MIX_W * D_MODEL, MIX_W, D_MODEL, nullptr, (bf16_t*)(ws + WS_WOUT) + (size_t)l * D_MODEL * MIX_W, scr, r, lane); continue; } r -= I_OUT;
        if (r < I_GLU) { p0_transpose_item(P.w_glu + (size_t)l * SSM_W * SSM_W, SSM_W, SSM_W, nullptr, (bf16_t*)(ws + WS_WGLU) + (size_t)l * SSM_W * SSM_W, scr, r, lane); continue; } r -= I_GLU;
        p0_transpose_item(P.w_mem_kv + (size_t)l * D_MODEL * 1024, D_MODEL, 1024, P.mem_norm_g + l * D_MODEL, (bf16_t*)(ws + WS_WMEM) + (size_t)l * 1024 * D_MODEL, scr, r, lane);
    }
    for (int m = gw; m < MTOK + BATCH * N_MEM; m += NGW) {
        const bool is_x = m < MTOK; const int row = is_x ? m : m - MTOK;
        const f32x4* xr = (const f32x4*)((is_x ? P.x : P.mem) + (size_t)row * D_MODEL) + lane;
        bf16_t* ob = (bf16_t*)(ws + (is_x ? WS_XB : WS_MEMB)) + (size_t)row * D_MODEL;
        f32x4 v[4]; float s = 0.f;
#pragma unroll
        for (int j = 0; j < 4; ++j) { v[j] = xr[64 * j]; s += (v[j][0] * v[j][0] + v[j][1] * v[j][1]) + (v[j][2] * v[j][2] + v[j][3] * v[j][3]); }
        s = wave_sum(s);
#pragma unroll
        for (int j = 0; j < 4; ++j) { pg8::u32x2 w; w.x = pg8::pk_f16(v[j][0], v[j][1]); w.y = pg8::pk_f16(v[j][2], v[j][3]); *((pg8::u32x2*)ob + lane + 64 * j) = w; }
        if (is_x) { if (lane < 16) ((float*)(ws + WS_SUMSQ))[(size_t)row * 16 + lane] = (lane == 0) ? s : 0.f; }
        else if (lane == 0) ((float*)(ws + WS_MISC))[row] = rsqrtf(s * (1.f / D_MODEL) + EPS);
    }
    { bf16_t* tab = (bf16_t*)(ws + WS_ROPE);
      for (int idx = vcu * NTHREADS + tid; idx < MTOK * 32; idx += G * NTHREADS) { const int tok = idx >> 5, i = idx & 31;
          const float inv = powf(10000.0f, -(float)i / 32.0f); const float ang = (float)P.pos[tok] * inv; const double a = (double)ang;
          tab[tok * 64 + i] = f2bf((float)cos(a)); tab[tok * 64 + 32 + i] = f2bf((float)sin(a)); } }
}


typedef _Float16 f16x8 __attribute__((ext_vector_type(8)));
typedef float f32x16 __attribute__((ext_vector_type(16)));
__device__ __forceinline__ int crow(int r, int hi) { return (r & 3) + 8 * (r >> 2) + 4 * hi; }
__device__ __forceinline__ float hf(_Float16 h) { return (float)h; }
constexpr float LOG2E = 1.4426950408889634f;
__device__ __forceinline__ f16x8 pack8(const f32x16& p, int s) { f16x8 r;
#pragma unroll
    for (int j = 0; j < 8; ++j) r[j] = (_Float16)p[8 * s + j];
    return r; }


__device__ __forceinline__ void stage_tile(LAS unsigned char* st, int pitchB, int colOff, const f32x16& o, int c, int hi) {
#pragma unroll
    for (int r = 0; r < 16; ++r) *(LAS _Float16*)(st + crow(r, hi) * pitchB + (colOff + c) * 2) = (_Float16)o[r];
}

typedef unsigned v2u __attribute__((ext_vector_type(2)));
__device__ __forceinline__ void stage_ot(LAS unsigned char* st, int pitchB, int colOff, const f32x16& o, float sc, int q, int hi) {
#pragma unroll
    for (int g4 = 0; g4 < 4; ++g4) { v2u w; w.x = pg8::pk_f16(o[4 * g4] * sc, o[4 * g4 + 1] * sc); w.y = pg8::pk_f16(o[4 * g4 + 2] * sc, o[4 * g4 + 3] * sc);
        *(LAS v2u*)(st + q * pitchB + (colOff + 8 * g4 + 4 * hi) * 2) = w; }
}
__device__ __forceinline__ void stage_ot2(LAS unsigned char* st, int pitchB, int colOff, const f32x16& o0, float s0, const f32x16& o1, float s1, int q, int hi) {
#pragma unroll
    for (int g4 = 0; g4 < 4; ++g4) { v2u w; w.x = pg8::pk_f16(o0[4 * g4] * s0 + o1[4 * g4] * s1, o0[4 * g4 + 1] * s0 + o1[4 * g4 + 1] * s1); w.y = pg8::pk_f16(o0[4 * g4 + 2] * s0 + o1[4 * g4 + 2] * s1, o0[4 * g4 + 3] * s0 + o1[4 * g4 + 3] * s1);
        *(LAS v2u*)(st + q * pitchB + (colOff + 8 * g4 + 4 * hi) * 2) = w; }
}
__device__ __forceinline__ v4u pk_mul8(v4u a, v4u b) { return __builtin_bit_cast(v4u, __builtin_bit_cast(f16x8, a) * __builtin_bit_cast(f16x8, b)); }
__device__ __forceinline__ float silu_fast(float x) { return x * __builtin_amdgcn_rcpf(1.f + __expf(-x)); }
constexpr int ATT_KF = 0, ATT_VF = 32768, ATT_ST = 65536;
__device__ __forceinline__ int opaque_tid() { int t = threadIdx.x; asm volatile("" : "+v"(t)); return t; }
__device__ __forceinline__ void attn_a_item(const Params& P, int layer, LAS unsigned char* lds, int item) {
    const int tid = opaque_tid(), lane = tid & 63, wave = __builtin_amdgcn_readfirstlane(tid >> 6);
    const int kvh = item & 1, blk = (item >> 1) & 31, b = item >> 6;
    const bf16_t* Z = (const bf16_t*)(P.ws + WS_Z); bf16_t* MIX = (bf16_t*)(P.ws + WS_MIX); const bf16_t* rope = (const bf16_t*)(P.ws + WS_ROPE);
    const float* kg = P.k_norm_g + layer * HD; const float* qg = P.q_norm_g + layer * HD;
    {
        const int key = tid >> 1, hh = tid & 1, tpos = blk * 128 - 128 + key; const bool valid = tpos >= 0;
        const int tok = b * SEQ + (valid ? tpos : 0);
        const bf16_t* zr = Z + (size_t)tok * IN_W;
        const int kt = key >> 5, kl = key & 31;
#pragma unroll
        for (int i = 0; i < 2; ++i) { const int c = 2 * hh + i;
            f16x8 o1 = *(const f16x8*)(zr + ZK + kvh * HD + 8 * c), o2 = *(const f16x8*)(zr + ZK + kvh * HD + 32 + 8 * c);
            if (!valid) { o1 = (f16x8){0, 0, 0, 0, 0, 0, 0, 0}; o2 = o1; }
            { const int cc = c;     *(LAS f16x8*)(lds + ATT_KF + (((kt * 4 + (cc >> 1)) * 64) + kl + 32 * (cc & 1)) * 16) = o1; }
            { const int cc = c + 4; *(LAS f16x8*)(lds + ATT_KF + (((kt * 4 + (cc >> 1)) * 64) + kl + 32 * (cc & 1)) * 16) = o2; } }
        const int sK = kl >> 4, h2 = ((kl & 15) >> 2) & 1, jj = 4 * ((kl & 15) >> 3) + (kl & 3);
        LAS unsigned short* vb = (LAS unsigned short*)(lds + ATT_VF + ((((kt * 2 + hh) * 2 + sK) * 64) + 32 * h2) * 16 + 2 * jj);
#pragma unroll
        for (int i = 0; i < 4; ++i) { const v4u v = *(const v4u*)(zr + ZV + kvh * HD + 32 * hh + 8 * i);
#pragma unroll
            for (int j = 0; j < 8; ++j) { const unsigned wv = v[j >> 1]; vb[(8 * i + j) * 8] = valid ? (unsigned short)((j & 1) ? (wv >> 16) : (wv & 0xffffu)) : (unsigned short)0; } }
    }
    const int ql = lane & 31, hi = lane >> 5;
    f16x8 qfu[2][4];
#pragma unroll
    for (int ui = 0; ui < 2; ++ui) {
        const int head = 2 * (wave >> 2) + ui, w = wave & 3, hq = kvh * 4 + head;
        const int tq = b * SEQ + blk * 128 + 32 * w + ql;
        const bf16_t* zq = Z + (size_t)tq * IN_W + ZQ + hq * HD;
#pragma unroll
        for (int d0 = 0; d0 < 4; ++d0) qfu[ui][d0] = *(const f16x8*)(zq + 16 * d0 + 8 * hi);
    }
    __syncthreads();
#pragma unroll
    for (int ui = 0; ui < 2; ++ui) {
        const int head = 2 * (wave >> 2) + ui, w = wave & 3, hq = kvh * 4 + head;
        const f16x8* qf = qfu[ui];
        const int erow = lane >> 1, ehs = lane & 1; const size_t etok = (size_t)b * SEQ + blk * 128 + 32 * w + erow; const int ecol = hq * HD + 32 * ehs;
        v4u gv[4];
#pragma unroll
        for (int i = 0; i < 4; ++i) gv[i] = *(const v4u*)(Z + etok * IN_W + ZG + ecol + 8 * i);
        f32x16 p[5];
#pragma unroll
        for (int t = 0; t < 5; ++t) { const int kt = w + t; f32x16 acc = {};
#pragma unroll
            for (int d0 = 0; d0 < 4; ++d0) { const f16x8 kf = *(const LAS f16x8*)(lds + ATT_KF + ((kt * 4 + d0) * 64 + lane) * 16);
                acc = __builtin_amdgcn_mfma_f32_32x32x16_f16(kf, qf[d0], acc, 0, 0, 0); }
            p[t] = acc; }
        float mx = -INFINITY;
        int qlv = ql; asm volatile("" : "+v"(qlv));
#pragma unroll
        for (int t = 0; t < 5; ++t) { const bool tile_off = (blk == 0) && (w + t < 4);
#pragma unroll
            for (int r = 0; r < 16; ++r) { bool ok = !tile_off; if (t == 0) ok = ok && (crow(r, hi) > qlv); if (t == 4) ok = ok && (crow(r, hi) <= qlv);
                const float v = ok ? p[t][r] : -INFINITY; p[t][r] = v; mx = fmaxf(mx, v); } }
        mx = fmaxf(mx, __shfl_xor(mx, 32));
        const float sink2 = P.sinks[layer * NQH + hq] * LOG2E;
        mx = fmaxf(mx, sink2);
        float l = 0.f;
#pragma unroll
        for (int t = 0; t < 5; ++t)
#pragma unroll
            for (int r = 0; r < 16; ++r) { const float e = __builtin_amdgcn_exp2f(p[t][r] - mx); p[t][r] = e; l += e; }
        l += __shfl_xor(l, 32);
        l += __builtin_amdgcn_exp2f(sink2 - mx);
        const float linv = __builtin_amdgcn_rcpf(l);
        f32x16 o[2] = {};
#pragma unroll
        for (int t = 0; t < 5; ++t) { const int kt = w + t;
#pragma unroll
            for (int s2 = 0; s2 < 2; ++s2) { const f16x8 pa = pack8(p[t], s2);
#pragma unroll
                for (int db = 0; db < 2; ++db) { const f16x8 vf = *(const LAS f16x8*)(lds + ATT_VF + (((kt * 2 + db) * 2 + s2) * 64 + lane) * 16);
                    o[db] = __builtin_amdgcn_mfma_f32_32x32x16_f16(vf, pa, o[db], 0, 0, 0); } } }
        { LAS unsigned char* st = lds + ATT_ST + wave * 4608;
          stage_ot(st, 144, 0, o[0], linv, ql, hi); stage_ot(st, 144, 32, o[1], linv, ql, hi);
#pragma unroll
          for (int i = 0; i < 4; ++i) { const v4u ov = *(const LAS v4u*)(st + erow * 144 + ehs * 64 + 16 * i);
              *(v4u*)(MIX + etok * MIX_W + ecol + 8 * i) = pk_mul8(ov, gv[i]); } }
    }
    __syncthreads();
}
__device__ __forceinline__ void phase_attn_a(const Params& P, int layer, LAS unsigned char* lds, int vcu, int G, int bx, bool defer) {
    if (defer) {
        if (bx < 128) attn_a_item(P, layer, lds, bx);
        else for (int j = 0; j < 3; ++j) attn_a_item(P, layer, lds, 128 + 3 * (bx - 128) + j);
        return; }
    for (int it = vcu; it < BATCH * 32 * NKVH; it += G) attn_a_item(P, layer, lds, it);
}

__device__ __forceinline__ void attn_c_item(const Params& P, int layer, LAS unsigned char* lds, int item) {
    const int tid = opaque_tid(), lane = tid & 63, wave = __builtin_amdgcn_readfirstlane(tid >> 6);
    const int sblk = item & 7, h = (item >> 3) & 3, b = item >> 5;
    const bf16_t* Z = (const bf16_t*)(P.ws + WS_Z); bf16_t* MIX = (bf16_t*)(P.ws + WS_MIX);
    const f16x8* KFg = (const f16x8*)(P.ws + WS_MK) + (size_t)((layer * BATCH + b) * XH + h) * (8 * 8 * 64);
    const f16x8* VFg = (const f16x8*)(P.ws + WS_MV) + (size_t)((layer * BATCH + b) * XH + h) * (8 * 4 * 2 * 64);
    const float* xqg = P.xq_norm_g + layer * XHD;
#pragma unroll
    for (int i = 0; i < 16; ++i) { const int f = wave * 16 + i; const f16x8* src = (f < 64 ? KFg + f * 64 : VFg + (f - 64) * 64) + lane;
        __builtin_amdgcn_global_load_lds((const unsigned*)src, (LAS unsigned*)(lds + f * 1024), 16, 0, 0); }
    asm volatile("s_waitcnt vmcnt(0)" ::: "memory");
    __syncthreads();
    const int ql = lane & 31, hi = lane >> 5;
    for (int ui = 0; ui < 2; ++ui) {
        const int qbase = b * SEQ + sblk * 512 + (wave * 2 + ui) * 32;
        const bf16_t* zq = Z + (size_t)(qbase + ql) * IN_W + ZXQ + h * XHD;
        f16x8 qf[8]; float ss = 0.f;
#pragma unroll
        for (int d0 = 0; d0 < 8; ++d0) { qf[d0] = *(const f16x8*)(zq + 16 * d0 + 8 * hi);
#pragma unroll
            for (int j = 0; j < 8; ++j) { const float a = hf(qf[d0][j]); ss += a * a; } }
        ss += __shfl_xor(ss, 32);
        const float rs = rsqrtf(ss * (1.f / XHD) + EPS) * (0.08838834764831845f * LOG2E);
#pragma unroll
        for (int d0 = 0; d0 < 8; ++d0)
#pragma unroll
            for (int j = 0; j < 8; ++j) qf[d0][j] = (_Float16)(hf(qf[d0][j]) * rs * xqg[16 * d0 + 8 * hi + j]);
        f16x8 pa[2][4][2]; float mh[2], lh[2];
#pragma unroll
        for (int hf2 = 0; hf2 < 2; ++hf2) {
            f32x16 p[4];
#pragma unroll
            for (int t = 0; t < 4; ++t) { const int kt = 4 * hf2 + t; f32x16 acc = {};
#pragma unroll
                for (int d0 = 0; d0 < 8; ++d0) acc = __builtin_amdgcn_mfma_f32_32x32x16_f16(*(const LAS f16x8*)(lds + ((kt * 8 + d0) * 64 + lane) * 16), qf[d0], acc, 0, 0, 0);
                p[t] = acc; asm volatile("" ::: "memory"); }
            float mx = -INFINITY;
#pragma unroll
            for (int t = 0; t < 4; ++t)
#pragma unroll
                for (int r = 0; r < 16; ++r) mx = fmaxf(mx, p[t][r]);
            mx = fmaxf(mx, __shfl_xor(mx, 32));
            float l = 0.f;
#pragma unroll
            for (int t = 0; t < 4; ++t) {
#pragma unroll
                for (int r = 0; r < 16; ++r) { const float e = __builtin_amdgcn_exp2f(p[t][r] - mx); p[t][r] = e; l += e; }
                pa[hf2][t][0] = pack8(p[t], 0); pa[hf2][t][1] = pack8(p[t], 1); }
            l += __shfl_xor(l, 32);
            mh[hf2] = mx; lh[hf2] = l;
        }
        const float mm = fmaxf(mh[0], mh[1]); const float e0 = __builtin_amdgcn_exp2f(mh[0] - mm), e1 = __builtin_amdgcn_exp2f(mh[1] - mm);
        const float linv = __builtin_amdgcn_rcpf(lh[0] * e0 + lh[1] * e1); const float f0 = e0 * linv, f1 = e1 * linv;
#pragma unroll
        for (int db = 0; db < 4; ++db) { f32x16 o0 = {}, o1 = {};
#pragma unroll
            for (int t = 0; t < 4; ++t) {
#pragma unroll
                for (int s2 = 0; s2 < 2; ++s2) { o0 = __builtin_amdgcn_mfma_f32_32x32x16_f16(*(const LAS f16x8*)(lds + 65536 + (((t * 4 + db) * 2 + s2) * 64 + lane) * 16), pa[0][t][s2], o0, 0, 0, 0);
                    o1 = __builtin_amdgcn_mfma_f32_32x32x16_f16(*(const LAS f16x8*)(lds + 65536 + ((((4 + t) * 4 + db) * 2 + s2) * 64 + lane) * 16), pa[1][t][s2], o1, 0, 0, 0); }
                asm volatile("" ::: "memory"); }
            { LAS unsigned char* st = lds + 131072 + wave * 2560; const int erow = lane >> 1, ehs = lane & 1;
              const size_t tok = (size_t)qbase + erow; const int col = h * XHD + 32 * db + 16 * ehs;
              const v4u ga = *(const v4u*)(Z + tok * IN_W + ZXG + col), gb = *(const v4u*)(Z + tok * IN_W + ZXG + col + 8);
              stage_ot2(st, 80, 0, o0, f0, o1, f1, ql, hi);
              const v4u a0 = *(const LAS v4u*)(st + erow * 80 + ehs * 32), a1 = *(const LAS v4u*)(st + erow * 80 + ehs * 32 + 16);
              *(v4u*)(MIX + tok * MIX_W + 1024 + col) = pk_mul8(a0, ga); *(v4u*)(MIX + tok * MIX_W + 1024 + col + 8) = pk_mul8(a1, gb); }
            asm volatile("" ::: "memory"); }
    }
    __syncthreads();
}
__device__ __forceinline__ void phase_attn_c(const Params& P, int layer, LAS unsigned char* lds, int vcu, int G) {
    for (int it = vcu; it < BATCH * XH * 8; it += G) attn_c_item(P, layer, lds, it);
}
__device__ __forceinline__ void phase_memfin(const Params& P, int vcu, int G) {
    const int tid = opaque_tid(), lane = tid & 63, wave = __builtin_amdgcn_readfirstlane(tid >> 6);
    const float* mkv = (const float*)(P.ws + WS_Y2);
    for (int it = vcu * NWAVES + wave; it < DEPTH * BATCH * N_MEM; it += G * NWAVES) {
        const int l = it / (BATCH * N_MEM), row = it % (BATCH * N_MEM), b = row / N_MEM, key = row % N_MEM;
        const float* r = mkv + (size_t)row * (DEPTH * 1024) + l * 1024; const float* xkg = P.xk_norm_g + l * XHD;
        const int kt = key >> 5, kl = key & 31, sK = kl >> 4, h2 = ((kl & 15) >> 2) & 1, jj = 4 * ((kl & 15) >> 3) + (kl & 3);
        for (int h = 0; h < XH; ++h) {
            bf16_t* KF = (bf16_t*)(P.ws + WS_MK) + (size_t)((l * BATCH + b) * XH + h) * (8 * 8 * 64 * 8);
            bf16_t* VF = (bf16_t*)(P.ws + WS_MV) + (size_t)((l * BATCH + b) * XH + h) * (8 * 4 * 2 * 64 * 8);
            float v[2]; v[0] = r[h * XHD + lane]; v[1] = r[h * XHD + 64 + lane];
            const float s = wave_sum(v[0] * v[0] + v[1] * v[1]); const float rs = rsqrtf(s * (1.f / XHD) + EPS);
#pragma unroll
            for (int e = 0; e < 2; ++e) { const int d = lane + 64 * e;
                KF[(size_t)((kt * 8 + (d >> 4)) * 64 + kl + 32 * ((d >> 3) & 1)) * 8 + (d & 7)] = f2bf(v[e] * rs * xkg[d]);
                VF[(size_t)(((kt * 4 + (d >> 5)) * 2 + sK) * 64 + (d & 31) + 32 * h2) * 8 + jj] = f2bf(r[512 + h * XHD + d]); }
        }
    }
}


constexpr size_t SSMC_WE = 0, SSMC_WC = 64 * 1024, SSMC_KJ = 128 * 1024, SSMC_STRIDE = 144 * 1024;
constexpr size_t WS_A16 = WS_MISC + 128 * 1024;
__device__ __forceinline__ void ssm_consts_item(const Params& P, LAS unsigned char* lds, int item) {
    const int tid = opaque_tid(); const int l = item / SSM_G, g = item % SSM_G;
    LAS float* apw = (LAS float*)lds;
    LAS float* bbar = apw + 17 * 64 * 2;
    LAS float* kj = bbar + 64 * 16 * 2;
    LAS float* cre = kj + 16 * 256; LAS float* cim = cre + 16 * 64;
    { const float* c_re_g = P.c_re + (size_t)(l * SSM_G + g) * SSM_CH * SSM_P; const float* c_im_g = P.c_im + (size_t)(l * SSM_G + g) * SSM_CH * SSM_P;
      for (int i = tid; i < 16 * 64; i += NTHREADS) { cre[i] = c_re_g[i]; cim[i] = c_im_g[i]; } }
    const LAS float* c_re = cre; const LAS float* c_im = cim;
    const double dt = exp((double)P.log_dt[l * SSM_G + g]);
    for (int i = tid; i < 17 * 64; i += NTHREADS) { const int j = i / 64, p = i % 64; const int gp = (l * SSM_G + g) * SSM_P + p;
        const double lr = P.lam_re[gp], li = P.lam_im[gp]; const double mag = exp(lr * dt * j); double sn, cs; sincos(li * dt * j, &sn, &cs);
        apw[i * 2] = (float)(mag * cs); apw[i * 2 + 1] = (float)(mag * sn); }
    for (int i = tid; i < 64 * 16; i += NTHREADS) { const int p = i / 16, c = i % 16; const int gp = (l * SSM_G + g) * SSM_P + p;
        const double lr = P.lam_re[gp], li = P.lam_im[gp]; const double mag = exp(lr * dt), ar = mag * cos(li * dt), ai = mag * sin(li * dt), den = lr * lr + li * li;
        const double fr = ((ar - 1.0) * lr + ai * li) / den, fi = (ai * lr - (ar - 1.0) * li) / den;
        const double br = P.b_re[(size_t)gp * SSM_CH + c], bi = P.b_im[(size_t)gp * SSM_CH + c];
        bbar[i * 2] = (float)(fr * br - fi * bi); bbar[i * 2 + 1] = (float)(fr * bi + fi * br); }
    __syncthreads();
    for (int i = tid; i < 16 * 256; i += NTHREADS) { const int j = i >> 8, co = (i >> 4) & 15, ci = i & 15; float acc = 0.f;
        for (int p = 0; p < 64; ++p) { const float er = apw[(j * 64 + p) * 2], ei = apw[(j * 64 + p) * 2 + 1], br = bbar[(p * 16 + ci) * 2], bi = bbar[(p * 16 + ci) * 2 + 1];
            const float wr = er * br - ei * bi, wi = er * bi + ei * br; acc += c_re[co * SSM_P + p] * wr - c_im[co * SSM_P + p] * wi; }
        if (j == 0 && co == ci) acc += P.d_skip[l * SSM_W + g * SSM_CH + co];
        kj[i] = acc; }
    __syncthreads();
    unsigned char* base = P.ws + WS_SSMP + (size_t)item * SSMC_STRIDE;
    bf16_t* WE = (bf16_t*)(base + SSMC_WE); bf16_t* WC = (bf16_t*)(base + SSMC_WC); bf16_t* KJ = (bf16_t*)(base + SSMC_KJ);
    for (int i = tid; i < 64 * 512; i += NTHREADS) { const int f = i >> 9, e = i & 511, ln = e >> 3, j = e & 7, mt = f >> 4, sx = f & 15, r = ln & 31, hh = ln >> 5;
        const int R = 32 * mt + r, p = R >> 1, ri = R & 1, ci = 8 * hh + j; const float er = apw[((15 - sx) * 64 + p) * 2], ei = apw[((15 - sx) * 64 + p) * 2 + 1], br = bbar[(p * 16 + ci) * 2], bi = bbar[(p * 16 + ci) * 2 + 1];
        WE[i] = f2bf(ri ? (er * bi + ei * br) : (er * br - ei * bi)); }
    for (int i = tid; i < 9216 / 2; i += NTHREADS) KJ[i] = (i < 16 * 256) ? f2bf(kj[i]) : (bf16_t)0;
    for (int i = tid; i < 64 * 512; i += NTHREADS) { const int f = i >> 9, e = i & 511, ln = e >> 3, j = e & 7, mt = f >> 3, kc = f & 7, r = ln & 31, hh = ln >> 5;
        const int t = 2 * mt + (r >> 4), co = r & 15, p = 8 * kc + 4 * hh + (j >> 1), ri = j & 1; const float er = apw[((t + 1) * 64 + p) * 2], ei = apw[((t + 1) * 64 + p) * 2 + 1];
        const float cr = c_re[co * SSM_P + p], cim = c_im[co * SSM_P + p]; WC[i] = f2bf(ri ? -(cr * ei + cim * er) : (cr * er - cim * ei)); }
    if (tid < 64) { float* a16 = (float*)(P.ws + WS_A16) + (size_t)(item * 64 + tid) * 4; a16[0] = apw[(16 * 64 + tid) * 2]; a16[1] = apw[(16 * 64 + tid) * 2 + 1];
        const int gp = (l * SSM_G + g) * SSM_P + tid; const double lr = P.lam_re[gp], li = P.lam_im[gp]; const double mag = exp(lr * dt * 512.0); double sn, cs; sincos(li * dt * 512.0, &sn, &cs);
        a16[2] = (float)(mag * cs); a16[3] = (float)(mag * sn); }
    __syncthreads();
}
__device__ __forceinline__ void phase_ssm_consts(const Params& P, LAS unsigned char* lds, int vcu, int G) {
    for (int it = vcu; it < DEPTH * SSM_G; it += G) ssm_consts_item(P, lds, it);
}
__device__ __forceinline__ float gelu_tanh_fast(float x) {
    const float u = 0.7978845608028654f * (x + 0.044715f * x * x * x); return x * __builtin_amdgcn_rcpf(1.f + __expf(-2.f * u)); }

constexpr int SSM_EH = 0, SSM_EHP = 272, SSM_WX = 69632, SSM_KJ = SSM_WX + 65536, SSM_CHS = SSM_KJ + 9216;
static_assert(SSM_CHS + 4096 <= LDSCTL_OFF, "ssm lds map");
__device__ __forceinline__ void ssm_item(const Params& P, int layer, LAS unsigned char* lds, int item) {
    const int tid = opaque_tid(), lane = tid & 63, wave = __builtin_amdgcn_readfirstlane(tid >> 6);
    const int g = item >> 3, b = item & 7;
    const bf16_t* Z = (const bf16_t*)(P.ws + WS_Z); bf16_t* Y2 = (bf16_t*)(P.ws + WS_Y2);
    const unsigned char* cbase = P.ws + WS_SSMP + (size_t)(layer * SSM_G + g) * SSMC_STRIDE;
    const int nl = lane & 31, hh = lane >> 5;
    typedef float f32x2v __attribute__((ext_vector_type(2)));
#pragma unroll
    for (int i = 0; i < 8; ++i) { const int f = wave * 8 + i;
        __builtin_amdgcn_global_load_lds((const unsigned*)(cbase + SSMC_WE + f * 1024 + lane * 16), (LAS unsigned*)(lds + SSM_WX + f * 1024), 16, 0, 0); }
    __builtin_amdgcn_global_load_lds((const unsigned*)(cbase + SSMC_KJ + wave * 1024 + lane * 16), (LAS unsigned*)(lds + SSM_KJ + wave * 1024), 16, 0, 0);
    if (wave == 0) __builtin_amdgcn_global_load_lds((const unsigned*)(cbase + SSMC_KJ + 8192 + lane * 16), (LAS unsigned*)(lds + SSM_KJ + 8192), 16, 0, 0);
    const int n = 32 * wave + nl;
    const bf16_t* up = Z + (size_t)(b * SEQ + 16 * n) * IN_W + ZU + g * SSM_CH + 8 * hh;
    f16x8 uf[16];
#pragma unroll
    for (int sx = 0; sx < 16; ++sx) uf[sx] = *(const f16x8*)(up + (size_t)sx * IN_W);
    const float* a16p = (const float*)(P.ws + WS_A16) + (size_t)((layer * SSM_G + g) * 64 + lane) * 4;
    const float a16r = a16p[0], a16i = a16p[1], a5r = a16p[2], a5i = a16p[3];
    asm volatile("s_waitcnt vmcnt(0)" ::: "memory");
    __syncthreads();
    {
        f32x16 ae[4] = {};
#pragma unroll
        for (int sx = 0; sx < 16; ++sx) {
#pragma unroll
            for (int mt = 0; mt < 4; ++mt) ae[mt] = __builtin_amdgcn_mfma_f32_32x32x16_f16(*(const LAS f16x8*)(lds + SSM_WX + ((mt * 16 + sx) * 64 + lane) * 16), uf[sx], ae[mt], 0, 0, 0);
            if ((sx & 1) == 1) asm volatile("" ::: "memory"); }
#pragma unroll
        for (int mt = 0; mt < 4; ++mt)
#pragma unroll
            for (int r = 0; r < 16; r += 2) { const int p = 16 * mt + (crow(r, hh) >> 1);
                *(LAS unsigned*)(lds + SSM_EH + n * SSM_EHP + 4 * p) = pg8::pk_f16(ae[mt][r], ae[mt][r + 1]); }
    }
    __syncthreads();
#pragma unroll
    for (int i = 0; i < 8; ++i) { const int f = wave * 8 + i;
        __builtin_amdgcn_global_load_lds((const unsigned*)(cbase + SSMC_WC + f * 1024 + lane * 16), (LAS unsigned*)(lds + SSM_WX + f * 1024), 16, 0, 0); }
    {
        LAS unsigned char* eh = lds + SSM_EH + (32 * wave) * SSM_EHP + 4 * lane;
        float sr = 0.f, si = 0.f;
#pragma unroll 8
        for (int k = 0; k < 32; ++k) { const unsigned ev = *(const LAS unsigned*)(eh + k * SSM_EHP); const float er = pg8::h_lo(ev), ei = pg8::h_hi(ev);
            const float nr = a16r * sr - a16i * si + er, ni = a16r * si + a16i * sr + ei; sr = nr; si = ni; }
        LAS f32x2v* chs = (LAS f32x2v*)(lds + SSM_CHS);
        chs[wave * 64 + lane] = (f32x2v){sr, si};
        __syncthreads();
        float cr = 0.f, ci = 0.f;
        for (int v = 0; v < wave; ++v) { const f32x2v sv = chs[v * 64 + lane]; const float nr = a5r * cr - a5i * ci + sv.x, ni = a5r * ci + a5i * cr + sv.y; cr = nr; ci = ni; }
        sr = cr; si = ci;
#pragma unroll 8
        for (int k = 0; k < 32; ++k) { const unsigned ev = *(const LAS unsigned*)(eh + k * SSM_EHP); const float er = pg8::h_lo(ev), ei = pg8::h_hi(ev);
            *(LAS unsigned*)(eh + k * SSM_EHP) = pg8::pk_f16(sr, si);
            const float nr = a16r * sr - a16i * si + er, ni = a16r * si + a16i * sr + ei; sr = nr; si = ni; }
    }
    asm volatile("s_waitcnt vmcnt(0)" ::: "memory");
    __syncthreads();
    const int rhi = nl >> 4, co = nl & 15;
    const LAS unsigned char* kjl = lds + SSM_KJ + co * 32 + hh * 16;
#pragma unroll
    for (int mh = 0; mh < 2; ++mh) {
        f32x16 ay[4] = {};
#pragma unroll
        for (int sx = 0; sx < 16; ++sx) {
#pragma unroll
            for (int i = 0; i < 4; ++i) { const int mt = 4 * mh + i; const int lag0 = 2 * mt - sx;
                if (lag0 + 1 >= 0) { const int lag = lag0 + rhi; const int row = (lag0 >= 0) ? lag : (rhi ? 0 : 16);
                    ay[i] = __builtin_amdgcn_mfma_f32_32x32x16_f16(*(const LAS f16x8*)(kjl + row * 512), uf[sx], ay[i], 0, 0, 0); } }
            if ((sx & 1) == 1) asm volatile("" ::: "memory"); }
#pragma unroll
        for (int kc = 0; kc < 8; ++kc) { const f16x8 hfr = *(const LAS f16x8*)(lds + SSM_EH + n * SSM_EHP + 32 * kc + 16 * hh);
#pragma unroll
            for (int i = 0; i < 4; ++i) { const int mt = 4 * mh + i;
                ay[i] = __builtin_amdgcn_mfma_f32_32x32x16_f16(*(const LAS f16x8*)(lds + SSM_WX + ((mt * 8 + kc) * 64 + lane) * 16), hfr, ay[i], 0, 0, 0); }
            if ((kc & 1) == 1) asm volatile("" ::: "memory"); }
#pragma unroll
        for (int i = 0; i < 4; ++i) { const int mt = 4 * mh + i;
#pragma unroll
            for (int q = 0; q < 4; ++q) { const int t = 2 * mt + (q >> 1), co0 = 8 * (q & 1) + 4 * hh;
                pg8::u32x2 w; w.x = pg8::pk_f16(gelu_tanh_fast(ay[i][4 * q]), gelu_tanh_fast(ay[i][4 * q + 1])); w.y = pg8::pk_f16(gelu_tanh_fast(ay[i][4 * q + 2]), gelu_tanh_fast(ay[i][4 * q + 3]));
                *(pg8::u32x2*)(Y2 + (size_t)(b * SEQ + 16 * n + t) * SSM_W + g * SSM_CH + co0) = w; } }
    }
    __syncthreads();
}
__device__ __forceinline__ void phase_ssm(const Params& P, int layer, LAS unsigned char* lds, int vcu, int G) {
    for (int it = vcu; it < SSM_G * BATCH; it += G) ssm_item(P, layer, lds, it);
}


#define XB_TMO      128
#define XB_XCNT(j)  (256  + 64 * (j))
#define XB_XSUB(j)  (1280 + 64 * (j))
#define XB_XGEN(j)  (2304 + 64 * (j))
#define XB_TOP      3328
#define XB_TOPGEN   3392
#define XCD_BAR_WORDS 3456
#define XB_SPIN_CAP (1u << 18)
__device__ __forceinline__ unsigned xb_ld(unsigned* p)              { return __hip_atomic_load(p, __ATOMIC_RELAXED, __HIP_MEMORY_SCOPE_AGENT); }
__device__ __forceinline__ unsigned xb_add(unsigned* p, unsigned v) { return __hip_atomic_fetch_add(p, v, __ATOMIC_RELAXED, __HIP_MEMORY_SCOPE_AGENT); }
__device__ __forceinline__ unsigned xb_xcc_id() { return (unsigned)__builtin_amdgcn_s_getreg((3 << 11) | 20) & 0xFu; }
#define XB_SPIN(cond, bar) do { unsigned _sp = 0; while (cond) { __builtin_amdgcn_s_sleep(1); \
    if ((++_sp & 255u) == 0u) { if (xb_ld(&(bar)[XB_TMO])) break; if (_sp > XB_SPIN_CAP) { atomicAdd(&(bar)[XB_TMO], 1u); break; } } } } while (0)
struct XcdBarrier { unsigned* bar; unsigned x; volatile LAS unsigned* st; };
__device__ __forceinline__ XcdBarrier xcd_barrier_post(unsigned* bar, volatile LAS unsigned* st) {
    XcdBarrier b; b.bar = bar; b.x = xb_xcc_id(); b.st = st;
    if (threadIdx.x == 0) (void)xb_add(&bar[XB_XCNT(b.x)], 1u);
    return b;
}
__device__ __forceinline__ void xcd_barrier_complete(unsigned* bar, unsigned x, unsigned& nloc, unsigned& nx) {
    const unsigned G = gridDim.x * gridDim.y * gridDim.z;
    unsigned sum, cnt, mine, sp = 0u;
    for (;;) {
        sum = 0u; cnt = 0u; mine = 0u;
#pragma unroll
        for (unsigned j = 0; j < 16; ++j) { const unsigned c = xb_ld(&bar[XB_XCNT(j)]); sum += c; cnt += (c > 0u) ? 1u : 0u; mine = (j == x) ? c : mine; }
        if (sum == G) break;
        __builtin_amdgcn_s_sleep(1);
        if ((++sp & 255u) == 0u) { if (xb_ld(&bar[XB_TMO])) break; if (sp > XB_SPIN_CAP) { atomicAdd(&bar[XB_TMO], 1u); break; } }
    }
    nloc = mine > 0u ? mine : 1u; nx = cnt > 0u ? cnt : 1u;
}
__device__ __forceinline__ void xcd_barrier(const XcdBarrier& b) {
    asm volatile("s_waitcnt vmcnt(0)" ::: "memory");
    __syncthreads();
    if (threadIdx.x == 0) {
        unsigned* bar = b.bar;
        __builtin_amdgcn_s_waitcnt(0);
        unsigned nloc = b.st[0], nx = b.st[1];
        if (nloc == 0u) { xcd_barrier_complete(bar, b.x, nloc, nx); b.st[0] = nloc; b.st[1] = nx; }
        const unsigned old = xb_add(&bar[XB_XSUB(b.x)], 1u);
        const unsigned gen = old / nloc;
        if (old + 1u == (gen + 1u) * nloc) {
            __builtin_amdgcn_fence(__ATOMIC_RELEASE, "agent");
            asm volatile("s_waitcnt vmcnt(0)" ::: "memory");
            const unsigned og = xb_add(&bar[XB_TOP], 1u);
            const unsigned tg = og / nx;
            if (og + 1u == (tg + 1u) * nx) xb_add(&bar[XB_TOPGEN], 1u);
            else XB_SPIN(xb_ld(&bar[XB_TOPGEN]) == tg, bar);
            __builtin_amdgcn_fence(__ATOMIC_ACQUIRE, "agent");
            xb_add(&bar[XB_XGEN(b.x)], 1u);
            asm volatile("s_waitcnt vmcnt(0)" ::: "memory");
        } else {
            XB_SPIN(xb_ld(&bar[XB_XGEN(b.x)]) == gen, bar);
            __builtin_amdgcn_fence(__ATOMIC_ACQUIRE, "agent");
            asm volatile("s_waitcnt vmcnt(0)" ::: "memory");
        }
    }
    __syncthreads();
}
constexpr size_t WS_CTL = WS_MISC + 512 * 1024;
constexpr int CTL_BYTES = 16384;

constexpr int DEFER_TILE = 8;
__device__ __forceinline__ bool defer_mode(int layer, int G) { return layer > 0 && G == 256; }
__device__ __forceinline__ void run_inproj(const Params& P, int layer, LAS unsigned char* lds, int G, int bx) {
    unsigned char* ws = P.ws;
    pg8::Gemm g{(const bf16_t*)(ws + WS_XB), (const bf16_t*)(ws + WS_WIN) + (size_t)layer * IN_W * D_MODEL, MTOK, IN_W, D_MODEL};
    pg8::EpiZ E{(bf16_t*)(ws + WS_Z), (const float*)(ws + WS_SUMSQ), (const bf16_t*)(ws + WS_ROPE), P.q_norm_g + layer * HD, P.k_norm_g + layer * HD};
    if (defer_mode(layer, G)) { pg8::SkipOrder S; S.init2(g.M, g.N, G, bx, DEFER_TILE); pg8::gemm_phase<pg8::EpiZ, pg8::SkipOrder, true>(lds, g, S, E); }
    else { pg8::StaticOrder S; S.init(g.M, g.N, G, bx); pg8::gemm_phase<pg8::EpiZ, pg8::StaticOrder, true>(lds, g, S, E); }
}
__device__ __forceinline__ void run_inproj_tail(const Params& P, int layer, LAS unsigned char* lds, int G, int bx) {
    if (!defer_mode(layer, G)) return;
    unsigned char* ws = P.ws;
    pg8::Gemm g{(const bf16_t*)(ws + WS_XB), (const bf16_t*)(ws + WS_WIN) + (size_t)layer * IN_W * D_MODEL, MTOK, IN_W, D_MODEL};
    pg8::EpiZ E{(bf16_t*)(ws + WS_Z), (const float*)(ws + WS_SUMSQ), (const bf16_t*)(ws + WS_ROPE), P.q_norm_g + layer * HD, P.k_norm_g + layer * HD};
    pg8::DeferOrder S; S.init(g.M, G, bx, DEFER_TILE); pg8::gemm_phase<pg8::EpiZ, pg8::DeferOrder, true>(lds, g, S, E);
}
__device__ __forceinline__ void run_glu(const Params& P, int layer, LAS unsigned char* lds, int G, int bx) {
    unsigned char* ws = P.ws;
    pg8::Gemm g{(const bf16_t*)(ws + WS_Y2), (const bf16_t*)(ws + WS_WGLU) + (size_t)layer * SSM_W * SSM_W, MTOK, SSM_W, SSM_W}; pg8::StaticOrder S; S.init(g.M, g.N, G, bx);
    pg8::EpiGlu E{(const bf16_t*)(ws + WS_Y2), (const bf16_t*)(ws + WS_Z), P.b_glu + layer * SSM_W, (bf16_t*)(ws + WS_MIX)};
    pg8::gemm_phase<pg8::EpiGlu, pg8::StaticOrder, true>(lds, g, S, E);
}
__device__ __forceinline__ void run_outproj(const Params& P, int layer, LAS unsigned char* lds, int G, int bx) {
    unsigned char* ws = P.ws;
    pg8::Gemm g{(const bf16_t*)(ws + WS_MIX), (const bf16_t*)(ws + WS_WOUT) + (size_t)layer * D_MODEL * MIX_W, MTOK, D_MODEL, MIX_W}; pg8::StaticOrder S; S.init(g.M, g.N, G, bx);
    if (layer == 0) { pg8::EpiOut<0> E{P.x, P.out, (bf16_t*)(ws + WS_XB), (float*)(ws + WS_SUMSQ)}; pg8::gemm_phase<pg8::EpiOut<0>, pg8::StaticOrder, true>(lds, g, S, E); }
    else if (layer + 1 < DEPTH) { pg8::EpiOut<1> E{P.x, P.out, (bf16_t*)(ws + WS_XB), (float*)(ws + WS_SUMSQ)}; pg8::gemm_phase<pg8::EpiOut<1>, pg8::StaticOrder, true>(lds, g, S, E); }
    else { pg8::EpiOut<2> E{P.x, P.out, (bf16_t*)(ws + WS_XB), (float*)(ws + WS_SUMSQ)}; pg8::gemm_phase<pg8::EpiOut<2>, pg8::StaticOrder, true>(lds, g, S, E); }
}
__device__ __forceinline__ void run_memgemm(const Params& P, LAS unsigned char* lds, int G, int bx) {
    unsigned char* ws = P.ws;
    pg8::Gemm g{(const bf16_t*)(ws + WS_MEMB), (const bf16_t*)(ws + WS_WMEM), BATCH * N_MEM, DEPTH * 1024, D_MODEL}; pg8::MemTailOrder S; S.init(g.M, g.N, G, bx, ((MTOK / 256) * (IN_W / 256)) % G);
    pg8::EpiMemF32 E{(float*)(ws + WS_Y2), DEPTH * 1024, (const float*)(ws + WS_MISC)};
    pg8::gemm_phase<pg8::EpiMemF32, pg8::MemTailOrder, true>(lds, g, S, E);
}


template <class T> __device__ __forceinline__ T* as_global(unsigned long long v) { return (T*)(__attribute__((address_space(1))) T*)v; }
__device__ __forceinline__ Params load_params() {
    typedef const volatile unsigned long long __attribute__((address_space(4)))* kp_t;
    kp_t kp = (kp_t)__builtin_amdgcn_kernarg_segment_ptr();
    Params q;
    q.x = as_global<const float>(kp[0]); q.mem = as_global<const float>(kp[1]); q.pos = as_global<const int>(kp[2]); q.norm_g = as_global<const float>(kp[3]);
    q.w_in = as_global<const float>(kp[4]); q.q_norm_g = as_global<const float>(kp[5]); q.k_norm_g = as_global<const float>(kp[6]); q.sinks = as_global<const float>(kp[7]);
    q.lam_re = as_global<const float>(kp[8]); q.lam_im = as_global<const float>(kp[9]); q.log_dt = as_global<const float>(kp[10]); q.b_re = as_global<const float>(kp[11]);
    q.b_im = as_global<const float>(kp[12]); q.c_re = as_global<const float>(kp[13]); q.c_im = as_global<const float>(kp[14]); q.d_skip = as_global<const float>(kp[15]);
    q.w_glu = as_global<const float>(kp[16]); q.b_glu = as_global<const float>(kp[17]); q.mem_norm_g = as_global<const float>(kp[18]); q.w_mem_kv = as_global<const float>(kp[19]);
    q.xq_norm_g = as_global<const float>(kp[20]); q.xk_norm_g = as_global<const float>(kp[21]); q.w_out = as_global<const float>(kp[22]);
    q.out = as_global<float>(kp[23]); q.ws = as_global<unsigned char>(kp[24]);
    return q;
}
static_assert(sizeof(Params) == 25 * 8, "Params is 25 pointers");
__global__ void __launch_bounds__(NTHREADS, 2) k_mega(Params Parg) {
    extern __shared__ __attribute__((aligned(16))) unsigned char lds_raw[];
    LAS unsigned char* lds = (LAS unsigned char*)lds_raw;
    const int G = gridDim.x, bx = blockIdx.x; const int vcu = (G % 8 == 0) ? (bx % 8) * (G / 8) + bx / 8 : bx;
    for (int u = threadIdx.x; u < (LDS_BYTES - LDSCTL_OFF) / 4; u += NTHREADS) ((LAS unsigned*)(lds + LDSCTL_OFF))[u] = 0u;
    __syncthreads();
    (void)xcd_barrier_post((unsigned*)(Parg.ws + WS_CTL), (volatile LAS unsigned*)(lds + LDSCTL_OFF));
#define GRID_BARRIER() do { XcdBarrier bar_; { const Params Pb = load_params(); bar_.bar = (unsigned*)(Pb.ws + WS_CTL); } unsigned xq_ = xb_xcc_id(); asm volatile("" : "+s"(xq_)); bar_.x = xq_; bar_.st = (volatile LAS unsigned*)(lds + LDSCTL_OFF); xcd_barrier(bar_); } while (0)
    { const Params P = load_params(); phase_prep(P, lds, vcu, G); } __syncthreads();
    { const Params P = load_params(); phase_ssm_consts(P, lds, vcu, G); }
    GRID_BARRIER();
    { const Params P = load_params(); run_inproj(P, 0, lds, G, bx); }
    { const Params P = load_params(); run_memgemm(P, lds, G, bx); }
    GRID_BARRIER();
    { const Params P = load_params(); phase_memfin(P, vcu, G); }
    GRID_BARRIER();
#pragma unroll 1
    for (int layer = 0; layer < DEPTH; ++layer) {
        { const Params P = load_params(); run_inproj_tail(P, layer, lds, G, bx); }
        { const Params P = load_params(); phase_attn_a(P, layer, lds, vcu, G, bx, defer_mode(layer, G)); }
        { const Params P = load_params(); phase_attn_c(P, layer, lds, vcu, G); }
        { const Params P = load_params(); phase_ssm(P, layer, lds, vcu, G); }
        GRID_BARRIER();
        { const Params P = load_params(); run_glu(P, layer, lds, G, bx); }
        GRID_BARRIER();
        { const Params P = load_params(); run_outproj(P, layer, lds, G, bx); }
        if (layer + 1 < DEPTH) { GRID_BARRIER(); { const Params P = load_params(); run_inproj(P, layer + 1, lds, G, bx); } GRID_BARRIER(); }
    }
}

extern "C" void kernel_launch(void* const* d_in, const int* in_sizes, int n_in, void* d_out, int out_size, void* d_ws, size_t ws_size, hipStream_t stream) {
    if (ws_size < WS_END || n_in != 23) return;
    Params P{};
    P.x = (const float*)d_in[0]; P.mem = (const float*)d_in[1]; P.pos = (const int*)d_in[2]; P.norm_g = (const float*)d_in[3]; P.w_in = (const float*)d_in[4];
    P.q_norm_g = (const float*)d_in[5]; P.k_norm_g = (const float*)d_in[6]; P.sinks = (const float*)d_in[7]; P.lam_re = (const float*)d_in[8]; P.lam_im = (const float*)d_in[9];
    P.log_dt = (const float*)d_in[10]; P.b_re = (const float*)d_in[11]; P.b_im = (const float*)d_in[12]; P.c_re = (const float*)d_in[13]; P.c_im = (const float*)d_in[14];
    P.d_skip = (const float*)d_in[15]; P.w_glu = (const float*)d_in[16]; P.b_glu = (const float*)d_in[17]; P.mem_norm_g = (const float*)d_in[18]; P.w_mem_kv = (const float*)d_in[19];
    P.xq_norm_g = (const float*)d_in[20]; P.xk_norm_g = (const float*)d_in[21]; P.w_out = (const float*)d_in[22];
    P.out = (float*)d_out; P.ws = (unsigned char*)d_ws;
    static int coop_grid = 0;
    if (coop_grid == 0) {
        int dev = 0, cus = 0, per_cu = 0; hipGetDevice(&dev); hipDeviceGetAttribute(&cus, hipDeviceAttributeMultiprocessorCount, dev);
        (void)hipFuncSetAttribute((const void*)k_mega, hipFuncAttributeMaxDynamicSharedMemorySize, LDS_BYTES);
        if (hipOccupancyMaxActiveBlocksPerMultiprocessor(&per_cu, (const void*)k_mega, NTHREADS, LDS_BYTES) != hipSuccess || per_cu < 1) { fprintf(stderr, "kernel_launch: occupancy query says %d blocks/CU\n", per_cu); (void)hipGetLastError(); per_cu = 1; }
        if (per_cu > 1) per_cu = 1;
        coop_grid = (cus > 0 ? cus : 256) * per_cu;
    }
    (void)hipMemsetAsync((char*)d_ws + WS_CTL, 0, CTL_BYTES, stream);
    { void* args[] = {(void*)&P}; hipError_t e = hipLaunchCooperativeKernel((const void*)k_mega, dim3(coop_grid), dim3(NTHREADS), args, LDS_BYTES, stream);
      if (e != hipSuccess) fprintf(stderr, "cooperative launch failed: %s (grid %d)\n", hipGetErrorString(e), coop_grid); }
}
```

```cpp
#include <hip/hip_runtime.h>
#include <cstdio>
#include <stdint.h>
#include <math.h>

constexpr int D_MODEL = 1024, BATCH = 8, SEQ = 4096, DEPTH = 4, MTOK = BATCH * SEQ;
constexpr int HD = 64, NQH = 8, NKVH = 2, WINDOW = 128;
constexpr int SSM_CH = 16, SSM_G = 32, SSM_P = 64, SSM_W = 512, N_MEM = 256, XH = 4, XHD = 128;
constexpr int MIX_W = 1536, IN_W = 3328;
constexpr int ZQ = 0, ZK = 512, ZV = 640, ZG = 768, ZU = 1280, ZSG = 1792, ZXQ = 2304, ZXG = 2816;
constexpr float EPS = 1e-6f;

typedef unsigned short bf16_t;
__device__ __forceinline__ bf16_t f2bf(float f) { _Float16 h = (_Float16)f; return __builtin_bit_cast(unsigned short, h); }
__device__ __forceinline__ float bf2f(bf16_t h) { return (float)__builtin_bit_cast(_Float16, h); }
__device__ __forceinline__ float sigmoidf_(float x) { return __builtin_amdgcn_rcpf(1.f + __expf(-x)); }
__device__ __forceinline__ float siluf_(float x) { return x * sigmoidf_(x); }
__device__ __forceinline__ float gelu_tanh(float x) { const float c = 0.7978845608028654f; float u = c * (x + 0.044715f * x * x * x); return 0.5f * x * (1.f + tanhf(u)); }
__device__ __forceinline__ float wave_sum(float v) {
#pragma unroll
    for (int o = 1; o < 64; o <<= 1) v += __shfl_xor(v, o);
    return v;
}

constexpr size_t MiB = 1u << 20;
constexpr size_t WS_Z = 0;
constexpr size_t WS_MIX = 208 * MiB;
constexpr size_t WS_XB = 304 * MiB;
constexpr size_t WS_Y2 = 368 * MiB;
constexpr size_t WS_WIN = 400 * MiB;
constexpr size_t WS_WOUT = 426 * MiB;
constexpr size_t WS_WGLU = 438 * MiB;
constexpr size_t WS_WMEM = 440 * MiB;
constexpr size_t WS_MEMB = 448 * MiB;
constexpr size_t WS_MK = 452 * MiB;
constexpr size_t WS_MV = 460 * MiB;
constexpr size_t WS_ROPE = 468 * MiB;
constexpr size_t WS_SSMP = 476 * MiB;
constexpr size_t WS_SUMSQ = 508 * MiB;
constexpr size_t WS_MISC = 510 * MiB;
constexpr size_t WS_END = 511 * MiB;


namespace pg8 {
#define PG8_LAS __attribute__((address_space(3)))
typedef _Float16 f16x8 __attribute__((ext_vector_type(8)));
typedef _Float16 f16x2 __attribute__((ext_vector_type(2)));
typedef float f32x4 __attribute__((ext_vector_type(4)));
typedef unsigned u32x4 __attribute__((ext_vector_type(4)));
typedef unsigned u32x2 __attribute__((ext_vector_type(2)));
constexpr int BM = 256, BK = 64, HALF = 128, HTB = HALF * BK * 2, STAGE_BYTES = 8 * HTB, NXCD = 8, WGM = 8;
__host__ __device__ __forceinline__ int lds_byte(int r, int c) { const int st = (r >> 4) * 2 + (c >> 5), rr = r & 15, cc = c & 31, ob = rr * 64 + cc * 2; return st * 1024 + (ob ^ (((ob >> 9) & 1) << 5)); }
__host__ __device__ __forceinline__ void stage_rc(int b, int& R, int& C) { const int st = b / 1024, sb = b % 1024, swz = sb ^ (((sb >> 9) & 1) << 5); R = (st >> 1) * 16 + swz / 64; C = (st & 1) * 32 + (swz % 64) / 2; }
__host__ __device__ __forceinline__ int perm32(int rho) { const int n = rho >> 4, i = rho & 15; return 8 * (i >> 2) + 4 * n + (i & 3); }
struct Unit { int pm, pn, c0, half; };
struct Gemm { const bf16_t* A; const bf16_t* Bt; int M, N, K; };
struct StaticOrder {
    int nM, nN, nwg, G, c;
    __host__ __device__ void init(int M, int N, int G_, int c_) { nM = M / BM; nN = N / BM; nwg = nM * nN; G = G_; c = c_; }
    __host__ __device__ bool next(int i, Unit& u) const {
        const long L = (long)i * G + c; if (L >= nwg) return false;
        int wgid = (int)L; { const int q = nwg / NXCD, r = nwg % NXCD, xcd = wgid % NXCD, off = wgid / NXCD; wgid = (xcd < r ? xcd * (q + 1) : r * (q + 1) + (xcd - r) * q) + off; }
        const int nig = WGM * nN, gid = wgid / nig, fm = gid * WGM, gsz = (nM - fm) < WGM ? (nM - fm) : WGM;
        u.pm = fm + ((wgid % nig) % gsz); u.pn = (wgid % nig) / gsz; u.c0 = u.pn * BM; u.half = 0; return true;
    }
    __device__ __forceinline__ void a_ready(const Unit&) const {}
    __device__ __forceinline__ void done(const Unit&) const {}
};
struct TailOrder : StaticOrder {
    __host__ __device__ bool next(int i, Unit& u) const {
        const int full = nwg / G, left = nwg - full * G;
        if (i < full || 2 * left > G) return StaticOrder::next(i, u);
        if (i > full || c >= 2 * left) return false;
        StaticOrder t = *this; t.c = c >> 1;
        (void)t.StaticOrder::next(full, u);
        u.c0 += 128 * (c & 1); u.half = 1; return true;
    }
};
struct SkipOrder : StaticOrder {
    int skip;
    __host__ __device__ void init2(int M, int N, int G_, int c_, int skip_) { init(M, N - BM, G_, c_); skip = skip_; }
    __host__ __device__ bool next(int i, Unit& u) const { if (!StaticOrder::next(i, u)) return false; if (u.pn >= skip) { u.pn += 1; u.c0 = u.pn * BM; } return true; }
};
struct DeferOrder {
    int nM, pn, G, c;
    __host__ __device__ void init(int M, int G_, int c_, int pn_) { nM = M / BM; G = G_; c = c_; pn = pn_; }
    __host__ __device__ bool next(int i, Unit& u) const { const int L = i * G + c; if (L >= nM) return false; u.pm = L; u.pn = pn; u.c0 = pn * BM; u.half = 0; return true; }
    __device__ __forceinline__ void a_ready(const Unit&) const {}
    __device__ __forceinline__ void done(const Unit&) const {}
};
struct MemTailOrder {
    int k, stride, nM, nwg;
    __host__ __device__ void init(int M, int N, int G, int c, int first) { nM = M / BM; nwg = nM * (N / BM); k = c - first; stride = G - first; }
    __host__ __device__ bool next(int i, Unit& u) const {
        if (k < 0) return false;
        const int L = i * stride + k; if (L >= nwg) return false;
        u.pm = L % nM; u.pn = L / nM; u.c0 = u.pn * BM; u.half = 0; return true;
    }
    __device__ __forceinline__ void a_ready(const Unit&) const {}
    __device__ __forceinline__ void done(const Unit&) const {}
};
__device__ __forceinline__ unsigned pk_f16(float lo, float hi) { f16x2 v = {(_Float16)lo, (_Float16)hi}; return __builtin_bit_cast(unsigned, v); }
__device__ __forceinline__ float h_lo(unsigned w) { return (float)__builtin_bit_cast(_Float16, (unsigned short)(w & 0xffffu)); }
__device__ __forceinline__ float h_hi(unsigned w) { return (float)__builtin_bit_cast(_Float16, (unsigned short)(w >> 16)); }

struct EpiZ {
    static constexpr bool PERM = true, AFTER_DRAIN = false;
    bf16_t* Z; const float* sumsq; const bf16_t* rope; const float* qg; const float* kg;
    __device__ __forceinline__ void operator()(const f32x4 (&acc)[2][2][4][2], const Unit& u, int wr, int wc, int fr, int fq) const {
        const int row0 = u.pm * BM + wr * 64 + fr, cw = u.c0 + wc * 64, col0 = cw + 8 * fq;
        const bool is_q = cw < ZK, is_k = (cw >= ZK) && (cw < ZV), is_gate = (cw >= ZG && cw < ZU) || (cw >= ZSG && cw < ZXQ) || (cw >= ZXG);
        f32x4 g0a = {1.f, 1.f, 1.f, 1.f}, g0b = g0a, g1a = g0a, g1b = g0a; float qs = 1.f;
        if (is_q || is_k) { const float* g = is_q ? qg : kg; g0a = *(const f32x4*)(g + 8 * fq); g0b = *(const f32x4*)(g + 8 * fq + 4); g1a = *(const f32x4*)(g + 32 + 8 * fq); g1b = *(const f32x4*)(g + 36 + 8 * fq);
            if (is_q) qs = 0.125f * 1.4426950408889634f; }
#pragma unroll
        for (int ai = 0; ai < 2; ++ai)
#pragma unroll
            for (int m = 0; m < 4; ++m) { const int r = row0 + ai * HALF + m * 16;
                const f32x4* sp = (const f32x4*)(sumsq + (size_t)r * 16); const f32x4 s0 = sp[0], s1 = sp[1], s2 = sp[2], s3 = sp[3];
                const float ss = ((s0[0] + s0[1]) + (s0[2] + s0[3])) + ((s1[0] + s1[1]) + (s1[2] + s1[3])) + ((s2[0] + s2[1]) + (s2[2] + s2[3])) + ((s3[0] + s3[1]) + (s3[2] + s3[3]));
                const float rs = rsqrtf(ss * (1.f / D_MODEL) + EPS);
                f32x4 a0 = acc[ai][0][m][0] * rs, a1 = acc[ai][0][m][1] * rs, b0 = acc[ai][1][m][0] * rs, b1 = acc[ai][1][m][1] * rs;
                if (is_q || is_k) {
                    float hs = ((a0[0] * a0[0] + a0[1] * a0[1]) + (a0[2] * a0[2] + a0[3] * a0[3])) + ((a1[0] * a1[0] + a1[1] * a1[1]) + (a1[2] * a1[2] + a1[3] * a1[3]))
                             + ((b0[0] * b0[0] + b0[1] * b0[1]) + (b0[2] * b0[2] + b0[3] * b0[3])) + ((b1[0] * b1[0] + b1[1] * b1[1]) + (b1[2] * b1[2] + b1[3] * b1[3]));
                    hs += __shfl_xor(hs, 16); hs += __shfl_xor(hs, 32);
                    const float rn = rsqrtf(hs * (1.f / HD) + EPS);
                    const u32x4 cv = *(const u32x4*)(rope + (size_t)r * 64 + 8 * fq), sv = *(const u32x4*)(rope + (size_t)r * 64 + 32 + 8 * fq);
                    a0 = a0 * g0a * rn; a1 = a1 * g0b * rn; b0 = b0 * g1a * rn; b1 = b1 * g1b * rn;
                    const f32x4 c0 = {h_lo(cv.x), h_hi(cv.x), h_lo(cv.y), h_hi(cv.y)}, c1 = {h_lo(cv.z), h_hi(cv.z), h_lo(cv.w), h_hi(cv.w)};
                    const f32x4 n0 = {h_lo(sv.x), h_hi(sv.x), h_lo(sv.y), h_hi(sv.y)}, n1 = {h_lo(sv.z), h_hi(sv.z), h_lo(sv.w), h_hi(sv.w)};
                    const f32x4 ra0 = (a0 * c0 - b0 * n0) * qs, ra1 = (a1 * c1 - b1 * n1) * qs, rb0 = (b0 * c0 + a0 * n0) * qs, rb1 = (b1 * c1 + a1 * n1) * qs;
                    a0 = ra0; a1 = ra1; b0 = rb0; b1 = rb1;
                } else if (is_gate) {
#pragma unroll
                    for (int j = 0; j < 4; ++j) { a0[j] = a0[j] * sigmoidf_(a0[j]); a1[j] = a1[j] * sigmoidf_(a1[j]); b0[j] = b0[j] * sigmoidf_(b0[j]); b1[j] = b1[j] * sigmoidf_(b1[j]); }
                }
                bf16_t* rowp = Z + (size_t)r * IN_W + col0;
                u32x4 w; w.x = pk_f16(a0[0], a0[1]); w.y = pk_f16(a0[2], a0[3]); w.z = pk_f16(a1[0], a1[1]); w.w = pk_f16(a1[2], a1[3]); *(u32x4*)(rowp) = w;
                w.x = pk_f16(b0[0], b0[1]); w.y = pk_f16(b0[2], b0[3]); w.z = pk_f16(b1[0], b1[1]); w.w = pk_f16(b1[2], b1[3]); *(u32x4*)(rowp + 32) = w; }
    }
};
struct EpiGlu {
    static constexpr bool PERM = true, AFTER_DRAIN = false;
    const bf16_t* Y2; const bf16_t* Z; const float* bg; bf16_t* MIX;
    __device__ __forceinline__ void operator()(const f32x4 (&acc)[2][2][4][2], const Unit& u, int wr, int wc, int fr, int fq) const {
        const int row0 = u.pm * BM + wr * 64 + fr, col0 = u.c0 + wc * 64 + 8 * fq;
#pragma unroll
        for (int bj = 0; bj < 2; ++bj) { const int c = col0 + bj * 32;
            const f32x4 b0 = *(const f32x4*)(bg + c), b1 = *(const f32x4*)(bg + c + 4);
#pragma unroll
            for (int ai = 0; ai < 2; ++ai)
#pragma unroll
                for (int m = 0; m < 4; ++m) { const int r = row0 + ai * HALF + m * 16;
                    const u32x4 yv = *(const u32x4*)(Y2 + (size_t)r * SSM_W + c), sv = *(const u32x4*)(Z + (size_t)r * IN_W + ZSG + c);
                    const f32x4 a0 = acc[ai][bj][m][0] + b0, a1 = acc[ai][bj][m][1] + b1;
                    float o[8];
#pragma unroll
                    for (int j = 0; j < 4; ++j) { const unsigned yw = yv[j], sw = sv[j];
                        const float g0 = (j < 2) ? a0[2 * j] : a1[2 * j - 4], g1 = (j < 2) ? a0[2 * j + 1] : a1[2 * j - 3];
                        o[2 * j] = h_lo(yw) * sigmoidf_(g0) * h_lo(sw); o[2 * j + 1] = h_hi(yw) * sigmoidf_(g1) * h_hi(sw); }
                    u32x4 w; w.x = pk_f16(o[0], o[1]); w.y = pk_f16(o[2], o[3]); w.z = pk_f16(o[4], o[5]); w.w = pk_f16(o[6], o[7]);
                    *(u32x4*)(MIX + (size_t)r * MIX_W + 512 + c) = w; } }
    }
};
template <int MODE> struct EpiOut {
    static constexpr bool PERM = true, AFTER_DRAIN = false;
    const float* xin; float* xout; bf16_t* XB; float* sumsq;
    __device__ __forceinline__ void operator()(const f32x4 (&acc)[2][2][4][2], const Unit& u, int wr, int wc, int fr, int fq) const {
        const int row0 = u.pm * BM + wr * 64 + fr, col0 = u.c0 + wc * 64 + 8 * fq;
#pragma unroll
        for (int ai = 0; ai < 2; ++ai)
#pragma unroll
            for (int m = 0; m < 4; ++m) { const int r = row0 + ai * HALF + m * 16; const size_t off = (size_t)r * D_MODEL + col0; float ss = 0.f;
#pragma unroll
                for (int bj = 0; bj < 2; ++bj) { f32x4 x0, x1;
                    if (MODE == 0) { x0 = *(const f32x4*)(xin + off + bj * 32); x1 = *(const f32x4*)(xin + off + bj * 32 + 4); }
                    else { const u32x4 xv = *(const u32x4*)(XB + off + bj * 32); x0 = (f32x4){h_lo(xv.x), h_hi(xv.x), h_lo(xv.y), h_hi(xv.y)}; x1 = (f32x4){h_lo(xv.z), h_hi(xv.z), h_lo(xv.w), h_hi(xv.w)}; }
                    const f32x4 o0 = x0 + acc[ai][bj][m][0], o1 = x1 + acc[ai][bj][m][1];
                    if (MODE == 2) { *(f32x4*)(xout + off + bj * 32) = o0; *(f32x4*)(xout + off + bj * 32 + 4) = o1; }
                    else { u32x4 w; w.x = pk_f16(o0[0], o0[1]); w.y = pk_f16(o0[2], o0[3]); w.z = pk_f16(o1[0], o1[1]); w.w = pk_f16(o1[2], o1[3]); *(u32x4*)(XB + off + bj * 32) = w;
                        ss += ((o0[0] * o0[0] + o0[1] * o0[1]) + (o0[2] * o0[2] + o0[3] * o0[3])) + ((o1[0] * o1[0] + o1[1] * o1[1]) + (o1[2] * o1[2] + o1[3] * o1[3])); } }
                if (MODE != 2) { ss += __shfl_xor(ss, 16); ss += __shfl_xor(ss, 32);
                    if (fq == 0) sumsq[(size_t)r * 16 + (u.c0 >> 8) * 4 + wc] = ss; } }
    }
};
struct EpiMemF32 {
    static constexpr bool PERM = false, AFTER_DRAIN = false;
    float* C; int ldc; const float* rstd;
    __device__ __forceinline__ void operator()(const f32x4 (&acc)[2][2][4][2], const Unit& u, int wr, int wc, int fr, int fq) const {
        const int row0 = u.pm * BM + wr * 64 + fr, col0 = u.c0 + wc * 32 + 4 * fq;
#pragma unroll
        for (int ai = 0; ai < 2; ++ai)
#pragma unroll
            for (int m = 0; m < 4; ++m) { const int r = row0 + ai * HALF + m * 16; const float rs = rstd[r]; float* rowp = C + (size_t)r * ldc + col0;
#pragma unroll
                for (int bj = 0; bj < 2; ++bj)
#pragma unroll
                    for (int n = 0; n < 2; ++n) *(f32x4*)(rowp + bj * HALF + n * 16) = acc[ai][bj][m][n] * rs; }
    }
};

template <class Epi, class Sched, bool ALIGN_EPI>
__device__ __forceinline__ void gemm_phase(PG8_LAS unsigned char* lds, const Gemm g, const Sched& S, const Epi& E) {
    int tid = threadIdx.x; asm volatile("" : "+v"(tid)); const int wid = __builtin_amdgcn_readfirstlane(tid >> 6), lane = tid & 63, wr = wid >> 2, wc = wid & 3, fr = lane & 15, fq = lane >> 4;
    const int K = g.K, nt = K / BK;
    unsigned voffA[2], voffB[2];
#pragma unroll
    for (int i = 0; i < 2; ++i) { int R, C; stage_rc(tid * 16 + i * 8192, R, C); const int Rb = Epi::PERM ? (64 * (R >> 5) + perm32(R & 31)) : R;
        voffA[i] = (unsigned)(R * K + C) * 2u; voffB[i] = (unsigned)(Rb * K + C) * 2u; }
    const size_t kstep = (size_t)(BK * 2);
    const size_t hstep = (size_t)HALF * K * 2;
    const size_t tstep = 2 * hstep;
    const size_t bhs = Epi::PERM ? (size_t)32 * K * 2 : hstep;
    const unsigned ldsw = (unsigned)wid * 1024u;
    const int aoff = lds_byte(wr * 64 + fr, fq * 8), boff = lds_byte(wc * 32 + fr, fq * 8);
#define PG8_SA(b, h) (((b) * 2 + (h)) * HTB)
#define PG8_SB(b, h) ((4 + (b) * 2 + (h)) * HTB)
#define PG8_STAGE(bufoff, gbase, voff) do { _Pragma("unroll") for (int _i = 0; _i < 2; ++_i) \
        __builtin_amdgcn_global_load_lds((const unsigned*)((const char*)(gbase) + (voff)[_i]), (PG8_LAS unsigned*)(lds + (bufoff) + ldsw + _i * 8192), 16, 0, 0); } while (0)
#define PG8_LDA(dst, b, h) do { _Pragma("unroll") for (int m = 0; m < 4; ++m) _Pragma("unroll") for (int k = 0; k < 2; ++k) dst[m][k] = *(const PG8_LAS f16x8*)(lds + PG8_SA(b, h) + aoff + m * 2048 + k * 1024); } while (0)
#define PG8_LDB(dst, b, h) do { _Pragma("unroll") for (int n = 0; n < 2; ++n) _Pragma("unroll") for (int k = 0; k < 2; ++k) dst[n][k] = *(const PG8_LAS f16x8*)(lds + PG8_SB(b, h) + boff + n * 2048 + k * 1024); } while (0)
#define PG8_MMA(ai, bj, At, Bt) do { __builtin_amdgcn_s_setprio(1); _Pragma("unroll") for (int m = 0; m < 4; ++m) _Pragma("unroll") for (int n = 0; n < 2; ++n) _Pragma("unroll") for (int k = 0; k < 2; ++k) \
        acc[ai][bj][m][n] = __builtin_amdgcn_mfma_f32_16x16x32_f16(Bt[n][k], At[m][k], acc[ai][bj][m][n], 0, 0, 0); __builtin_amdgcn_s_setprio(0); } while (0)
#define PG8_WAIT_V(n) asm volatile("s_waitcnt vmcnt(" #n ")" ::: "memory")
#define PG8_WAIT_L(n) asm volatile("s_waitcnt lgkmcnt(" #n ")" ::: "memory")
#define PG8_BAR __builtin_amdgcn_s_barrier()
#define PG8_SCHED __builtin_amdgcn_sched_barrier(0)
    Unit cur, nxt; int ui = 0;
    if (!S.next(0, cur)) return;
    f32x4 acc[2][2][4][2];
#pragma unroll
    for (int a = 0; a < 2; ++a)
#pragma unroll
        for (int b = 0; b < 2; ++b)
#pragma unroll
            for (int m = 0; m < 4; ++m)
#pragma unroll
                for (int n = 0; n < 2; ++n) acc[a][b][m][n] = (f32x4){0.f, 0.f, 0.f, 0.f};
    f16x8 At[4][2], B0[2][2], B1[2][2];
    const char* cA = (const char*)g.A + (size_t)cur.pm * tstep; const char* cB = (const char*)g.Bt + (size_t)cur.c0 * K * 2;
    S.a_ready(cur);
    PG8_STAGE(PG8_SB(0, 0), cB, voffB); PG8_STAGE(PG8_SB(0, 1), cB + bhs, voffB); PG8_STAGE(PG8_SA(0, 0), cA, voffA); PG8_STAGE(PG8_SA(0, 1), cA + hstep, voffA);
    if (wr == 1) PG8_BAR;
    PG8_WAIT_V(2); PG8_BAR;
    PG8_STAGE(PG8_SB(1, 0), cB + kstep, voffB); PG8_STAGE(PG8_SA(1, 0), cA + kstep, voffA); PG8_STAGE(PG8_SB(1, 1), cB + bhs + kstep, voffB);
    PG8_WAIT_V(6); PG8_BAR;
    for (;;) {
        const bool has_next = S.next(ui + 1, nxt);
        const char* nA = has_next ? (const char*)g.A + (size_t)nxt.pm * tstep : cA; const char* nB = has_next ? (const char*)g.Bt + (size_t)nxt.c0 * K * 2 : cB;
        for (int t = 0; t < nt; t += 2) {
            const bool last = (t == nt - 2);
            const char* a1 = cA + (size_t)(t + 1) * kstep;
            const char* a2 = last ? nA : cA + (size_t)(t + 2) * kstep; const char* b2 = last ? nB : cB + (size_t)(t + 2) * kstep;
            const char* a3 = a2 + kstep; const char* b3 = b2 + kstep;
            if (last && has_next) S.a_ready(nxt);
            PG8_LDB(B0, 0, 0); PG8_LDB(B1, 0, 1); PG8_SCHED; PG8_LDA(At, 0, 0); PG8_STAGE(PG8_SA(1, 1), a1 + hstep, voffA);
            PG8_WAIT_V(8); PG8_WAIT_L(0); PG8_BAR; PG8_MMA(0, 0, At, B0); if (!cur.half) PG8_MMA(0, 1, At, B1); PG8_BAR; PG8_SCHED;
            PG8_LDA(At, 0, 1); PG8_STAGE(PG8_SB(0, 0), b2, voffB); PG8_STAGE(PG8_SB(0, 1), b2 + bhs, voffB); PG8_STAGE(PG8_SA(0, 0), a2, voffA);
            PG8_WAIT_V(8); PG8_WAIT_L(0); PG8_BAR; PG8_MMA(1, 0, At, B0); if (!cur.half) PG8_MMA(1, 1, At, B1); PG8_BAR; PG8_SCHED;
            PG8_LDB(B0, 1, 0); PG8_LDB(B1, 1, 1); PG8_SCHED; PG8_LDA(At, 1, 0); PG8_STAGE(PG8_SA(0, 1), a2 + hstep, voffA);
            PG8_WAIT_V(8); PG8_WAIT_L(0); PG8_BAR; PG8_MMA(0, 0, At, B0); if (!cur.half) PG8_MMA(0, 1, At, B1); PG8_BAR; PG8_SCHED;
            PG8_LDA(At, 1, 1); PG8_STAGE(PG8_SB(1, 0), b3, voffB); PG8_STAGE(PG8_SB(1, 1), b3 + bhs, voffB); PG8_STAGE(PG8_SA(1, 0), a3, voffA);
            PG8_WAIT_V(8); PG8_WAIT_L(0); PG8_BAR; PG8_MMA(1, 0, At, B0); if (!cur.half) PG8_MMA(1, 1, At, B1); PG8_BAR; PG8_SCHED;
        }
        if constexpr (ALIGN_EPI) { if (wr == 0) PG8_BAR; }
        E(acc, cur, wr, wc, fr, fq); S.done(cur);
        if (!has_next) break;
#pragma unroll
        for (int a = 0; a < 2; ++a)
#pragma unroll
            for (int b = 0; b < 2; ++b)
#pragma unroll
                for (int m = 0; m < 4; ++m)
#pragma unroll
                    for (int n = 0; n < 2; ++n) acc[a][b][m][n] = (f32x4){0.f, 0.f, 0.f, 0.f};
        cur = nxt; cA = nA; cB = nB; ++ui;
        if constexpr (ALIGN_EPI) { if (wr == 1) PG8_BAR; }
    }
    PG8_WAIT_V(0);
    if constexpr (!ALIGN_EPI) { if (wr == 0) PG8_BAR; }
    PG8_BAR;
#undef PG8_SA
#undef PG8_SB
#undef PG8_STAGE
#undef PG8_LDA
#undef PG8_LDB
#undef PG8_MMA
#undef PG8_WAIT_V
#undef PG8_WAIT_L
#undef PG8_BAR
#undef PG8_SCHED
}
}

constexpr int NWAVES = 8, NTHREADS = 512;
constexpr int LDS_BYTES = 155648;
constexpr int LDSCTL_OFF = 154624;
#define LAS __attribute__((address_space(3)))
typedef unsigned v4u __attribute__((ext_vector_type(4)));
typedef float f32x4 __attribute__((ext_vector_type(4)));

struct Params {
    const float* x; const float* mem; const int* pos; const float* norm_g; const float* w_in; const float* q_norm_g; const float* k_norm_g; const float* sinks;
    const float* lam_re; const float* lam_im; const float* log_dt; const float* b_re; const float* b_im; const float* c_re; const float* c_im; const float* d_skip;
    const float* w_glu; const float* b_glu; const float* mem_norm_g; const float* w_mem_kv; const float* xq_norm_g; const float* xk_norm_g; const float* w_out;
    float* out; unsigned char* ws;
};

__device__ __forceinline__ void p0_transpose_item(const float* W, int K, int N, const float* scale, bf16_t* WT, LAS float* scr, int item, int lane) {
    const int nblk = N / 64, kb = item / nblk, nb = item % nblk, k0 = 64 * kb, n0 = 64 * nb;
    const int lr = lane >> 4, lc = (lane & 15) * 4;
#pragma unroll 4
    for (int i = 0; i < 16; ++i) { const int kk = 4 * i + lr; const float sc = scale ? scale[k0 + kk] : 1.f; const f32x4 v = *(const f32x4*)(W + (size_t)(k0 + kk) * N + n0 + lc);
        LAS float* d = scr + kk * 65 + lc; d[0] = v[0] * sc; d[1] = v[1] * sc; d[2] = v[2] * sc; d[3] = v[3] * sc; }
    asm volatile("s_waitcnt lgkmcnt(0)" ::: "memory");
    const int c = lane & 7;
#pragma unroll
    for (int j = 0; j < 8; ++j) { const int n = (lane >> 3) + 8 * j; const LAS float* s = scr + (8 * c) * 65 + n;
        v4u o; o.x = pg8::pk_f16(s[0 * 65], s[1 * 65]); o.y = pg8::pk_f16(s[2 * 65], s[3 * 65]); o.z = pg8::pk_f16(s[4 * 65], s[5 * 65]); o.w = pg8::pk_f16(s[6 * 65], s[7 * 65]);
        *(v4u*)(WT + (size_t)(n0 + n) * K + k0 + 8 * c) = o; }
    asm volatile("s_waitcnt lgkmcnt(0)" ::: "memory");
}
__device__ __forceinline__ void phase_prep(const Params& P, LAS unsigned char* lds, int vcu, int G) {
    int tid = threadIdx.x; asm volatile("" : "+v"(tid)); const int lane = tid & 63, wave = __builtin_amdgcn_readfirstlane(tid >> 6);
    LAS float* scr = (LAS float*)(lds + wave * 16640);
    const int gw = vcu * NWAVES + wave, NGW = G * NWAVES;
    unsigned char* ws = P.ws;
    constexpr int I_IN = (D_MODEL / 64) * (IN_W / 64), I_OUT = (MIX_W / 64) * (D_MODEL / 64), I_GLU = (SSM_W / 64) * (SSM_W / 64), I_MEM = (D_MODEL / 64) * (1024 / 64);
    constexpr int I_LAYER = I_IN + I_OUT + I_GLU + I_MEM;
    for (int it = gw; it < DEPTH * I_LAYER; it += NGW) {
        const int l = it / I_LAYER; int r = it % I_LAYER;
        if (r < I_IN) { p0_transpose_item(P.w_in + (size_t)l * D_MODEL * IN_W, D_MODEL, IN_W, P.norm_g + l * D_MODEL, (bf16_t*)(ws + WS_WIN) + (size_t)l * IN_W * D_MODEL, scr, r, lane); continue; } r -= I_IN;
        if (r < I_OUT) { p0_transpose_item(P.w_out + (size_t)l * MIX_W * D_MODEL, MIX_W, D_MODEL, nullptr, (bf16_t*)(ws + WS_WOUT) + (size_t)l * D_MODEL * MIX_W, scr, r, lane); continue; } r -= I_OUT;
        if (r < I_GLU) { p0_transpose_item(P.w_glu + (size_t)l * SSM_W * SSM_W, SSM_W, SSM_W, nullptr, (bf16_t*)(ws + WS_WGLU) + (size_t)l * SSM_W * SSM_W, scr, r, lane); continue; } r -= I_GLU;
        p0_transpose_item(P.w_mem_kv + (size_t)l * D_MODEL * 1024, D_MODEL, 1024, P.mem_norm_g + l * D_MODEL, (bf16_t*)(ws + WS_WMEM) + (size_t)l * 1024 * D_MODEL, scr, r, lane);
    }
    for (int m = gw; m < MTOK + BATCH * N_MEM; m += NGW) {
        const bool is_x = m < MTOK; const int row = is_x ? m : m - MTOK;
        const f32x4* xr = (const f32x4*)((is_x ? P.x : P.mem) + (size_t)row * D_MODEL) + lane;
        bf16_t* ob = (bf16_t*)(ws + (is_x ? WS_XB : WS_MEMB)) + (size_t)row * D_MODEL;
        f32x4 v[4]; float s = 0.f;
#pragma unroll
        for (int j = 0; j < 4; ++j) { v[j] = xr[64 * j]; s += (v[j][0] * v[j][0] + v[j][1] * v[j][1]) + (v[j][2] * v[j][2] + v[j][3] * v[j][3]); }
        s = wave_sum(s);
#pragma unroll
        for (int j = 0; j < 4; ++j) { pg8::u32x2 w; w.x = pg8::pk_f16(v[j][0], v[j][1]); w.y = pg8::pk_f16(v[j][2], v[j][3]); *((pg8::u32x2*)ob + lane + 64 * j) = w; }
        if (is_x) { if (lane < 16) ((float*)(ws + WS_SUMSQ))[(size_t)row * 16 + lane] = (lane == 0) ? s : 0.f; }
        else if (lane == 0) ((float*)(ws + WS_MISC))[row] = rsqrtf(s * (1.f / D_MODEL) + EPS);
    }
    { bf16_t* tab = (bf16_t*)(ws + WS_ROPE);
      for (int idx = vcu * NTHREADS + tid; idx < MTOK * 32; idx += G * NTHREADS) { const int tok = idx >> 5, i = idx & 31;
          const float inv = powf(10000.0f, -(float)i / 32.0f); const float ang = (float)P.pos[tok] * inv; const double a = (double)ang;
          tab[tok * 64 + i] = f2bf((float)cos(a)); tab[tok * 64 + 32 + i] = f2bf((float)sin(a)); } }
}


typedef _Float16 f16x8 __attribute__((ext_vector_type(8)));
typedef float f32x16 __attribute__((ext_vector_type(16)));
__device__ __forceinline__ int crow(int r, int hi) { return (r & 3) + 8 * (r >> 2) + 4 * hi; }
__device__ __forceinline__ float hf(_Float16 h) { return (float)h; }
constexpr float LOG2E = 1.4426950408889634f;
__device__ __forceinline__ f16x8 pack8(const f32x16& p, int s) { f16x8 r;
#pragma unroll
    for (int j = 0; j < 8; ++j) r[j] = (_Float16)p[8 * s + j];
    return r; }


__device__ __forceinline__ void stage_tile(LAS unsigned char* st, int pitchB, int colOff, const f32x16& o, int c, int hi) {
#pragma unroll
    for (int r = 0; r < 16; ++r) *(LAS _Float16*)(st + crow(r, hi) * pitchB + (colOff + c) * 2) = (_Float16)o[r];
}

typedef unsigned v2u __attribute__((ext_vector_type(2)));
__device__ __forceinline__ void stage_ot(LAS unsigned char* st, int pitchB, int colOff, const f32x16& o, float sc, int q, int hi) {
#pragma unroll
    for (int g4 = 0; g4 < 4; ++g4) { v2u w; w.x = pg8::pk_f16(o[4 * g4] * sc, o[4 * g4 + 1] * sc); w.y = pg8::pk_f16(o[4 * g4 + 2] * sc, o[4 * g4 + 3] * sc);
        *(LAS v2u*)(st + q * pitchB + (colOff + 8 * g4 + 4 * hi) * 2) = w; }
}
__device__ __forceinline__ void stage_ot2(LAS unsigned char* st, int pitchB, int colOff, const f32x16& o0, float s0, const f32x16& o1, float s1, int q, int hi) {
#pragma unroll
    for (int g4 = 0; g4 < 4; ++g4) { v2u w; w.x = pg8::pk_f16(o0[4 * g4] * s0 + o1[4 * g4] * s1, o0[4 * g4 + 1] * s0 + o1[4 * g4 + 1] * s1); w.y = pg8::pk_f16(o0[4 * g4 + 2] * s0 + o1[4 * g4 + 2] * s1, o0[4 * g4 + 3] * s0 + o1[4 * g4 + 3] * s1);
        *(LAS v2u*)(st + q * pitchB + (colOff + 8 * g4 + 4 * hi) * 2) = w; }
}
__device__ __forceinline__ v4u pk_mul8(v4u a, v4u b) { return __builtin_bit_cast(v4u, __builtin_bit_cast(f16x8, a) * __builtin_bit_cast(f16x8, b)); }

typedef _Float16 h2_t __attribute__((ext_vector_type(2)));
__device__ __forceinline__ float sum8_f16(f16x8 v, float acc) {
    const h2_t one = {(_Float16)1.f, (_Float16)1.f};
#pragma unroll
    for (int k = 0; k < 4; ++k) { const h2_t p = {v[2 * k], v[2 * k + 1]}; acc = __builtin_amdgcn_fdot2(p, one, acc, false); }
    return acc; }
__device__ __forceinline__ float silu_fast(float x) { return x * __builtin_amdgcn_rcpf(1.f + __expf(-x)); }
constexpr int ATT_KF = 0, ATT_VF = 32768, ATT_ST = 65536;
__device__ __forceinline__ int opaque_tid() { int t = threadIdx.x; asm volatile("" : "+v"(t)); return t; }
__device__ __forceinline__ void attn_a_item(const Params& P, int layer, LAS unsigned char* lds, int item) {
    const int tid = opaque_tid(), lane = tid & 63, wave = __builtin_amdgcn_readfirstlane(tid >> 6);
    const int kvh = item & 1, blk = (item >> 1) & 31, b = item >> 6;
    const bf16_t* Z = (const bf16_t*)(P.ws + WS_Z); bf16_t* MIX = (bf16_t*)(P.ws + WS_MIX); const bf16_t* rope = (const bf16_t*)(P.ws + WS_ROPE);
    const float* kg = P.k_norm_g + layer * HD; const float* qg = P.q_norm_g + layer * HD;
    {
        const int key = tid >> 1, hh = tid & 1, tpos = blk * 128 - 128 + key; const bool valid = tpos >= 0;
        const int tok = b * SEQ + (valid ? tpos : 0);
        const bf16_t* zr = Z + (size_t)tok * IN_W;
        const int kt = key >> 5, kl = key & 31;
#pragma unroll
        for (int i = 0; i < 2; ++i) { const int c = 2 * hh + i;
            f16x8 o1 = *(const f16x8*)(zr + ZK + kvh * HD + 8 * c), o2 = *(const f16x8*)(zr + ZK + kvh * HD + 32 + 8 * c);
            if (!valid) { o1 = (f16x8){0, 0, 0, 0, 0, 0, 0, 0}; o2 = o1; }
            { const int cc = c;     *(LAS f16x8*)(lds + ATT_KF + (((kt * 4 + (cc >> 1)) * 64) + kl + 32 * (cc & 1)) * 16) = o1; }
            { const int cc = c + 4; *(LAS f16x8*)(lds + ATT_KF + (((kt * 4 + (cc >> 1)) * 64) + kl + 32 * (cc & 1)) * 16) = o2; } }
        const int sK = kl >> 4, h2 = ((kl & 15) >> 2) & 1, jj = 4 * ((kl & 15) >> 3) + (kl & 3);
        LAS unsigned short* vb = (LAS unsigned short*)(lds + ATT_VF + ((((kt * 2 + hh) * 2 + sK) * 64) + 32 * h2) * 16 + 2 * jj);
#pragma unroll
        for (int i = 0; i < 4; ++i) { const v4u v = *(const v4u*)(zr + ZV + kvh * HD + 32 * hh + 8 * i);
#pragma unroll
            for (int j = 0; j < 8; ++j) { const unsigned wv = v[j >> 1]; vb[(8 * i + j) * 8] = valid ? (unsigned short)((j & 1) ? (wv >> 16) : (wv & 0xffffu)) : (unsigned short)0; } }
    }
    const int ql = lane & 31, hi = lane >> 5;
    f16x8 qfu[2][4];
#pragma unroll
    for (int ui = 0; ui < 2; ++ui) {
        const int head = 2 * (wave >> 2) + ui, w = wave & 3, hq = kvh * 4 + head;
        const int tq = b * SEQ + blk * 128 + 32 * w + ql;
        const bf16_t* zq = Z + (size_t)tq * IN_W + ZQ + hq * HD;
#pragma unroll
        for (int d0 = 0; d0 < 4; ++d0) qfu[ui][d0] = *(const f16x8*)(zq + 16 * d0 + 8 * hi);
    }
    __syncthreads();
#pragma unroll
    for (int ui = 0; ui < 2; ++ui) {
        const int head = 2 * (wave >> 2) + ui, w = wave & 3, hq = kvh * 4 + head;
        const f16x8* qf = qfu[ui];
        const int erow = lane >> 1, ehs = lane & 1; const size_t etok = (size_t)b * SEQ + blk * 128 + 32 * w + erow; const int ecol = hq * HD + 32 * ehs;
        v4u gv[4];
#pragma unroll
        for (int i = 0; i < 4; ++i) gv[i] = *(const v4u*)(Z + etok * IN_W + ZG + ecol + 8 * i);
        f32x16 p[5];
#pragma unroll
        for (int t = 0; t < 5; ++t) { const int kt = w + t; f32x16 acc = {};
#pragma unroll
            for (int d0 = 0; d0 < 4; ++d0) { const f16x8 kf = *(const LAS f16x8*)(lds + ATT_KF + ((kt * 4 + d0) * 64 + lane) * 16);
                acc = __builtin_amdgcn_mfma_f32_32x32x16_f16(kf, qf[d0], acc, 0, 0, 0); }
            p[t] = acc; }
        float mx = -INFINITY;
        int qlv = ql; asm volatile("" : "+v"(qlv));
#pragma unroll
        for (int t = 0; t < 5; ++t) { const bool tile_off = (blk == 0) && (w + t < 4);
#pragma unroll
            for (int r = 0; r < 16; ++r) { bool ok = !tile_off; if (t == 0) ok = ok && (crow(r, hi) > qlv); if (t == 4) ok = ok && (crow(r, hi) <= qlv);
                const float v = ok ? p[t][r] : -INFINITY; p[t][r] = v; mx = fmaxf(mx, v); } }
        mx = fmaxf(mx, __shfl_xor(mx, 32));
        const float sink2 = P.sinks[layer * NQH + hq] * LOG2E;
        mx = fmaxf(mx, sink2);
#pragma unroll
        for (int t = 0; t < 5; ++t) { const f32x16 dv = p[t] - mx;
#pragma unroll
            for (int r = 0; r < 16; ++r) p[t][r] = __builtin_amdgcn_exp2f(dv[r]); }
        float l = 0.f;
        f32x16 o[2] = {};
#pragma unroll
        for (int t = 0; t < 5; ++t) { const int kt = w + t;
#pragma unroll
            for (int s2 = 0; s2 < 2; ++s2) { const f16x8 pa = pack8(p[t], s2); l = sum8_f16(pa, l);
#pragma unroll
                for (int db = 0; db < 2; ++db) { const f16x8 vf = *(const LAS f16x8*)(lds + ATT_VF + (((kt * 2 + db) * 2 + s2) * 64 + lane) * 16);
                    o[db] = __builtin_amdgcn_mfma_f32_32x32x16_f16(vf, pa, o[db], 0, 0, 0); } } }
        l += __shfl_xor(l, 32); l += __builtin_amdgcn_exp2f(sink2 - mx);
        const float linv = __builtin_amdgcn_rcpf(l);
        { LAS unsigned char* st = lds + ATT_ST + wave * 4608;
          stage_ot(st, 144, 0, o[0], linv, ql, hi); stage_ot(st, 144, 32, o[1], linv, ql, hi);
#pragma unroll
          for (int i = 0; i < 4; ++i) { const v4u ov = *(const LAS v4u*)(st + erow * 144 + ehs * 64 + 16 * i);
              *(v4u*)(MIX + etok * MIX_W + ecol + 8 * i) = pk_mul8(ov, gv[i]); } }
    }
    __syncthreads();
}
__device__ __forceinline__ void phase_attn_a(const Params& P, int layer, LAS unsigned char* lds, int vcu, int G, int bx, bool defer) {
    if (defer) {
        if (bx < 128) attn_a_item(P, layer, lds, bx);
        else for (int j = 0; j < 3; ++j) attn_a_item(P, layer, lds, 128 + 3 * (bx - 128) + j);
        return; }
    for (int it = vcu; it < BATCH * 32 * NKVH; it += G) attn_a_item(P, layer, lds, it);
}

__device__ __forceinline__ void attn_c_item(const Params& P, int layer, LAS unsigned char* lds, int item) {
    const int tid = opaque_tid(), lane = tid & 63, wave = __builtin_amdgcn_readfirstlane(tid >> 6);
    const int sblk = item & 7, h = (item >> 3) & 3, b = item >> 5;
    const bf16_t* Z = (const bf16_t*)(P.ws + WS_Z); bf16_t* MIX = (bf16_t*)(P.ws + WS_MIX);
    const f16x8* KFg = (const f16x8*)(P.ws + WS_MK) + (size_t)((layer * BATCH + b) * XH + h) * (8 * 8 * 64);
    const f16x8* VFg = (const f16x8*)(P.ws + WS_MV) + (size_t)((layer * BATCH + b) * XH + h) * (8 * 4 * 2 * 64);
    const float* xqg = P.xq_norm_g + layer * XHD;
#pragma unroll
    for (int i = 0; i < 16; ++i) { const int f = wave * 16 + i; const f16x8* src = (f < 64 ? KFg + f * 64 : VFg + (f - 64) * 64) + lane;
        __builtin_amdgcn_global_load_lds((const unsigned*)src, (LAS unsigned*)(lds + f * 1024), 16, 0, 0); }
    asm volatile("s_waitcnt vmcnt(0)" ::: "memory");
    __syncthreads();
    const int ql = lane & 31, hi = lane >> 5;
    for (int ui = 0; ui < 2; ++ui) {
        const int qbase = b * SEQ + sblk * 512 + (wave * 2 + ui) * 32;
        const bf16_t* zq = Z + (size_t)(qbase + ql) * IN_W + ZXQ + h * XHD;
        f16x8 qf[8]; float ss = 0.f;
#pragma unroll
        for (int d0 = 0; d0 < 8; ++d0) { qf[d0] = *(const f16x8*)(zq + 16 * d0 + 8 * hi);
#pragma unroll
            for (int k2 = 0; k2 < 4; ++k2) { const h2_t v = {qf[d0][2 * k2], qf[d0][2 * k2 + 1]}; ss = __builtin_amdgcn_fdot2(v, v, ss, false); } }
        ss += __shfl_xor(ss, 32);
        const _Float16 rsh = (_Float16)(rsqrtf(ss * (1.f / XHD) + EPS) * (0.08838834764831845f * LOG2E));
#pragma unroll
        for (int d0 = 0; d0 < 8; ++d0) qf[d0] = qf[d0] * rsh;
        f16x8 pa[2][4][2]; float mh[2], lh[2];
#pragma unroll
        for (int hf2 = 0; hf2 < 2; ++hf2) {
            f32x16 p[4];
#pragma unroll
            for (int t = 0; t < 4; ++t) { const int kt = 4 * hf2 + t; f32x16 acc = {};
#pragma unroll
                for (int d0 = 0; d0 < 8; ++d0) acc = __builtin_amdgcn_mfma_f32_32x32x16_f16(*(const LAS f16x8*)(lds + ((kt * 8 + d0) * 64 + lane) * 16), qf[d0], acc, 0, 0, 0);
                p[t] = acc; asm volatile("" ::: "memory"); }
            float mx = -INFINITY;
#pragma unroll
            for (int t = 0; t < 4; ++t)
#pragma unroll
                for (int r = 0; r < 16; ++r) mx = fmaxf(mx, p[t][r]);
            mx = fmaxf(mx, __shfl_xor(mx, 32));
            float l = 0.f;
#pragma unroll
            for (int t = 0; t < 4; ++t) { const f32x16 dv = p[t] - mx;
#pragma unroll
                for (int r = 0; r < 16; ++r) p[t][r] = __builtin_amdgcn_exp2f(dv[r]);
                pa[hf2][t][0] = pack8(p[t], 0); pa[hf2][t][1] = pack8(p[t], 1); l = sum8_f16(pa[hf2][t][0], l); l = sum8_f16(pa[hf2][t][1], l); }
            l += __shfl_xor(l, 32);
            mh[hf2] = mx; lh[hf2] = l;
        }
        const float mm = fmaxf(mh[0], mh[1]); const float e0 = __builtin_amdgcn_exp2f(mh[0] - mm), e1 = __builtin_amdgcn_exp2f(mh[1] - mm);
        const float linv = __builtin_amdgcn_rcpf(lh[0] * e0 + lh[1] * e1); const float f0 = e0 * linv, f1 = e1 * linv;
#pragma unroll
        for (int db = 0; db < 4; ++db) { f32x16 o0 = {}, o1 = {};
#pragma unroll
            for (int t = 0; t < 4; ++t) {
#pragma unroll
                for (int s2 = 0; s2 < 2; ++s2) { o0 = __builtin_amdgcn_mfma_f32_32x32x16_f16(*(const LAS f16x8*)(lds + 65536 + (((t * 4 + db) * 2 + s2) * 64 + lane) * 16), pa[0][t][s2], o0, 0, 0, 0);
                    o1 = __builtin_amdgcn_mfma_f32_32x32x16_f16(*(const LAS f16x8*)(lds + 65536 + ((((4 + t) * 4 + db) * 2 + s2) * 64 + lane) * 16), pa[1][t][s2], o1, 0, 0, 0); }
                asm volatile("" ::: "memory"); }
            { LAS unsigned char* st = lds + 131072 + wave * 2560; const int erow = lane >> 1, ehs = lane & 1;
              const size_t tok = (size_t)qbase + erow; const int col = h * XHD + 32 * db + 16 * ehs;
              const v4u ga = *(const v4u*)(Z + tok * IN_W + ZXG + col), gb = *(const v4u*)(Z + tok * IN_W + ZXG + col + 8);
              stage_ot2(st, 80, 0, o0, f0, o1, f1, ql, hi);
              const v4u a0 = *(const LAS v4u*)(st + erow * 80 + ehs * 32), a1 = *(const LAS v4u*)(st + erow * 80 + ehs * 32 + 16);
              *(v4u*)(MIX + tok * MIX_W + 1024 + col) = pk_mul8(a0, ga); *(v4u*)(MIX + tok * MIX_W + 1024 + col + 8) = pk_mul8(a1, gb); }
            asm volatile("" ::: "memory"); }
    }
    __syncthreads();
}
__device__ __forceinline__ void phase_attn_c(const Params& P, int layer, LAS unsigned char* lds, int vcu, int G) {
    for (int it = vcu; it < BATCH * XH * 8; it += G) attn_c_item(P, layer, lds, it);
}
__device__ __forceinline__ void phase_memfin(const Params& P, int vcu, int G) {
    const int tid = opaque_tid(), lane = tid & 63, wave = __builtin_amdgcn_readfirstlane(tid >> 6);
    const float* mkv = (const float*)(P.ws + WS_Y2);
    for (int it = vcu * NWAVES + wave; it < DEPTH * BATCH * N_MEM; it += G * NWAVES) {
        const int l = it / (BATCH * N_MEM), row = it % (BATCH * N_MEM), b = row / N_MEM, key = row % N_MEM;
        const float* r = mkv + (size_t)row * (DEPTH * 1024) + l * 1024; const float* xkg = P.xk_norm_g + l * XHD; const float* xqg = P.xq_norm_g + l * XHD;
        const int kt = key >> 5, kl = key & 31, sK = kl >> 4, h2 = ((kl & 15) >> 2) & 1, jj = 4 * ((kl & 15) >> 3) + (kl & 3);
        for (int h = 0; h < XH; ++h) {
            bf16_t* KF = (bf16_t*)(P.ws + WS_MK) + (size_t)((l * BATCH + b) * XH + h) * (8 * 8 * 64 * 8);
            bf16_t* VF = (bf16_t*)(P.ws + WS_MV) + (size_t)((l * BATCH + b) * XH + h) * (8 * 4 * 2 * 64 * 8);
            float v[2]; v[0] = r[h * XHD + lane]; v[1] = r[h * XHD + 64 + lane];
            const float s = wave_sum(v[0] * v[0] + v[1] * v[1]); const float rs = rsqrtf(s * (1.f / XHD) + EPS);
#pragma unroll
            for (int e = 0; e < 2; ++e) { const int d = lane + 64 * e;
                KF[(size_t)((kt * 8 + (d >> 4)) * 64 + kl + 32 * ((d >> 3) & 1)) * 8 + (d & 7)] = f2bf(v[e] * rs * xkg[d] * xqg[d]);
                VF[(size_t)(((kt * 4 + (d >> 5)) * 2 + sK) * 64 + (d & 31) + 32 * h2) * 8 + jj] = f2bf(r[512 + h * XHD + d]); }
        }
    }
}


constexpr size_t SSMC_WE = 0, SSMC_WC = 64 * 1024, SSMC_KJ = 128 * 1024, SSMC_STRIDE = 144 * 1024;
constexpr size_t WS_A16 = WS_MISC + 128 * 1024;
__device__ __forceinline__ void ssm_consts_item(const Params& P, LAS unsigned char* lds, int item) {
    const int tid = opaque_tid(); const int l = item / SSM_G, g = item % SSM_G;
    LAS float* apw = (LAS float*)lds;
    LAS float* bbar = apw + 17 * 64 * 2;
    LAS float* kj = bbar + 64 * 16 * 2;
    LAS float* cre = kj + 16 * 256; LAS float* cim = cre + 16 * 64;
    { const float* c_re_g = P.c_re + (size_t)(l * SSM_G + g) * SSM_CH * SSM_P; const float* c_im_g = P.c_im + (size_t)(l * SSM_G + g) * SSM_CH * SSM_P;
      for (int i = tid; i < 16 * 64; i += NTHREADS) { cre[i] = c_re_g[i]; cim[i] = c_im_g[i]; } }
    const LAS float* c_re = cre; const LAS float* c_im = cim;
    const double dt = exp((double)P.log_dt[l * SSM_G + g]);
    for (int i = tid; i < 17 * 64; i += NTHREADS) { const int j = i / 64, p = i % 64; const int gp = (l * SSM_G + g) * SSM_P + p;
        const double lr = P.lam_re[gp], li = P.lam_im[gp]; const double mag = exp(lr * dt * j); double sn, cs; sincos(li * dt * j, &sn, &cs);
        apw[i * 2] = (float)(mag * cs); apw[i * 2 + 1] = (float)(mag * sn); }
    for (int i = tid; i < 64 * 16; i += NTHREADS) { const int p = i / 16, c = i % 16; const int gp = (l * SSM_G + g) * SSM_P + p;
        const double lr = P.lam_re[gp], li = P.lam_im[gp]; const double mag = exp(lr * dt), ar = mag * cos(li * dt), ai = mag * sin(li * dt), den = lr * lr + li * li;
        const double fr = ((ar - 1.0) * lr + ai * li) / den, fi = (ai * lr - (ar - 1.0) * li) / den;
        const double br = P.b_re[(size_t)gp * SSM_CH + c], bi = P.b_im[(size_t)gp * SSM_CH + c];
        bbar[i * 2] = (float)(fr * br - fi * bi); bbar[i * 2 + 1] = (float)(fr * bi + fi * br); }
    __syncthreads();
    for (int i = tid; i < 16 * 256; i += NTHREADS) { const int j = i >> 8, co = (i >> 4) & 15, ci = i & 15; float acc = 0.f;
        for (int p = 0; p < 64; ++p) { const float er = apw[(j * 64 + p) * 2], ei = apw[(j * 64 + p) * 2 + 1], br = bbar[(p * 16 + ci) * 2], bi = bbar[(p * 16 + ci) * 2 + 1];
            const float wr = er * br - ei * bi, wi = er * bi + ei * br; acc += c_re[co * SSM_P + p] * wr - c_im[co * SSM_P + p] * wi; }
        if (j == 0 && co == ci) acc += P.d_skip[l * SSM_W + g * SSM_CH + co];
        kj[i] = acc; }
    __syncthreads();
    unsigned char* base = P.ws + WS_SSMP + (size_t)item * SSMC_STRIDE;
    bf16_t* WE = (bf16_t*)(base + SSMC_WE); bf16_t* WC = (bf16_t*)(base + SSMC_WC); bf16_t* KJ = (bf16_t*)(base + SSMC_KJ);
    for (int i = tid; i < 64 * 512; i += NTHREADS) { const int f = i >> 9, e = i & 511, ln = e >> 3, j = e & 7, mt = f >> 4, sx = f & 15, r = ln & 31, hh = ln >> 5;
        const int R = 32 * mt + r, p = R >> 1, ri = R & 1, ci = 8 * hh + j; const float er = apw[((15 - sx) * 64 + p) * 2], ei = apw[((15 - sx) * 64 + p) * 2 + 1], br = bbar[(p * 16 + ci) * 2], bi = bbar[(p * 16 + ci) * 2 + 1];
        WE[i] = f2bf(ri ? (er * bi + ei * br) : (er * br - ei * bi)); }
    for (int i = tid; i < 9216 / 2; i += NTHREADS) KJ[i] = (i < 16 * 256) ? f2bf(kj[i]) : (bf16_t)0;
    for (int i = tid; i < 64 * 512; i += NTHREADS) { const int f = i >> 9, e = i & 511, ln = e >> 3, j = e & 7, mt = f >> 3, kc = f & 7, r = ln & 31, hh = ln >> 5;
        const int t = 2 * mt + (r >> 4), co = r & 15, p = 8 * kc + 4 * hh + (j >> 1), ri = j & 1; const float er = apw[((t + 1) * 64 + p) * 2], ei = apw[((t + 1) * 64 + p) * 2 + 1];
        const float cr = c_re[co * SSM_P + p], cim = c_im[co * SSM_P + p]; WC[i] = f2bf(ri ? -(cr * ei + cim * er) : (cr * er - cim * ei)); }
    if (tid < 64) { float* a16 = (float*)(P.ws + WS_A16) + (size_t)(item * 64 + tid) * 4; a16[0] = apw[(16 * 64 + tid) * 2]; a16[1] = apw[(16 * 64 + tid) * 2 + 1];
        const int gp = (l * SSM_G + g) * SSM_P + tid; const double lr = P.lam_re[gp], li = P.lam_im[gp]; const double mag = exp(lr * dt * 512.0); double sn, cs; sincos(li * dt * 512.0, &sn, &cs);
        a16[2] = (float)(mag * cs); a16[3] = (float)(mag * sn); }
    __syncthreads();
}
__device__ __forceinline__ void phase_ssm_consts(const Params& P, LAS unsigned char* lds, int vcu, int G) {
    for (int it = vcu; it < DEPTH * SSM_G; it += G) ssm_consts_item(P, lds, it);
}
__device__ __forceinline__ float gelu_tanh_fast(float x) {
    const float u = 0.7978845608028654f * (x + 0.044715f * x * x * x); return x * __builtin_amdgcn_rcpf(1.f + __expf(-2.f * u)); }

constexpr int SSM_EH = 0, SSM_EHP = 272, SSM_WX = 69632, SSM_KJ = SSM_WX + 65536, SSM_CHS = SSM_KJ + 9216;
static_assert(SSM_CHS + 4096 <= LDSCTL_OFF, "ssm lds map");
__device__ __forceinline__ void ssm_item(const Params& P, int layer, LAS unsigned char* lds, int item) {
    const int tid = opaque_tid(), lane = tid & 63, wave = __builtin_amdgcn_readfirstlane(tid >> 6);
    const int g = item >> 3, b = item & 7;
    const bf16_t* Z = (const bf16_t*)(P.ws + WS_Z); bf16_t* Y2 = (bf16_t*)(P.ws + WS_Y2);
    const unsigned char* cbase = P.ws + WS_SSMP + (size_t)(layer * SSM_G + g) * SSMC_STRIDE;
    const int nl = lane & 31, hh = lane >> 5;
    typedef float f32x2v __attribute__((ext_vector_type(2)));
#pragma unroll
    for (int i = 0; i < 8; ++i) { const int f = wave * 8 + i;
        __builtin_amdgcn_global_load_lds((const unsigned*)(cbase + SSMC_WE + f * 1024 + lane * 16), (LAS unsigned*)(lds + SSM_WX + f * 1024), 16, 0, 0); }
    __builtin_amdgcn_global_load_lds((const unsigned*)(cbase + SSMC_KJ + wave * 1024 + lane * 16), (LAS unsigned*)(lds + SSM_KJ + wave * 1024), 16, 0, 0);
    if (wave == 0) __builtin_amdgcn_global_load_lds((const unsigned*)(cbase + SSMC_KJ + 8192 + lane * 16), (LAS unsigned*)(lds + SSM_KJ + 8192), 16, 0, 0);
    const int n = 32 * wave + nl;
    const bf16_t* up = Z + (size_t)(b * SEQ + 16 * n) * IN_W + ZU + g * SSM_CH + 8 * hh;
    f16x8 uf[16];
#pragma unroll
    for (int sx = 0; sx < 16; ++sx) uf[sx] = *(const f16x8*)(up + (size_t)sx * IN_W);
    const float* a16p = (const float*)(P.ws + WS_A16) + (size_t)((layer * SSM_G + g) * 64 + lane) * 4;
    const float a16r = a16p[0], a16i = a16p[1], a5r = a16p[2], a5i = a16p[3];
    asm volatile("s_waitcnt vmcnt(0)" ::: "memory");
    __syncthreads();
    {
        f32x16 ae[4] = {};
#pragma unroll
        for (int sx = 0; sx < 16; ++sx) {
#pragma unroll
            for (int mt = 0; mt < 4; ++mt) ae[mt] = __builtin_amdgcn_mfma_f32_32x32x16_f16(*(const LAS f16x8*)(lds + SSM_WX + ((mt * 16 + sx) * 64 + lane) * 16), uf[sx], ae[mt], 0, 0, 0);
            if ((sx & 1) == 1) asm volatile("" ::: "memory"); }
#pragma unroll
        for (int mt = 0; mt < 4; ++mt)
#pragma unroll
            for (int r = 0; r < 16; r += 2) { const int p = 16 * mt + (crow(r, hh) >> 1);
                *(LAS unsigned*)(lds + SSM_EH + n * SSM_EHP + 4 * p) = pg8::pk_f16(ae[mt][r], ae[mt][r + 1]); }
    }
    __syncthreads();
#pragma unroll
    for (int i = 0; i < 8; ++i) { const int f = wave * 8 + i;
        __builtin_amdgcn_global_load_lds((const unsigned*)(cbase + SSMC_WC + f * 1024 + lane * 16), (LAS unsigned*)(lds + SSM_WX + f * 1024), 16, 0, 0); }
    {
        LAS unsigned char* eh = lds + SSM_EH + (32 * wave) * SSM_EHP + 4 * lane;
        float sr = 0.f, si = 0.f;
#pragma unroll 8
        for (int k = 0; k < 32; ++k) { const unsigned ev = *(const LAS unsigned*)(eh + k * SSM_EHP); const float er = pg8::h_lo(ev), ei = pg8::h_hi(ev);
            const float nr = a16r * sr - a16i * si + er, ni = a16r * si + a16i * sr + ei; sr = nr; si = ni; }
        LAS f32x2v* chs = (LAS f32x2v*)(lds + SSM_CHS);
        chs[wave * 64 + lane] = (f32x2v){sr, si};
        __syncthreads();
        float cr = 0.f, ci = 0.f;
        for (int v = 0; v < wave; ++v) { const f32x2v sv = chs[v * 64 + lane]; const float nr = a5r * cr - a5i * ci + sv.x, ni = a5r * ci + a5i * cr + sv.y; cr = nr; ci = ni; }
        sr = cr; si = ci;
#pragma unroll 8
        for (int k = 0; k < 32; ++k) { const unsigned ev = *(const LAS unsigned*)(eh + k * SSM_EHP); const float er = pg8::h_lo(ev), ei = pg8::h_hi(ev);
            *(LAS unsigned*)(eh + k * SSM_EHP) = pg8::pk_f16(sr, si);
            const float nr = a16r * sr - a16i * si + er, ni = a16r * si + a16i * sr + ei; sr = nr; si = ni; }
    }
    asm volatile("s_waitcnt vmcnt(0)" ::: "memory");
    __syncthreads();
    const int rhi = nl >> 4, co = nl & 15;
    const LAS unsigned char* kjl = lds + SSM_KJ + co * 32 + hh * 16;
#pragma unroll
    for (int mh = 0; mh < 2; ++mh) {
        f32x16 ay[4] = {};
#pragma unroll
        for (int sx = 0; sx < 16; ++sx) {
#pragma unroll
            for (int i = 0; i < 4; ++i) { const int mt = 4 * mh + i; const int lag0 = 2 * mt - sx;
                if (lag0 + 1 >= 0) { const int lag = lag0 + rhi; const int row = (lag0 >= 0) ? lag : (rhi ? 0 : 16);
                    ay[i] = __builtin_amdgcn_mfma_f32_32x32x16_f16(*(const LAS f16x8*)(kjl + row * 512), uf[sx], ay[i], 0, 0, 0); } }
            if ((sx & 1) == 1) asm volatile("" ::: "memory"); }
#pragma unroll
        for (int kc = 0; kc < 8; ++kc) { const f16x8 hfr = *(const LAS f16x8*)(lds + SSM_EH + n * SSM_EHP + 32 * kc + 16 * hh);
#pragma unroll
            for (int i = 0; i < 4; ++i) { const int mt = 4 * mh + i;
                ay[i] = __builtin_amdgcn_mfma_f32_32x32x16_f16(*(const LAS f16x8*)(lds + SSM_WX + ((mt * 8 + kc) * 64 + lane) * 16), hfr, ay[i], 0, 0, 0); }
            if ((kc & 1) == 1) asm volatile("" ::: "memory"); }
#pragma unroll
        for (int i = 0; i < 4; ++i) { const int mt = 4 * mh + i;
#pragma unroll
            for (int q = 0; q < 4; ++q) { const int t = 2 * mt + (q >> 1), co0 = 8 * (q & 1) + 4 * hh;
                pg8::u32x2 w; w.x = pg8::pk_f16(gelu_tanh_fast(ay[i][4 * q]), gelu_tanh_fast(ay[i][4 * q + 1])); w.y = pg8::pk_f16(gelu_tanh_fast(ay[i][4 * q + 2]), gelu_tanh_fast(ay[i][4 * q + 3]));
                *(pg8::u32x2*)(Y2 + (size_t)(b * SEQ + 16 * n + t) * SSM_W + g * SSM_CH + co0) = w; } }
    }
    __syncthreads();
}
__device__ __forceinline__ void phase_ssm(const Params& P, int layer, LAS unsigned char* lds, int vcu, int G) {
    for (int it = vcu; it < SSM_G * BATCH; it += G) ssm_item(P, layer, lds, it);
}


#define XB_TMO      128
#define XB_XCNT(j)  (256  + 64 * (j))
#define XB_XSUB(j)  (1280 + 64 * (j))
#define XB_XGEN(j)  (2304 + 64 * (j))
#define XB_TOP      3328
#define XB_TOPGEN   3392
#define XCD_BAR_WORDS 3456
#define XB_SPIN_CAP (1u << 18)
__device__ __forceinline__ unsigned xb_ld(unsigned* p)              { return __hip_atomic_load(p, __ATOMIC_RELAXED, __HIP_MEMORY_SCOPE_AGENT); }
__device__ __forceinline__ unsigned xb_add(unsigned* p, unsigned v) { return __hip_atomic_fetch_add(p, v, __ATOMIC_RELAXED, __HIP_MEMORY_SCOPE_AGENT); }
__device__ __forceinline__ unsigned xb_xcc_id() { return (unsigned)__builtin_amdgcn_s_getreg((3 << 11) | 20) & 0xFu; }
#define XB_SPIN(cond, bar) do { unsigned _sp = 0; while (cond) { __builtin_amdgcn_s_sleep(1); \
    if ((++_sp & 255u) == 0u) { if (xb_ld(&(bar)[XB_TMO])) break; if (_sp > XB_SPIN_CAP) { atomicAdd(&(bar)[XB_TMO], 1u); break; } } } } while (0)
struct XcdBarrier { unsigned* bar; unsigned x; volatile LAS unsigned* st; };
__device__ __forceinline__ XcdBarrier xcd_barrier_post(unsigned* bar, volatile LAS unsigned* st) {
    XcdBarrier b; b.bar = bar; b.x = xb_xcc_id(); b.st = st;
    if (threadIdx.x == 0) (void)xb_add(&bar[XB_XCNT(b.x)], 1u);
    return b;
}
__device__ __forceinline__ void xcd_barrier_complete(unsigned* bar, unsigned x, unsigned& nloc, unsigned& nx) {
    const unsigned G = gridDim.x * gridDim.y * gridDim.z;
    unsigned sum, cnt, mine, sp = 0u;
    for (;;) {
        sum = 0u; cnt = 0u; mine = 0u;
#pragma unroll
        for (unsigned j = 0; j < 16; ++j) { const unsigned c = xb_ld(&bar[XB_XCNT(j)]); sum += c; cnt += (c > 0u) ? 1u : 0u; mine = (j == x) ? c : mine; }
        if (sum == G) break;
        __builtin_amdgcn_s_sleep(1);
        if ((++sp & 255u) == 0u) { if (xb_ld(&bar[XB_TMO])) break; if (sp > XB_SPIN_CAP) { atomicAdd(&bar[XB_TMO], 1u); break; } }
    }
    nloc = mine > 0u ? mine : 1u; nx = cnt > 0u ? cnt : 1u;
}
__device__ __forceinline__ void xcd_barrier(const XcdBarrier& b) {
    asm volatile("s_waitcnt vmcnt(0)" ::: "memory");
    __syncthreads();
    if (threadIdx.x == 0) {
        unsigned* bar = b.bar;
        __builtin_amdgcn_s_waitcnt(0);
        unsigned nloc = b.st[0], nx = b.st[1];
        if (nloc == 0u) { xcd_barrier_complete(bar, b.x, nloc, nx); b.st[0] = nloc; b.st[1] = nx; }
        const unsigned old = xb_add(&bar[XB_XSUB(b.x)], 1u);
        const unsigned gen = old / nloc;
        if (old + 1u == (gen + 1u) * nloc) {
            __builtin_amdgcn_fence(__ATOMIC_RELEASE, "agent");
            asm volatile("s_waitcnt vmcnt(0)" ::: "memory");
            const unsigned og = xb_add(&bar[XB_TOP], 1u);
            const unsigned tg = og / nx;
            if (og + 1u == (tg + 1u) * nx) xb_add(&bar[XB_TOPGEN], 1u);
            else XB_SPIN(xb_ld(&bar[XB_TOPGEN]) == tg, bar);
            __builtin_amdgcn_fence(__ATOMIC_ACQUIRE, "agent");
            xb_add(&bar[XB_XGEN(b.x)], 1u);
            asm volatile("s_waitcnt vmcnt(0)" ::: "memory");
        } else {
            XB_SPIN(xb_ld(&bar[XB_XGEN(b.x)]) == gen, bar);
            __builtin_amdgcn_fence(__ATOMIC_ACQUIRE, "agent");
            asm volatile("s_waitcnt vmcnt(0)" ::: "memory");
        }
    }
    __syncthreads();
}
constexpr size_t WS_CTL = WS_MISC + 512 * 1024;
constexpr int CTL_BYTES = 16384;

constexpr int DEFER_TILE = 8;
__device__ __forceinline__ bool defer_mode(int layer, int G) { return layer > 0 && G == 256; }
__device__ __forceinline__ void run_inproj(const Params& P, int layer, LAS unsigned char* lds, int G, int bx) {
    unsigned char* ws = P.ws;
    pg8::Gemm g{(const bf16_t*)(ws + WS_XB), (const bf16_t*)(ws + WS_WIN) + (size_t)layer * IN_W * D_MODEL, MTOK, IN_W, D_MODEL};
    pg8::EpiZ E{(bf16_t*)(ws + WS_Z), (const float*)(ws + WS_SUMSQ), (const bf16_t*)(ws + WS_ROPE), P.q_norm_g + layer * HD, P.k_norm_g + layer * HD};
    if (defer_mode(layer, G)) { pg8::SkipOrder S; S.init2(g.M, g.N, G, bx, DEFER_TILE); pg8::gemm_phase<pg8::EpiZ, pg8::SkipOrder, true>(lds, g, S, E); }
    else { pg8::StaticOrder S; S.init(g.M, g.N, G, bx); pg8::gemm_phase<pg8::EpiZ, pg8::StaticOrder, true>(lds, g, S, E); }
}
__device__ __forceinline__ void run_inproj_tail(const Params& P, int layer, LAS unsigned char* lds, int G, int bx) {
    if (!defer_mode(layer, G)) return;
    unsigned char* ws = P.ws;
    pg8::Gemm g{(const bf16_t*)(ws + WS_XB), (const bf16_t*)(ws + WS_WIN) + (size_t)layer * IN_W * D_MODEL, MTOK, IN_W, D_MODEL};
    pg8::EpiZ E{(bf16_t*)(ws + WS_Z), (const float*)(ws + WS_SUMSQ), (const bf16_t*)(ws + WS_ROPE), P.q_norm_g + layer * HD, P.k_norm_g + layer * HD};
    pg8::DeferOrder S; S.init(g.M, G, bx, DEFER_TILE); pg8::gemm_phase<pg8::EpiZ, pg8::DeferOrder, true>(lds, g, S, E);
}
__device__ __forceinline__ void run_glu(const Params& P, int layer, LAS unsigned char* lds, int G, int bx) {
    unsigned char* ws = P.ws;
    pg8::Gemm g{(const bf16_t*)(ws + WS_Y2), (const bf16_t*)(ws + WS_WGLU) + (size_t)layer * SSM_W * SSM_W, MTOK, SSM_W, SSM_W}; pg8::StaticOrder S; S.init(g.M, g.N, G, bx);
    pg8::EpiGlu E{(const bf16_t*)(ws + WS_Y2), (const bf16_t*)(ws + WS_Z), P.b_glu + layer * SSM_W, (bf16_t*)(ws + WS_MIX)};
    pg8::gemm_phase<pg8::EpiGlu, pg8::StaticOrder, true>(lds, g, S, E);
}
__device__ __forceinline__ void run_outproj(const Params& P, int layer, LAS unsigned char* lds, int G, int bx) {
    unsigned char* ws = P.ws;
    pg8::Gemm g{(const bf16_t*)(ws + WS_MIX), (const bf16_t*)(ws + WS_WOUT) + (size_t)layer * D_MODEL * MIX_W, MTOK, D_MODEL, MIX_W}; pg8::StaticOrder S; S.init(g.M, g.N, G, bx);
    if (layer == 0) { pg8::EpiOut<0> E{P.x, P.out, (bf16_t*)(ws + WS_XB), (float*)(ws + WS_SUMSQ)}; pg8::gemm_phase<pg8::EpiOut<0>, pg8::StaticOrder, true>(lds, g, S, E); }
    else if (layer + 1 < DEPTH) { pg8::EpiOut<1> E{P.x, P.out, (bf16_t*)(ws + WS_XB), (float*)(ws + WS_SUMSQ)}; pg8::gemm_phase<pg8::EpiOut<1>, pg8::StaticOrder, true>(lds, g, S, E); }
    else { pg8::EpiOut<2> E{P.x, P.out, (bf16_t*)(ws + WS_XB), (float*)(ws + WS_SUMSQ)}; pg8::gemm_phase<pg8::EpiOut<2>, pg8::StaticOrder, true>(lds, g, S, E); }
}
__device__ __forceinline__ void run_memgemm(const Params& P, LAS unsigned char* lds, int G, int bx) {
    unsigned char* ws = P.ws;
    pg8::Gemm g{(const bf16_t*)(ws + WS_MEMB), (const bf16_t*)(ws + WS_WMEM), BATCH * N_MEM, DEPTH * 1024, D_MODEL}; pg8::MemTailOrder S; S.init(g.M, g.N, G, bx, ((MTOK / 256) * (IN_W / 256)) % G);
    pg8::EpiMemF32 E{(float*)(ws + WS_Y2), DEPTH * 1024, (const float*)(ws + WS_MISC)};
    pg8::gemm_phase<pg8::EpiMemF32, pg8::MemTailOrder, true>(lds, g, S, E);
}


template <class T> __device__ __forceinline__ T* as_global(unsigned long long v) { return (T*)(__attribute__((address_space(1))) T*)v; }
__device__ __forceinline__ Params load_params() {
    typedef const volatile unsigned long long __attribute__((address_space(4)))* kp_t;
    kp_t kp = (kp_t)__builtin_amdgcn_kernarg_segment_ptr();
    Params q;
    q.x = as_global<const float>(kp[0]); q.mem = as_global<const float>(kp[1]); q.pos = as_global<const int>(kp[2]); q.norm_g = as_global<const float>(kp[3]);
    q.w_in = as_global<const float>(kp[4]); q.q_norm_g = as_global<const float>(kp[5]); q.k_norm_g = as_global<const float>(kp[6]); q.sinks = as_global<const float>(kp[7]);
    q.lam_re = as_global<const float>(kp[8]); q.lam_im = as_global<const float>(kp[9]); q.log_dt = as_global<const float>(kp[10]); q.b_re = as_global<const float>(kp[11]);
    q.b_im = as_global<const float>(kp[12]); q.c_re = as_global<const float>(kp[13]); q.c_im = as_global<const float>(kp[14]); q.d_skip = as_global<const float>(kp[15]);
    q.w_glu = as_global<const float>(kp[16]); q.b_glu = as_global<const float>(kp[17]); q.mem_norm_g = as_global<const float>(kp[18]); q.w_mem_kv = as_global<const float>(kp[19]);
    q.xq_norm_g = as_global<const float>(kp[20]); q.xk_norm_g = as_global<const float>(kp[21]); q.w_out = as_global<const float>(kp[22]);
    q.out = as_global<float>(kp[23]); q.ws = as_global<unsigned char>(kp[24]);
    return q;
}
static_assert(sizeof(Params) == 25 * 8, "Params is 25 pointers");
__global__ void __launch_bounds__(NTHREADS, 2) k_mega(Params Parg) {
    extern __shared__ __attribute__((aligned(16))) unsigned char lds_raw[];
    LAS unsigned char* lds = (LAS unsigned char*)lds_raw;
    const int G = gridDim.x, bx = blockIdx.x; const int vcu = (G % 8 == 0) ? (bx % 8) * (G / 8) + bx / 8 : bx;
    for (int u = threadIdx.x; u < (LDS_BYTES - LDSCTL_OFF) / 4; u += NTHREADS) ((LAS unsigned*)(lds + LDSCTL_OFF))[u] = 0u;
    __syncthreads();
    (void)xcd_barrier_post((unsigned*)(Parg.ws + WS_CTL), (volatile LAS unsigned*)(lds + LDSCTL_OFF));
#define GRID_BARRIER() do { XcdBarrier bar_; { const Params Pb = load_params(); bar_.bar = (unsigned*)(Pb.ws + WS_CTL); } unsigned xq_ = xb_xcc_id(); asm volatile("" : "+s"(xq_)); bar_.x = xq_; bar_.st = (volatile LAS unsigned*)(lds + LDSCTL_OFF); xcd_barrier(bar_); } while (0)
    { const Params P = load_params(); phase_prep(P, lds, vcu, G); } __syncthreads();
    { const Params P = load_params(); phase_ssm_consts(P, lds, vcu, G); }
    GRID_BARRIER();
    { const Params P = load_params(); run_inproj(P, 0, lds, G, bx); }
    { const Params P = load_params(); run_memgemm(P, lds, G, bx); }
    GRID_BARRIER();
    { const Params P = load_params(); phase_memfin(P, vcu, G); }
    GRID_BARRIER();
#pragma unroll 1
    for (int layer = 0; layer < DEPTH; ++layer) {
        { const Params P = load_params(); run_inproj_tail(P, layer, lds, G, bx); }
        { const Params P = load_params(); phase_attn_a(P, layer, lds, vcu, G, bx, defer_mode(layer, G)); }
        { const Params P = load_params(); phase_attn_c(P, layer, lds, vcu, G); }
        { const Params P = load_params(); phase_ssm(P, layer, lds, vcu, G); }
        GRID_BARRIER();
        { const Params P = load_params(); run_glu(P, layer, lds, G, bx); }
        GRID_BARRIER();
        { const Params P = load_params(); run_outproj(P, layer, lds, G, bx); }
        if (layer + 1 < DEPTH) { GRID_BARRIER(); { const Params P = load_params(); run_inproj(P, layer + 1, lds, G, bx); } GRID_BARRIER(); }
    }
}

extern "C" void kernel_launch(void* const* d_in, const int* in_sizes, int n_in, void* d_out, int out_size, void* d_ws, size_t ws_size, hipStream_t stream) {
    if (ws_size < WS_END || n_in != 23) return;
    Params P{};
    P.x = (const float*)d_in[0]; P.mem = (const float*)d_in[1]; P.pos = (const int*)d_in[2]; P.norm_g = (const float*)d_in[3]; P.w_in = (const float*)d_in[4];
    P.q_norm_g = (const float*)d_in[5]; P.k_norm_g = (const float*)d_in[6]; P.sinks = (const float*)d_in[7]; P.lam_re = (const float*)d_in[8]; P.lam_im = (const float*)d_in[9];
    P.log_dt = (const float*)d_in[10]; P.b_re = (const float*)d_in[11]; P.b_im = (const float*)d_in[12]; P.c_re = (const float*)d_in[13]; P.c_im = (const float*)d_in[14];
    P.d_skip = (const float*)d_in[15]; P.w_glu = (const float*)d_in[16]; P.b_glu = (const float*)d_in[17]; P.mem_norm_g = (const float*)d_in[18]; P.w_mem_kv = (const float*)d_in[19];
    P.xq_norm_g = (const float*)d_in[20]; P.xk_norm_g = (const float*)d_in[21]; P.w_out = (const float*)d_in[22];
    P.out = (float*)d_out; P.ws = (unsigned char*)d_ws;
    static int coop_grid = 0;
    if (coop_grid == 0) {
        int dev = 0, cus = 0, per_cu = 0; hipGetDevice(&dev); hipDeviceGetAttribute(&cus, hipDeviceAttributeMultiprocessorCount, dev);
        (void)hipFuncSetAttribute((const void*)k_mega, hipFuncAttributeMaxDynamicSharedMemorySize, LDS_BYTES);
        if (hipOccupancyMaxActiveBlocksPerMultiprocessor(&per_cu, (const void*)k_mega, NTHREADS, LDS_BYTES) != hipSuccess || per_cu < 1) { fprintf(stderr, "kernel_launch: occupancy query says %d blocks/CU\n", per_cu); (void)hipGetLastError(); per_cu = 1; }
        if (per_cu > 1) per_cu = 1;
        coop_grid = (cus > 0 ? cus : 256) * per_cu;
    }
    (void)hipMemsetAsync((char*)d_ws + WS_CTL, 0, CTL_BYTES, stream);
    { void* args[] = {(void*)&P}; hipError_t e = hipLaunchCooperativeKernel((const void*)k_mega, dim3(coop_grid), dim3(NTHREADS), args, LDS_BYTES, stream);
      if (e != hipSuccess) fprintf(stderr, "cooperative launch failed: %s (grid %d)\n", hipGetErrorString(e), coop_grid); }
}
```

```cpp
#include <hip/hip_runtime.h>
#include <cstdio>
#include <stdint.h>
#include <math.h>

constexpr int D_MODEL = 1024, BATCH = 8, SEQ = 4096, DEPTH = 4, MTOK = BATCH * SEQ;
constexpr int HD = 64, NQH = 8, NKVH = 2, WINDOW = 128;
constexpr int SSM_CH = 16, SSM_G = 32, SSM_P = 64, SSM_W = 512, N_MEM = 256, XH = 4, XHD = 128;
constexpr int MIX_W = 1536, IN_W = 3328;
constexpr int ZQ = 0, ZK = 512, ZV = 640, ZG = 768, ZU = 1280, ZSG = 1792, ZXQ = 2304, ZXG = 2816;
constexpr float EPS = 1e-6f;

typedef unsigned short bf16_t;
__device__ __forceinline__ bf16_t f2bf(float f) { _Float16 h = (_Float16)f; return __builtin_bit_cast(unsigned short, h); }
__device__ __forceinline__ float bf2f(bf16_t h) { return (float)__builtin_bit_cast(_Float16, h); }
__device__ __forceinline__ float sigmoidf_(float x) { return __builtin_amdgcn_rcpf(1.f + __expf(-x)); }
__device__ __forceinline__ float siluf_(float x) { return x * sigmoidf_(x); }
__device__ __forceinline__ float gelu_tanh(float x) { const float c = 0.7978845608028654f; float u = c * (x + 0.044715f * x * x * x); return 0.5f * x * (1.f + tanhf(u)); }
__device__ __forceinline__ float wave_sum(float v) {
#pragma unroll
    for (int o = 1; o < 64; o <<= 1) v += __shfl_xor(v, o);
    return v;
}

constexpr size_t MiB = 1u << 20;
constexpr size_t WS_Z = 0;
constexpr size_t WS_MIX = 208 * MiB;
constexpr size_t WS_XB = 304 * MiB;
constexpr size_t WS_Y2 = 368 * MiB;
constexpr size_t WS_WIN = 400 * MiB;
constexpr size_t WS_WOUT = 426 * MiB;
constexpr size_t WS_WGLU = 438 * MiB;
constexpr size_t WS_WMEM = 440 * MiB;
constexpr size_t WS_MEMB = 448 * MiB;
constexpr size_t WS_MK = 452 * MiB;
constexpr size_t WS_MV = 460 * MiB;
constexpr size_t WS_ROPE = 468 * MiB;
constexpr size_t WS_SSMP = 476 * MiB;
constexpr size_t WS_SUMSQ = 508 * MiB;
constexpr size_t WS_MISC = 510 * MiB;
constexpr size_t WS_END = 511 * MiB;


namespace pg8 {
#define PG8_LAS __attribute__((address_space(3)))
typedef _Float16 f16x8 __attribute__((ext_vector_type(8)));
typedef _Float16 f16x2 __attribute__((ext_vector_type(2)));
typedef float f32x4 __attribute__((ext_vector_type(4)));
typedef unsigned u32x4 __attribute__((ext_vector_type(4)));
typedef unsigned u32x2 __attribute__((ext_vector_type(2)));
constexpr int BM = 256, BK = 64, HALF = 128, HTB = HALF * BK * 2, STAGE_BYTES = 8 * HTB, NXCD = 8, WGM = 8;
__host__ __device__ __forceinline__ int lds_byte(int r, int c) { const int st = (r >> 4) * 2 + (c >> 5), rr = r & 15, cc = c & 31, ob = rr * 64 + cc * 2; return st * 1024 + (ob ^ (((ob >> 9) & 1) << 5)); }
__host__ __device__ __forceinline__ void stage_rc(int b, int& R, int& C) { const int st = b / 1024, sb = b % 1024, swz = sb ^ (((sb >> 9) & 1) << 5); R = (st >> 1) * 16 + swz / 64; C = (st & 1) * 32 + (swz % 64) / 2; }
__host__ __device__ __forceinline__ int perm32(int rho) { const int n = rho >> 4, i = rho & 15; return 8 * (i >> 2) + 4 * n + (i & 3); }
struct Unit { int pm, pn, c0, half, idx; };
struct Gemm { const bf16_t* A; const bf16_t* Bt; int M, N, K; };
struct StaticOrder {
    int nM, nN, nwg, G, c;
    __host__ __device__ void init(int M, int N, int G_, int c_) { nM = M / BM; nN = N / BM; nwg = nM * nN; G = G_; c = c_; }
    __host__ __device__ bool next(int i, Unit& u) const {
        const long L = (long)i * G + c; if (L >= nwg) return false;
        int wgid = (int)L; { const int q = nwg / NXCD, r = nwg % NXCD, xcd = wgid % NXCD, off = wgid / NXCD; wgid = (xcd < r ? xcd * (q + 1) : r * (q + 1) + (xcd - r) * q) + off; }
        const int nig = WGM * nN, gid = wgid / nig, fm = gid * WGM, gsz = (nM - fm) < WGM ? (nM - fm) : WGM;
        u.pm = fm + ((wgid % nig) % gsz); u.pn = (wgid % nig) / gsz; u.c0 = u.pn * BM; u.half = 0; u.idx = i; return true;
    }
    __device__ __forceinline__ void a_ready(const Unit&) const {}
    __device__ __forceinline__ void done(const Unit&) const {}
};
struct TailOrder : StaticOrder {
    __host__ __device__ bool next(int i, Unit& u) const {
        const int full = nwg / G, left = nwg - full * G;
        if (i < full || 2 * left > G) return StaticOrder::next(i, u);
        if (i > full || c >= 2 * left) return false;
        StaticOrder t = *this; t.c = c >> 1;
        (void)t.StaticOrder::next(full, u);
        u.c0 += 128 * (c & 1); u.half = 1; u.idx = i; return true;
    }
};
struct SkipOrder : StaticOrder {
    int skip;
    __host__ __device__ void init2(int M, int N, int G_, int c_, int skip_) { init(M, N - BM, G_, c_); skip = skip_; }
    __host__ __device__ bool next(int i, Unit& u) const { if (!StaticOrder::next(i, u)) return false; if (u.pn >= skip) { u.pn += 1; u.c0 = u.pn * BM; } return true; }
};
struct DeferOrder {
    int nM, pn, G, c;
    __host__ __device__ void init(int M, int G_, int c_, int pn_) { nM = M / BM; G = G_; c = c_; pn = pn_; }
    __host__ __device__ bool next(int i, Unit& u) const { const int L = i * G + c; if (L >= nM) return false; u.pm = L; u.pn = pn; u.c0 = pn * BM; u.half = 0; u.idx = i; return true; }
    __device__ __forceinline__ void a_ready(const Unit&) const {}
    __device__ __forceinline__ void done(const Unit&) const {}
};
struct MemTailOrder {
    int k, stride, nM, nwg;
    __host__ __device__ void init(int M, int N, int G, int c, int first) { nM = M / BM; nwg = nM * (N / BM); k = c - first; stride = G - first; }
    __host__ __device__ bool next(int i, Unit& u) const {
        if (k < 0) return false;
        const int L = i * stride + k; if (L >= nwg) return false;
        u.pm = L % nM; u.pn = L / nM; u.c0 = u.pn * BM; u.half = 0; u.idx = i; return true;
    }
    __device__ __forceinline__ void a_ready(const Unit&) const {}
    __device__ __forceinline__ void done(const Unit&) const {}
};
__device__ __forceinline__ unsigned pk_f16(float lo, float hi) { f16x2 v = {(_Float16)lo, (_Float16)hi}; return __builtin_bit_cast(unsigned, v); }
__device__ __forceinline__ float h_lo(unsigned w) { return (float)__builtin_bit_cast(_Float16, (unsigned short)(w & 0xffffu)); }
__device__ __forceinline__ float h_hi(unsigned w) { return (float)__builtin_bit_cast(_Float16, (unsigned short)(w >> 16)); }

struct EpiZ {
    static constexpr bool PERM = true, AFTER_DRAIN = false;
    bf16_t* Z; const PG8_LAS float* rstd_lds; const bf16_t* rope; const float* qg; const float* kg;
    __device__ __forceinline__ void operator()(const f32x4 (&acc)[2][2][4][2], const Unit& u, int wr, int wc, int fr, int fq) const {
        const int row0 = u.pm * BM + wr * 64 + fr, cw = u.c0 + wc * 64, col0 = cw + 8 * fq;
        const bool is_q = cw < ZK, is_k = (cw >= ZK) && (cw < ZV), is_gate = (cw >= ZG && cw < ZU) || (cw >= ZSG && cw < ZXQ) || (cw >= ZXG);
        f32x4 g0a = {1.f, 1.f, 1.f, 1.f}, g0b = g0a, g1a = g0a, g1b = g0a; float qs = 1.f;
        if (is_q || is_k) { const float* g = is_q ? qg : kg; g0a = *(const f32x4*)(g + 8 * fq); g0b = *(const f32x4*)(g + 8 * fq + 4); g1a = *(const f32x4*)(g + 32 + 8 * fq); g1b = *(const f32x4*)(g + 36 + 8 * fq);
            if (is_q) qs = 0.125f * 1.4426950408889634f; }
#pragma unroll
        for (int ai = 0; ai < 2; ++ai)
#pragma unroll
            for (int m = 0; m < 4; ++m) { const int r = row0 + ai * HALF + m * 16;
                const float rs = rstd_lds[u.idx * 256 + wr * 64 + ai * HALF + m * 16 + fr];
                f32x4 a0 = acc[ai][0][m][0] * rs, a1 = acc[ai][0][m][1] * rs, b0 = acc[ai][1][m][0] * rs, b1 = acc[ai][1][m][1] * rs;
                if (is_q || is_k) {
                    float hs = ((a0[0] * a0[0] + a0[1] * a0[1]) + (a0[2] * a0[2] + a0[3] * a0[3])) + ((a1[0] * a1[0] + a1[1] * a1[1]) + (a1[2] * a1[2] + a1[3] * a1[3]))
                             + ((b0[0] * b0[0] + b0[1] * b0[1]) + (b0[2] * b0[2] + b0[3] * b0[3])) + ((b1[0] * b1[0] + b1[1] * b1[1]) + (b1[2] * b1[2] + b1[3] * b1[3]));
                    hs += __shfl_xor(hs, 16); hs += __shfl_xor(hs, 32);
                    const float rn = rsqrtf(hs * (1.f / HD) + EPS);
                    const u32x4 cv = *(const u32x4*)(rope + (size_t)r * 64 + 8 * fq), sv = *(const u32x4*)(rope + (size_t)r * 64 + 32 + 8 * fq);
                    a0 = a0 * g0a * rn; a1 = a1 * g0b * rn; b0 = b0 * g1a * rn; b1 = b1 * g1b * rn;
                    const f32x4 c0 = {h_lo(cv.x), h_hi(cv.x), h_lo(cv.y), h_hi(cv.y)}, c1 = {h_lo(cv.z), h_hi(cv.z), h_lo(cv.w), h_hi(cv.w)};
                    const f32x4 n0 = {h_lo(sv.x), h_hi(sv.x), h_lo(sv.y), h_hi(sv.y)}, n1 = {h_lo(sv.z), h_hi(sv.z), h_lo(sv.w), h_hi(sv.w)};
                    const f32x4 ra0 = (a0 * c0 - b0 * n0) * qs, ra1 = (a1 * c1 - b1 * n1) * qs, rb0 = (b0 * c0 + a0 * n0) * qs, rb1 = (b1 * c1 + a1 * n1) * qs;
                    a0 = ra0; a1 = ra1; b0 = rb0; b1 = rb1;
                } else if (is_gate) {
#pragma unroll
                    for (int j = 0; j < 4; ++j) { a0[j] = a0[j] * sigmoidf_(a0[j]); a1[j] = a1[j] * sigmoidf_(a1[j]); b0[j] = b0[j] * sigmoidf_(b0[j]); b1[j] = b1[j] * sigmoidf_(b1[j]); }
                }
                bf16_t* rowp = Z + (size_t)r * IN_W + col0;
                u32x4 w; w.x = pk_f16(a0[0], a0[1]); w.y = pk_f16(a0[2], a0[3]); w.z = pk_f16(a1[0], a1[1]); w.w = pk_f16(a1[2], a1[3]); *(u32x4*)(rowp) = w;
                w.x = pk_f16(b0[0], b0[1]); w.y = pk_f16(b0[2], b0[3]); w.z = pk_f16(b1[0], b1[1]); w.w = pk_f16(b1[2], b1[3]); *(u32x4*)(rowp + 32) = w; }
    }
};
struct EpiGlu {
    static constexpr bool PERM = true, AFTER_DRAIN = false;
    const bf16_t* Y2; const bf16_t* Z; const float* bg; bf16_t* MIX;
    __device__ __forceinline__ void operator()(const f32x4 (&acc)[2][2][4][2], const Unit& u, int wr, int wc, int fr, int fq) const {
        const int row0 = u.pm * BM + wr * 64 + fr, col0 = u.c0 + wc * 64 + 8 * fq;
#pragma unroll
        for (int bj = 0; bj < 2; ++bj) { const int c = col0 + bj * 32;
            const f32x4 b0 = *(const f32x4*)(bg + c), b1 = *(const f32x4*)(bg + c + 4);
#pragma unroll
            for (int ai = 0; ai < 2; ++ai)
#pragma unroll
                for (int m = 0; m < 4; ++m) { const int r = row0 + ai * HALF + m * 16;
                    const u32x4 yv = *(const u32x4*)(Y2 + (size_t)r * SSM_W + c), sv = *(const u32x4*)(Z + (size_t)r * IN_W + ZSG + c);
                    const f32x4 a0 = acc[ai][bj][m][0] + b0, a1 = acc[ai][bj][m][1] + b1;
                    float o[8];
#pragma unroll
                    for (int j = 0; j < 4; ++j) { const unsigned yw = yv[j], sw = sv[j];
                        const float g0 = (j < 2) ? a0[2 * j] : a1[2 * j - 4], g1 = (j < 2) ? a0[2 * j + 1] : a1[2 * j - 3];
                        o[2 * j] = h_lo(yw) * sigmoidf_(g0) * h_lo(sw); o[2 * j + 1] = h_hi(yw) * sigmoidf_(g1) * h_hi(sw); }
                    u32x4 w; w.x = pk_f16(o[0], o[1]); w.y = pk_f16(o[2], o[3]); w.z = pk_f16(o[4], o[5]); w.w = pk_f16(o[6], o[7]);
                    *(u32x4*)(MIX + (size_t)r * MIX_W + 512 + c) = w; } }
    }
};
template <int MODE> struct EpiOut {
    static constexpr bool PERM = true, AFTER_DRAIN = false;
    const float* xin; float* xout; bf16_t* XB; float* sumsq;
    __device__ __forceinline__ void operator()(const f32x4 (&acc)[2][2][4][2], const Unit& u, int wr, int wc, int fr, int fq) const {
        const int row0 = u.pm * BM + wr * 64 + fr, col0 = u.c0 + wc * 64 + 8 * fq;
#pragma unroll
        for (int ai = 0; ai < 2; ++ai)
#pragma unroll
            for (int m = 0; m < 4; ++m) { const int r = row0 + ai * HALF + m * 16; const size_t off = (size_t)r * D_MODEL + col0; float ss = 0.f;
#pragma unroll
                for (int bj = 0; bj < 2; ++bj) { f32x4 x0, x1;
                    if (MODE == 0) { x0 = *(const f32x4*)(xin + off + bj * 32); x1 = *(const f32x4*)(xin + off + bj * 32 + 4); }
                    else { const u32x4 xv = *(const u32x4*)(XB + off + bj * 32); x0 = (f32x4){h_lo(xv.x), h_hi(xv.x), h_lo(xv.y), h_hi(xv.y)}; x1 = (f32x4){h_lo(xv.z), h_hi(xv.z), h_lo(xv.w), h_hi(xv.w)}; }
                    const f32x4 o0 = x0 + acc[ai][bj][m][0], o1 = x1 + acc[ai][bj][m][1];
                    if (MODE == 2) { *(f32x4*)(xout + off + bj * 32) = o0; *(f32x4*)(xout + off + bj * 32 + 4) = o1; }
                    else { u32x4 w; w.x = pk_f16(o0[0], o0[1]); w.y = pk_f16(o0[2], o0[3]); w.z = pk_f16(o1[0], o1[1]); w.w = pk_f16(o1[2], o1[3]); *(u32x4*)(XB + off + bj * 32) = w;
                        ss += ((o0[0] * o0[0] + o0[1] * o0[1]) + (o0[2] * o0[2] + o0[3] * o0[3])) + ((o1[0] * o1[0] + o1[1] * o1[1]) + (o1[2] * o1[2] + o1[3] * o1[3])); } }
                if (MODE != 2) { ss += __shfl_xor(ss, 16); ss += __shfl_xor(ss, 32);
                    if (fq == 0) sumsq[(size_t)r * 16 + (u.c0 >> 8) * 4 + wc] = ss; } }
    }
};
struct EpiMemF32 {
    static constexpr bool PERM = false, AFTER_DRAIN = false;
    float* C; int ldc; const float* rstd;
    __device__ __forceinline__ void operator()(const f32x4 (&acc)[2][2][4][2], const Unit& u, int wr, int wc, int fr, int fq) const {
        const int row0 = u.pm * BM + wr * 64 + fr, col0 = u.c0 + wc * 32 + 4 * fq;
#pragma unroll
        for (int ai = 0; ai < 2; ++ai)
#pragma unroll
            for (int m = 0; m < 4; ++m) { const int r = row0 + ai * HALF + m * 16; const float rs = rstd[r]; float* rowp = C + (size_t)r * ldc + col0;
#pragma unroll
                for (int bj = 0; bj < 2; ++bj)
#pragma unroll
                    for (int n = 0; n < 2; ++n) *(f32x4*)(rowp + bj * HALF + n * 16) = acc[ai][bj][m][n] * rs; }
    }
};

template <class Epi, class Sched, bool ALIGN_EPI>
__device__ __forceinline__ void gemm_phase(PG8_LAS unsigned char* lds, const Gemm g, const Sched& S, const Epi& E) {
    int tid = threadIdx.x; asm volatile("" : "+v"(tid)); const int wid = __builtin_amdgcn_readfirstlane(tid >> 6), lane = tid & 63, wr = wid >> 2, wc = wid & 3, fr = lane & 15, fq = lane >> 4;
    const int K = g.K, nt = K / BK;
    unsigned voffA[2], voffB[2];
#pragma unroll
    for (int i = 0; i < 2; ++i) { int R, C; stage_rc(tid * 16 + i * 8192, R, C); const int Rb = Epi::PERM ? (64 * (R >> 5) + perm32(R & 31)) : R;
        voffA[i] = (unsigned)(R * K + C) * 2u; voffB[i] = (unsigned)(Rb * K + C) * 2u; }
    const size_t kstep = (size_t)(BK * 2);
    const size_t hstep = (size_t)HALF * K * 2;
    const size_t tstep = 2 * hstep;
    const size_t bhs = Epi::PERM ? (size_t)32 * K * 2 : hstep;
    const unsigned ldsw = (unsigned)wid * 1024u;
    const int aoff = lds_byte(wr * 64 + fr, fq * 8), boff = lds_byte(wc * 32 + fr, fq * 8);
#define PG8_SA(b, h) (((b) * 2 + (h)) * HTB)
#define PG8_SB(b, h) ((4 + (b) * 2 + (h)) * HTB)
#define PG8_STAGE(bufoff, gbase, voff) do { _Pragma("unroll") for (int _i = 0; _i < 2; ++_i) \
        __builtin_amdgcn_global_load_lds((const unsigned*)((const char*)(gbase) + (voff)[_i]), (PG8_LAS unsigned*)(lds + (bufoff) + ldsw + _i * 8192), 16, 0, 0); } while (0)
#define PG8_LDA(dst, b, h) do { _Pragma("unroll") for (int m = 0; m < 4; ++m) _Pragma("unroll") for (int k = 0; k < 2; ++k) dst[m][k] = *(const PG8_LAS f16x8*)(lds + PG8_SA(b, h) + aoff + m * 2048 + k * 1024); } while (0)
#define PG8_LDB(dst, b, h) do { _Pragma("unroll") for (int n = 0; n < 2; ++n) _Pragma("unroll") for (int k = 0; k < 2; ++k) dst[n][k] = *(const PG8_LAS f16x8*)(lds + PG8_SB(b, h) + boff + n * 2048 + k * 1024); } while (0)
#define PG8_MMA(ai, bj, At, Bt) do { __builtin_amdgcn_s_setprio(1); _Pragma("unroll") for (int m = 0; m < 4; ++m) _Pragma("unroll") for (int n = 0; n < 2; ++n) _Pragma("unroll") for (int k = 0; k < 2; ++k) \
        acc[ai][bj][m][n] = __builtin_amdgcn_mfma_f32_16x16x32_f16(Bt[n][k], At[m][k], acc[ai][bj][m][n], 0, 0, 0); __builtin_amdgcn_s_setprio(0); } while (0)
#define PG8_WAIT_V(n) asm volatile("s_waitcnt vmcnt(" #n ")" ::: "memory")
#define PG8_WAIT_L(n) asm volatile("s_waitcnt lgkmcnt(" #n ")" ::: "memory")
#define PG8_BAR __builtin_amdgcn_s_barrier()
#define PG8_SCHED __builtin_amdgcn_sched_barrier(0)
    Unit cur, nxt; int ui = 0;
    if (!S.next(0, cur)) return;
    f32x4 acc[2][2][4][2];
#pragma unroll
    for (int a = 0; a < 2; ++a)
#pragma unroll
        for (int b = 0; b < 2; ++b)
#pragma unroll
            for (int m = 0; m < 4; ++m)
#pragma unroll
                for (int n = 0; n < 2; ++n) acc[a][b][m][n] = (f32x4){0.f, 0.f, 0.f, 0.f};
    f16x8 At[4][2], B0[2][2], B1[2][2];
    const char* cA = (const char*)g.A + (size_t)cur.pm * tstep; const char* cB = (const char*)g.Bt + (size_t)cur.c0 * K * 2;
    S.a_ready(cur);
    PG8_STAGE(PG8_SB(0, 0), cB, voffB); PG8_STAGE(PG8_SB(0, 1), cB + bhs, voffB); PG8_STAGE(PG8_SA(0, 0), cA, voffA); PG8_STAGE(PG8_SA(0, 1), cA + hstep, voffA);
    if (wr == 1) PG8_BAR;
    PG8_WAIT_V(2); PG8_BAR;
    PG8_STAGE(PG8_SB(1, 0), cB + kstep, voffB); PG8_STAGE(PG8_SA(1, 0), cA + kstep, voffA); PG8_STAGE(PG8_SB(1, 1), cB + bhs + kstep, voffB);
    PG8_WAIT_V(6); PG8_BAR;
    for (;;) {
        const bool has_next = S.next(ui + 1, nxt);
        const char* nA = has_next ? (const char*)g.A + (size_t)nxt.pm * tstep : cA; const char* nB = has_next ? (const char*)g.Bt + (size_t)nxt.c0 * K * 2 : cB;
        for (int t = 0; t < nt; t += 2) {
            const bool last = (t == nt - 2);
            const char* a1 = cA + (size_t)(t + 1) * kstep;
            const char* a2 = last ? nA : cA + (size_t)(t + 2) * kstep; const char* b2 = last ? nB : cB + (size_t)(t + 2) * kstep;
            const char* a3 = a2 + kstep; const char* b3 = b2 + kstep;
            if (last && has_next) S.a_ready(nxt);
            PG8_LDB(B0, 0, 0); PG8_LDB(B1, 0, 1); PG8_SCHED; PG8_LDA(At, 0, 0); PG8_STAGE(PG8_SA(1, 1), a1 + hstep, voffA);
            PG8_WAIT_V(8); PG8_WAIT_L(0); PG8_BAR; PG8_MMA(0, 0, At, B0); if (!cur.half) PG8_MMA(0, 1, At, B1); PG8_BAR; PG8_SCHED;
            PG8_LDA(At, 0, 1); PG8_STAGE(PG8_SB(0, 0), b2, voffB); PG8_STAGE(PG8_SB(0, 1), b2 + bhs, voffB); PG8_STAGE(PG8_SA(0, 0), a2, voffA);
            PG8_WAIT_V(8); PG8_WAIT_L(0); PG8_BAR; PG8_MMA(1, 0, At, B0); if (!cur.half) PG8_MMA(1, 1, At, B1); PG8_BAR; PG8_SCHED;
            PG8_LDB(B0, 1, 0); PG8_LDB(B1, 1, 1); PG8_SCHED; PG8_LDA(At, 1, 0); PG8_STAGE(PG8_SA(0, 1), a2 + hstep, voffA);
            PG8_WAIT_V(8); PG8_WAIT_L(0); PG8_BAR; PG8_MMA(0, 0, At, B0); if (!cur.half) PG8_MMA(0, 1, At, B1); PG8_BAR; PG8_SCHED;
            PG8_LDA(At, 1, 1); PG8_STAGE(PG8_SB(1, 0), b3, voffB); PG8_STAGE(PG8_SB(1, 1), b3 + bhs, voffB); PG8_STAGE(PG8_SA(1, 0), a3, voffA);
            PG8_WAIT_V(8); PG8_WAIT_L(0); PG8_BAR; PG8_MMA(1, 0, At, B0); if (!cur.half) PG8_MMA(1, 1, At, B1); PG8_BAR; PG8_SCHED;
        }
        if constexpr (ALIGN_EPI) { if (wr == 0) PG8_BAR; }
        E(acc, cur, wr, wc, fr, fq); S.done(cur);
        if (!has_next) break;
#pragma unroll
        for (int a = 0; a < 2; ++a)
#pragma unroll
            for (int b = 0; b < 2; ++b)
#pragma unroll
                for (int m = 0; m < 4; ++m)
#pragma unroll
                    for (int n = 0; n < 2; ++n) acc[a][b][m][n] = (f32x4){0.f, 0.f, 0.f, 0.f};
        cur = nxt; cA = nA; cB = nB; ++ui;
        if constexpr (ALIGN_EPI) { if (wr == 1) PG8_BAR; }
    }
    PG8_WAIT_V(0);
    if constexpr (!ALIGN_EPI) { if (wr == 0) PG8_BAR; }
    PG8_BAR;
#undef PG8_SA
#undef PG8_SB
#undef PG8_STAGE
#undef PG8_LDA
#undef PG8_LDB
#undef PG8_MMA
#undef PG8_WAIT_V
#undef PG8_WAIT_L
#undef PG8_BAR
#undef PG8_SCHED
}
}

constexpr int NWAVES = 8, NTHREADS = 512;
constexpr int LDS_BYTES = 155648;
constexpr int LDSCTL_OFF = 154624;
#define LAS __attribute__((address_space(3)))
typedef unsigned v4u __attribute__((ext_vector_type(4)));
typedef float f32x4 __attribute__((ext_vector_type(4)));

struct Params {
    const float* x; const float* mem; const int* pos; const float* norm_g; const float* w_in; const float* q_norm_g; const float* k_norm_g; const float* sinks;
    const float* lam_re; const float* lam_im; const float* log_dt; const float* b_re; const float* b_im; const float* c_re; const float* c_im; const float* d_skip;
    const float* w_glu; const float* b_glu; const float* mem_norm_g; const float* w_mem_kv; const float* xq_norm_g; const float* xk_norm_g; const float* w_out;
    float* out; unsigned char* ws;
};

__device__ __forceinline__ void p0_transpose_item(const float* W, int K, int N, const float* scale, bf16_t* WT, LAS float* scr, int item, int lane) {
    const int nblk = N / 64, kb = item / nblk, nb = item % nblk, k0 = 64 * kb, n0 = 64 * nb;
    const int lr = lane >> 4, lc = (lane & 15) * 4;
#pragma unroll 4
    for (int i = 0; i < 16; ++i) { const int kk = 4 * i + lr; const float sc = scale ? scale[k0 + kk] : 1.f; const f32x4 v = *(const f32x4*)(W + (size_t)(k0 + kk) * N + n0 + lc);
        LAS float* d = scr + kk * 65 + lc; d[0] = v[0] * sc; d[1] = v[1] * sc; d[2] = v[2] * sc; d[3] = v[3] * sc; }
    asm volatile("s_waitcnt lgkmcnt(0)" ::: "memory");
    const int c = lane & 7;
#pragma unroll
    for (int j = 0; j < 8; ++j) { const int n = (lane >> 3) + 8 * j; const LAS float* s = scr + (8 * c) * 65 + n;
        v4u o; o.x = pg8::pk_f16(s[0 * 65], s[1 * 65]); o.y = pg8::pk_f16(s[2 * 65], s[3 * 65]); o.z = pg8::pk_f16(s[4 * 65], s[5 * 65]); o.w = pg8::pk_f16(s[6 * 65], s[7 * 65]);
        *(v4u*)(WT + (size_t)(n0 + n) * K + k0 + 8 * c) = o; }
    asm volatile("s_waitcnt lgkmcnt(0)" ::: "memory");
}
__device__ __forceinline__ void phase_prep(const Params& P, LAS unsigned char* lds, int vcu, int G) {
    int tid = threadIdx.x; asm volatile("" : "+v"(tid)); const int lane = tid & 63, wave = __builtin_amdgcn_readfirstlane(tid >> 6);
    LAS float* scr = (LAS float*)(lds + wave * 16640);
    const int gw = vcu * NWAVES + wave, NGW = G * NWAVES;
    unsigned char* ws = P.ws;
    constexpr int I_IN = (D_MODEL / 64) * (IN_W / 64), I_OUT = (MIX_W / 64) * (D_MODEL / 64), I_GLU = (SSM_W / 64) * (SSM_W / 64), I_MEM = (D_MODEL / 64) * (1024 / 64);
    constexpr int I_LAYER = I_IN + I_OUT + I_GLU + I_MEM;
    for (int it = gw; it < DEPTH * I_LAYER; it += NGW) {
        const int l = it / I_LAYER; int r = it % I_LAYER;
        if (r < I_IN) { p0_transpose_item(P.w_in + (size_t)l * D_MODEL * IN_W, D_MODEL, IN_W, P.norm_g + l * D_MODEL, (bf16_t*)(ws + WS_WIN) + (size_t)l * IN_W * D_MODEL, scr, r, lane); continue; } r -= I_IN;
        if (r < I_OUT) { p0_transpose_item(P.w_out + (size_t)l * MIX_W * D_MODEL, MIX_W, D_MODEL, nullptr, (bf16_t*)(ws + WS_WOUT) + (size_t)l * D_MODEL * MIX_W, scr, r, lane); continue; } r -= I_OUT;
        if (r < I_GLU) { p0_transpose_item(P.w_glu + (size_t)l * SSM_W * SSM_W, SSM_W, SSM_W, nullptr, (bf16_t*)(ws + WS_WGLU) + (size_t)l * SSM_W * SSM_W, scr, r, lane); continue; } r -= I_GLU;
        p0_transpose_item(P.w_mem_kv + (size_t)l * D_MODEL * 1024, D_MODEL, 1024, P.mem_norm_g + l * D_MODEL, (bf16_t*)(ws + WS_WMEM) + (size_t)l * 1024 * D_MODEL, scr, r, lane);
    }
    for (int m = gw; m < MTOK + BATCH * N_MEM; m += NGW) {
        const bool is_x = m < MTOK; const int row = is_x ? m : m - MTOK;
        const f32x4* xr = (const f32x4*)((is_x ? P.x : P.mem) + (size_t)row * D_MODEL) + lane;
        bf16_t* ob = (bf16_t*)(ws + (is_x ? WS_XB : WS_MEMB)) + (size_t)row * D_MODEL;
        f32x4 v[4]; float s = 0.f;
#pragma unroll
        for (int j = 0; j < 4; ++j) { v[j] = xr[64 * j]; s += (v[j][0] * v[j][0] + v[j][1] * v[j][1]) + (v[j][2] * v[j][2] + v[j][3] * v[j][3]); }
        s = wave_sum(s);
#pragma unroll
        for (int j = 0; j < 4; ++j) { pg8::u32x2 w; w.x = pg8::pk_f16(v[j][0], v[j][1]); w.y = pg8::pk_f16(v[j][2], v[j][3]); *((pg8::u32x2*)ob + lane + 64 * j) = w; }
        if (is_x) { if (lane < 16) ((float*)(ws + WS_SUMSQ))[(size_t)row * 16 + lane] = (lane == 0) ? s : 0.f; }
        else if (lane == 0) ((float*)(ws + WS_MISC))[row] = rsqrtf(s * (1.f / D_MODEL) + EPS);
    }
    { bf16_t* tab = (bf16_t*)(ws + WS_ROPE);
      for (int idx = vcu * NTHREADS + tid; idx < MTOK * 32; idx += G * NTHREADS) { const int tok = idx >> 5, i = idx & 31;
          const float inv = powf(10000.0f, -(float)i / 32.0f); const float ang = (float)P.pos[tok] * inv; const double a = (double)ang;
          tab[tok * 64 + i] = f2bf((float)cos(a)); tab[tok * 64 + 32 + i] = f2bf((float)sin(a)); } }
}


typedef _Float16 f16x8 __attribute__((ext_vector_type(8)));
typedef float f32x16 __attribute__((ext_vector_type(16)));
__device__ __forceinline__ int crow(int r, int hi) { return (r & 3) + 8 * (r >> 2) + 4 * hi; }
__device__ __forceinline__ float hf(_Float16 h) { return (float)h; }
constexpr float LOG2E = 1.4426950408889634f;
__device__ __forceinline__ f16x8 pack8(const f32x16& p, int s) { f16x8 r;
#pragma unroll
    for (int j = 0; j < 8; ++j) r[j] = (_Float16)p[8 * s + j];
    return r; }


__device__ __forceinline__ void stage_tile(LAS unsigned char* st, int pitchB, int colOff, const f32x16& o, int c, int hi) {
#pragma unroll
    for (int r = 0; r < 16; ++r) *(LAS _Float16*)(st + crow(r, hi) * pitchB + (colOff + c) * 2) = (_Float16)o[r];
}

typedef unsigned v2u __attribute__((ext_vector_type(2)));
__device__ __forceinline__ void stage_ot(LAS unsigned char* st, int pitchB, int colOff, const f32x16& o, float sc, int q, int hi) {
#pragma unroll
    for (int g4 = 0; g4 < 4; ++g4) { v2u w; w.x = pg8::pk_f16(o[4 * g4] * sc, o[4 * g4 + 1] * sc); w.y = pg8::pk_f16(o[4 * g4 + 2] * sc, o[4 * g4 + 3] * sc);
        *(LAS v2u*)(st + q * pitchB + (colOff + 8 * g4 + 4 * hi) * 2) = w; }
}
__device__ __forceinline__ void stage_ot2(LAS unsigned char* st, int pitchB, int colOff, const f32x16& o0, float s0, const f32x16& o1, float s1, int q, int hi) {
#pragma unroll
    for (int g4 = 0; g4 < 4; ++g4) { v2u w; w.x = pg8::pk_f16(o0[4 * g4] * s0 + o1[4 * g4] * s1, o0[4 * g4 + 1] * s0 + o1[4 * g4 + 1] * s1); w.y = pg8::pk_f16(o0[4 * g4 + 2] * s0 + o1[4 * g4 + 2] * s1, o0[4 * g4 + 3] * s0 + o1[4 * g4 + 3] * s1);
        *(LAS v2u*)(st + q * pitchB + (colOff + 8 * g4 + 4 * hi) * 2) = w; }
}
__device__ __forceinline__ v4u pk_mul8(v4u a, v4u b) { return __builtin_bit_cast(v4u, __builtin_bit_cast(f16x8, a) * __builtin_bit_cast(f16x8, b)); }

typedef _Float16 h2_t __attribute__((ext_vector_type(2)));
__device__ __forceinline__ float sum8_f16(f16x8 v, float acc) {
    const h2_t one = {(_Float16)1.f, (_Float16)1.f};
#pragma unroll
    for (int k = 0; k < 4; ++k) { const h2_t p = {v[2 * k], v[2 * k + 1]}; acc = __builtin_amdgcn_fdot2(p, one, acc, false); }
    return acc; }
__device__ __forceinline__ float silu_fast(float x) { return x * __builtin_amdgcn_rcpf(1.f + __expf(-x)); }
constexpr int ATT_KF = 0, ATT_VF = 32768, ATT_ST = 65536;
__device__ __forceinline__ int opaque_tid() { int t = threadIdx.x; asm volatile("" : "+v"(t)); return t; }
__device__ __forceinline__ void attn_a_item(const Params& P, int layer, LAS unsigned char* lds, int item) {
    const int tid = opaque_tid(), lane = tid & 63, wave = __builtin_amdgcn_readfirstlane(tid >> 6);
    const int kvh = item & 1, blk = (item >> 1) & 31, b = item >> 6;
    const bf16_t* Z = (const bf16_t*)(P.ws + WS_Z); bf16_t* MIX = (bf16_t*)(P.ws + WS_MIX); const bf16_t* rope = (const bf16_t*)(P.ws + WS_ROPE);
    const float* kg = P.k_norm_g + layer * HD; const float* qg = P.q_norm_g + layer * HD;
    {
        const int key = tid >> 1, hh = tid & 1, tpos = blk * 128 - 128 + key; const bool valid = tpos >= 0;
        const int tok = b * SEQ + (valid ? tpos : 0);
        const bf16_t* zr = Z + (size_t)tok * IN_W;
        const int kt = key >> 5, kl = key & 31;
#pragma unroll
        for (int i = 0; i < 2; ++i) { const int c = 2 * hh + i;
            f16x8 o1 = *(const f16x8*)(zr + ZK + kvh * HD + 8 * c), o2 = *(const f16x8*)(zr + ZK + kvh * HD + 32 + 8 * c);
            if (!valid) { o1 = (f16x8){0, 0, 0, 0, 0, 0, 0, 0}; o2 = o1; }
            { const int cc = c;     *(LAS f16x8*)(lds + ATT_KF + (((kt * 4 + (cc >> 1)) * 64) + kl + 32 * (cc & 1)) * 16) = o1; }
            { const int cc = c + 4; *(LAS f16x8*)(lds + ATT_KF + (((kt * 4 + (cc >> 1)) * 64) + kl + 32 * (cc & 1)) * 16) = o2; } }
        const int sK = kl >> 4, h2 = ((kl & 15) >> 2) & 1, jj = 4 * ((kl & 15) >> 3) + (kl & 3);
        LAS unsigned short* vb = (LAS unsigned short*)(lds + ATT_VF + ((((kt * 2 + hh) * 2 + sK) * 64) + 32 * h2) * 16 + 2 * jj);
#pragma unroll
        for (int i = 0; i < 4; ++i) { const v4u v = *(const v4u*)(zr + ZV + kvh * HD + 32 * hh + 8 * i);
#pragma unroll
            for (int j = 0; j < 8; ++j) { const unsigned wv = v[j >> 1]; vb[(8 * i + j) * 8] = valid ? (unsigned short)((j & 1) ? (wv >> 16) : (wv & 0xffffu)) : (unsigned short)0; } }
    }
    const int ql = lane & 31, hi = lane >> 5;
    f16x8 qfu[2][4];
#pragma unroll
    for (int ui = 0; ui < 2; ++ui) {
        const int head = 2 * (wave >> 2) + ui, w = wave & 3, hq = kvh * 4 + head;
        const int tq = b * SEQ + blk * 128 + 32 * w + ql;
        const bf16_t* zq = Z + (size_t)tq * IN_W + ZQ + hq * HD;
#pragma unroll
        for (int d0 = 0; d0 < 4; ++d0) qfu[ui][d0] = *(const f16x8*)(zq + 16 * d0 + 8 * hi);
    }
    __syncthreads();
#pragma unroll
    for (int ui = 0; ui < 2; ++ui) {
        const int head = 2 * (wave >> 2) + ui, w = wave & 3, hq = kvh * 4 + head;
        const f16x8* qf = qfu[ui];
        const int erow = lane >> 1, ehs = lane & 1; const size_t etok = (size_t)b * SEQ + blk * 128 + 32 * w + erow; const int ecol = hq * HD + 32 * ehs;
        v4u gv[4];
#pragma unroll
        for (int i = 0; i < 4; ++i) gv[i] = *(const v4u*)(Z + etok * IN_W + ZG + ecol + 8 * i);
        f32x16 p[5];
#pragma unroll
        for (int t = 0; t < 5; ++t) { const int kt = w + t; f32x16 acc = {};
#pragma unroll
            for (int d0 = 0; d0 < 4; ++d0) { const f16x8 kf = *(const LAS f16x8*)(lds + ATT_KF + ((kt * 4 + d0) * 64 + lane) * 16);
                acc = __builtin_amdgcn_mfma_f32_32x32x16_f16(kf, qf[d0], acc, 0, 0, 0); }
            p[t] = acc; }
        float mx = -INFINITY;
        int qlv = ql; asm volatile("" : "+v"(qlv));
#pragma unroll
        for (int t = 0; t < 5; ++t) { const bool tile_off = (blk == 0) && (w + t < 4);
#pragma unroll
            for (int r = 0; r < 16; ++r) { bool ok = !tile_off; if (t == 0) ok = ok && (crow(r, hi) > qlv); if (t == 4) ok = ok && (crow(r, hi) <= qlv);
                const float v = ok ? p[t][r] : -INFINITY; p[t][r] = v; mx = fmaxf(mx, v); } }
        mx = fmaxf(mx, __shfl_xor(mx, 32));
        const float sink2 = P.sinks[layer * NQH + hq] * LOG2E;
        mx = fmaxf(mx, sink2);
#pragma unroll
        for (int t = 0; t < 5; ++t) { const f32x16 dv = p[t] - mx;
#pragma unroll
            for (int r = 0; r < 16; ++r) p[t][r] = __builtin_amdgcn_exp2f(dv[r]); }
        float l = 0.f;
        f32x16 o[2] = {};
#pragma unroll
        for (int t = 0; t < 5; ++t) { const int kt = w + t;
#pragma unroll
            for (int s2 = 0; s2 < 2; ++s2) { const f16x8 pa = pack8(p[t], s2); l = sum8_f16(pa, l);
#pragma unroll
                for (int db = 0; db < 2; ++db) { const f16x8 vf = *(const LAS f16x8*)(lds + ATT_VF + (((kt * 2 + db) * 2 + s2) * 64 + lane) * 16);
                    o[db] = __builtin_amdgcn_mfma_f32_32x32x16_f16(vf, pa, o[db], 0, 0, 0); } } }
        l += __shfl_xor(l, 32); l += __builtin_amdgcn_exp2f(sink2 - mx);
        const float linv = __builtin_amdgcn_rcpf(l);
        { LAS unsigned char* st = lds + ATT_ST + wave * 4608;
          stage_ot(st, 144, 0, o[0], linv, ql, hi); stage_ot(st, 144, 32, o[1], linv, ql, hi);
#pragma unroll
          for (int i = 0; i < 4; ++i) { const v4u ov = *(const LAS v4u*)(st + erow * 144 + ehs * 64 + 16 * i);
              *(v4u*)(MIX + etok * MIX_W + ecol + 8 * i) = pk_mul8(ov, gv[i]); } }
    }
    __syncthreads();
}
__device__ __forceinline__ void phase_attn_a(const Params& P, int layer, LAS unsigned char* lds, int vcu, int G, int bx, bool defer) {
    if (defer) {
        if (bx < 128) attn_a_item(P, layer, lds, bx);
        else for (int j = 0; j < 3; ++j) attn_a_item(P, layer, lds, 128 + 3 * (bx - 128) + j);
        return; }
    for (int it = vcu; it < BATCH * 32 * NKVH; it += G) attn_a_item(P, layer, lds, it);
}

__device__ __forceinline__ void attn_c_item(const Params& P, int layer, LAS unsigned char* lds, int item) {
    const int tid = opaque_tid(), lane = tid & 63, wave = __builtin_amdgcn_readfirstlane(tid >> 6);
    const int sblk = item & 7, h = (item >> 3) & 3, b = item >> 5;
    const bf16_t* Z = (const bf16_t*)(P.ws + WS_Z); bf16_t* MIX = (bf16_t*)(P.ws + WS_MIX);
    const f16x8* KFg = (const f16x8*)(P.ws + WS_MK) + (size_t)((layer * BATCH + b) * XH + h) * (8 * 8 * 64);
    const f16x8* VFg = (const f16x8*)(P.ws + WS_MV) + (size_t)((layer * BATCH + b) * XH + h) * (8 * 4 * 2 * 64);
    const float* xqg = P.xq_norm_g + layer * XHD;
#pragma unroll
    for (int i = 0; i < 16; ++i) { const int f = wave * 16 + i; const f16x8* src = (f < 64 ? KFg + f * 64 : VFg + (f - 64) * 64) + lane;
        __builtin_amdgcn_global_load_lds((const unsigned*)src, (LAS unsigned*)(lds + f * 1024), 16, 0, 0); }
    asm volatile("s_waitcnt vmcnt(0)" ::: "memory");
    __syncthreads();
    const int ql = lane & 31, hi = lane >> 5;
    for (int ui = 0; ui < 2; ++ui) {
        const int qbase = b * SEQ + sblk * 512 + (wave * 2 + ui) * 32;
        const bf16_t* zq = Z + (size_t)(qbase + ql) * IN_W + ZXQ + h * XHD;
        f16x8 qf[8]; float ss = 0.f;
#pragma unroll
        for (int d0 = 0; d0 < 8; ++d0) { qf[d0] = *(const f16x8*)(zq + 16 * d0 + 8 * hi);
#pragma unroll
            for (int k2 = 0; k2 < 4; ++k2) { const h2_t v = {qf[d0][2 * k2], qf[d0][2 * k2 + 1]}; ss = __builtin_amdgcn_fdot2(v, v, ss, false); } }
        ss += __shfl_xor(ss, 32);
        const _Float16 rsh = (_Float16)(rsqrtf(ss * (1.f / XHD) + EPS) * (0.08838834764831845f * LOG2E));
#pragma unroll
        for (int d0 = 0; d0 < 8; ++d0) qf[d0] = qf[d0] * rsh;
        f16x8 pa[2][4][2]; float mh[2], lh[2];
#pragma unroll
        for (int hf2 = 0; hf2 < 2; ++hf2) {
            f32x16 p[4];
#pragma unroll
            for (int t = 0; t < 4; ++t) { const int kt = 4 * hf2 + t; f32x16 acc = {};
#pragma unroll
                for (int d0 = 0; d0 < 8; ++d0) acc = __builtin_amdgcn_mfma_f32_32x32x16_f16(*(const LAS f16x8*)(lds + ((kt * 8 + d0) * 64 + lane) * 16), qf[d0], acc, 0, 0, 0);
                p[t] = acc; asm volatile("" ::: "memory"); }
            float mx = -INFINITY;
#pragma unroll
            for (int t = 0; t < 4; ++t)
#pragma unroll
                for (int r = 0; r < 16; ++r) mx = fmaxf(mx, p[t][r]);
            mx = fmaxf(mx, __shfl_xor(mx, 32));
            float l = 0.f;
#pragma unroll
            for (int t = 0; t < 4; ++t) { const f32x16 dv = p[t] - mx;
#pragma unroll
                for (int r = 0; r < 16; ++r) p[t][r] = __builtin_amdgcn_exp2f(dv[r]);
                pa[hf2][t][0] = pack8(p[t], 0); pa[hf2][t][1] = pack8(p[t], 1); l = sum8_f16(pa[hf2][t][0], l); l = sum8_f16(pa[hf2][t][1], l); }
            l += __shfl_xor(l, 32);
            mh[hf2] = mx; lh[hf2] = l;
        }
        const float mm = fmaxf(mh[0], mh[1]); const float e0 = __builtin_amdgcn_exp2f(mh[0] - mm), e1 = __builtin_amdgcn_exp2f(mh[1] - mm);
        const float linv = __builtin_amdgcn_rcpf(lh[0] * e0 + lh[1] * e1); const float f0 = e0 * linv, f1 = e1 * linv;
#pragma unroll
        for (int db = 0; db < 4; ++db) { f32x16 o0 = {}, o1 = {};
#pragma unroll
            for (int t = 0; t < 4; ++t) {
#pragma unroll
                for (int s2 = 0; s2 < 2; ++s2) { o0 = __builtin_amdgcn_mfma_f32_32x32x16_f16(*(const LAS f16x8*)(lds + 65536 + (((t * 4 + db) * 2 + s2) * 64 + lane) * 16), pa[0][t][s2], o0, 0, 0, 0);
                    o1 = __builtin_amdgcn_mfma_f32_32x32x16_f16(*(const LAS f16x8*)(lds + 65536 + ((((4 + t) * 4 + db) * 2 + s2) * 64 + lane) * 16), pa[1][t][s2], o1, 0, 0, 0); }
                asm volatile("" ::: "memory"); }
            { LAS unsigned char* st = lds + 131072 + wave * 2560; const int erow = lane >> 1, ehs = lane & 1;
              const size_t tok = (size_t)qbase + erow; const int col = h * XHD + 32 * db + 16 * ehs;
              const v4u ga = *(const v4u*)(Z + tok * IN_W + ZXG + col), gb = *(const v4u*)(Z + tok * IN_W + ZXG + col + 8);
              stage_ot2(st, 80, 0, o0, f0, o1, f1, ql, hi);
              const v4u a0 = *(const LAS v4u*)(st + erow * 80 + ehs * 32), a1 = *(const LAS v4u*)(st + erow * 80 + ehs * 32 + 16);
              *(v4u*)(MIX + tok * MIX_W + 1024 + col) = pk_mul8(a0, ga); *(v4u*)(MIX + tok * MIX_W + 1024 + col + 8) = pk_mul8(a1, gb); }
            asm volatile("" ::: "memory"); }
    }
    __syncthreads();
}
__device__ __forceinline__ void phase_attn_c(const Params& P, int layer, LAS unsigned char* lds, int vcu, int G) {
    for (int it = vcu; it < BATCH * XH * 8; it += G) attn_c_item(P, layer, lds, it);
}
__device__ __forceinline__ void phase_memfin(const Params& P, int vcu, int G) {
    const int tid = opaque_tid(), lane = tid & 63, wave = __builtin_amdgcn_readfirstlane(tid >> 6);
    const float* mkv = (const float*)(P.ws + WS_Y2);
    for (int it = vcu * NWAVES + wave; it < DEPTH * BATCH * N_MEM; it += G * NWAVES) {
        const int l = it / (BATCH * N_MEM), row = it % (BATCH * N_MEM), b = row / N_MEM, key = row % N_MEM;
        const float* r = mkv + (size_t)row * (DEPTH * 1024) + l * 1024; const float* xkg = P.xk_norm_g + l * XHD; const float* xqg = P.xq_norm_g + l * XHD;
        const int kt = key >> 5, kl = key & 31, sK = kl >> 4, h2 = ((kl & 15) >> 2) & 1, jj = 4 * ((kl & 15) >> 3) + (kl & 3);
        for (int h = 0; h < XH; ++h) {
            bf16_t* KF = (bf16_t*)(P.ws + WS_MK) + (size_t)((l * BATCH + b) * XH + h) * (8 * 8 * 64 * 8);
            bf16_t* VF = (bf16_t*)(P.ws + WS_MV) + (size_t)((l * BATCH + b) * XH + h) * (8 * 4 * 2 * 64 * 8);
            float v[2]; v[0] = r[h * XHD + lane]; v[1] = r[h * XHD + 64 + lane];
            const float s = wave_sum(v[0] * v[0] + v[1] * v[1]); const float rs = rsqrtf(s * (1.f / XHD) + EPS);
#pragma unroll
            for (int e = 0; e < 2; ++e) { const int d = lane + 64 * e;
                KF[(size_t)((kt * 8 + (d >> 4)) * 64 + kl + 32 * ((d >> 3) & 1)) * 8 + (d & 7)] = f2bf(v[e] * rs * xkg[d] * xqg[d]);
                VF[(size_t)(((kt * 4 + (d >> 5)) * 2 + sK) * 64 + (d & 31) + 32 * h2) * 8 + jj] = f2bf(r[512 + h * XHD + d]); }
        }
    }
}


constexpr size_t SSMC_WE = 0, SSMC_WC = 64 * 1024, SSMC_KJ = 128 * 1024, SSMC_STRIDE = 144 * 1024;
constexpr size_t WS_A16 = WS_MISC + 128 * 1024;
__device__ __forceinline__ void ssm_consts_item(const Params& P, LAS unsigned char* lds, int item) {
    const int tid = opaque_tid(); const int l = item / SSM_G, g = item % SSM_G;
    LAS float* apw = (LAS float*)lds;
    LAS float* bbar = apw + 17 * 64 * 2;
    LAS float* kj = bbar + 64 * 16 * 2;
    LAS float* cre = kj + 16 * 256; LAS float* cim = cre + 16 * 64;
    { const float* c_re_g = P.c_re + (size_t)(l * SSM_G + g) * SSM_CH * SSM_P; const float* c_im_g = P.c_im + (size_t)(l * SSM_G + g) * SSM_CH * SSM_P;
      for (int i = tid; i < 16 * 64; i += NTHREADS) { cre[i] = c_re_g[i]; cim[i] = c_im_g[i]; } }
    const LAS float* c_re = cre; const LAS float* c_im = cim;
    const double dt = exp((double)P.log_dt[l * SSM_G + g]);
    for (int i = tid; i < 17 * 64; i += NTHREADS) { const int j = i / 64, p = i % 64; const int gp = (l * SSM_G + g) * SSM_P + p;
        const double lr = P.lam_re[gp], li = P.lam_im[gp]; const double mag = exp(lr * dt * j); double sn, cs; sincos(li * dt * j, &sn, &cs);
        apw[i * 2] = (float)(mag * cs); apw[i * 2 + 1] = (float)(mag * sn); }
    for (int i = tid; i < 64 * 16; i += NTHREADS) { const int p = i / 16, c = i % 16; const int gp = (l * SSM_G + g) * SSM_P + p;
        const double lr = P.lam_re[gp], li = P.lam_im[gp]; const double mag = exp(lr * dt), ar = mag * cos(li * dt), ai = mag * sin(li * dt), den = lr * lr + li * li;
        const double fr = ((ar - 1.0) * lr + ai * li) / den, fi = (ai * lr - (ar - 1.0) * li) / den;
        const double br = P.b_re[(size_t)gp * SSM_CH + c], bi = P.b_im[(size_t)gp * SSM_CH + c];
        bbar[i * 2] = (float)(fr * br - fi * bi); bbar[i * 2 + 1] = (float)(fr * bi + fi * br); }
    __syncthreads();
    for (int i = tid; i < 16 * 256; i += NTHREADS) { const int j = i >> 8, co = (i >> 4) & 15, ci = i & 15; float acc = 0.f;
        for (int p = 0; p < 64; ++p) { const float er = apw[(j * 64 + p) * 2], ei = apw[(j * 64 + p) * 2 + 1], br = bbar[(p * 16 + ci) * 2], bi = bbar[(p * 16 + ci) * 2 + 1];
            const float wr = er * br - ei * bi, wi = er * bi + ei * br; acc += c_re[co * SSM_P + p] * wr - c_im[co * SSM_P + p] * wi; }
        if (j == 0 && co == ci) acc += P.d_skip[l * SSM_W + g * SSM_CH + co];
        kj[i] = acc; }
    __syncthreads();
    unsigned char* base = P.ws + WS_SSMP + (size_t)item * SSMC_STRIDE;
    bf16_t* WE = (bf16_t*)(base + SSMC_WE); bf16_t* WC = (bf16_t*)(base + SSMC_WC); bf16_t* KJ = (bf16_t*)(base + SSMC_KJ);
    for (int i = tid; i < 64 * 512; i += NTHREADS) { const int f = i >> 9, e = i & 511, ln = e >> 3, j = e & 7, mt = f >> 4, sx = f & 15, r = ln & 31, hh = ln >> 5;
        const int R = 32 * mt + r, p = R >> 1, ri = R & 1, ci = 8 * hh + j; const float er = apw[((15 - sx) * 64 + p) * 2], ei = apw[((15 - sx) * 64 + p) * 2 + 1], br = bbar[(p * 16 + ci) * 2], bi = bbar[(p * 16 + ci) * 2 + 1];
        WE[i] = f2bf(ri ? (er * bi + ei * br) : (er * br - ei * bi)); }
    for (int i = tid; i < 9216 / 2; i += NTHREADS) KJ[i] = (i < 16 * 256) ? f2bf(kj[i]) : (bf16_t)0;
    for (int i = tid; i < 64 * 512; i += NTHREADS) { const int f = i >> 9, e = i & 511, ln = e >> 3, j = e & 7, mt = f >> 3, kc = f & 7, r = ln & 31, hh = ln >> 5;
        const int t = 2 * mt + (r >> 4), co = r & 15, p = 8 * kc + 4 * hh + (j >> 1), ri = j & 1; const float er = apw[((t + 1) * 64 + p) * 2], ei = apw[((t + 1) * 64 + p) * 2 + 1];
        const float cr = c_re[co * SSM_P + p], cim = c_im[co * SSM_P + p]; WC[i] = f2bf(ri ? -(cr * ei + cim * er) : (cr * er - cim * ei)); }
    if (tid < 64) { float* a16 = (float*)(P.ws + WS_A16) + (size_t)(item * 64 + tid) * 4; a16[0] = apw[(16 * 64 + tid) * 2]; a16[1] = apw[(16 * 64 + tid) * 2 + 1];
        const int gp = (l * SSM_G + g) * SSM_P + tid; const double lr = P.lam_re[gp], li = P.lam_im[gp]; const double mag = exp(lr * dt * 512.0); double sn, cs; sincos(li * dt * 512.0, &sn, &cs);
        a16[2] = (float)(mag * cs); a16[3] = (float)(mag * sn); }
    __syncthreads();
}
__device__ __forceinline__ void phase_ssm_consts(const Params& P, LAS unsigned char* lds, int vcu, int G) {
    for (int it = vcu; it < DEPTH * SSM_G; it += G) ssm_consts_item(P, lds, it);
}
__device__ __forceinline__ float gelu_tanh_fast(float x) {
    const float u = 0.7978845608028654f * (x + 0.044715f * x * x * x); return x * __builtin_amdgcn_rcpf(1.f + __expf(-2.f * u)); }

constexpr int SSM_EH = 0, SSM_EHP = 272, SSM_WX = 69632, SSM_KJ = SSM_WX + 65536, SSM_CHS = SSM_KJ + 9216;
static_assert(SSM_CHS + 4096 <= LDSCTL_OFF, "ssm lds map");
__device__ __forceinline__ void ssm_item(const Params& P, int layer, LAS unsigned char* lds, int item) {
    const int tid = opaque_tid(), lane = tid & 63, wave = __builtin_amdgcn_readfirstlane(tid >> 6);
    const int g = item >> 3, b = item & 7;
    const bf16_t* Z = (const bf16_t*)(P.ws + WS_Z); bf16_t* Y2 = (bf16_t*)(P.ws + WS_Y2);
    const unsigned char* cbase = P.ws + WS_SSMP + (size_t)(layer * SSM_G + g) * SSMC_STRIDE;
    const int nl = lane & 31, hh = lane >> 5;
    typedef float f32x2v __attribute__((ext_vector_type(2)));
#pragma unroll
    for (int i = 0; i < 8; ++i) { const int f = wave * 8 + i;
        __builtin_amdgcn_global_load_lds((const unsigned*)(cbase + SSMC_WE + f * 1024 + lane * 16), (LAS unsigned*)(lds + SSM_WX + f * 1024), 16, 0, 0); }
    __builtin_amdgcn_global_load_lds((const unsigned*)(cbase + SSMC_KJ + wave * 1024 + lane * 16), (LAS unsigned*)(lds + SSM_KJ + wave * 1024), 16, 0, 0);
    if (wave == 0) __builtin_amdgcn_global_load_lds((const unsigned*)(cbase + SSMC_KJ + 8192 + lane * 16), (LAS unsigned*)(lds + SSM_KJ + 8192), 16, 0, 0);
    const int n = 32 * wave + nl;
    const bf16_t* up = Z + (size_t)(b * SEQ + 16 * n) * IN_W + ZU + g * SSM_CH + 8 * hh;
    f16x8 uf[16];
#pragma unroll
    for (int sx = 0; sx < 16; ++sx) uf[sx] = *(const f16x8*)(up + (size_t)sx * IN_W);
    const float* a16p = (const float*)(P.ws + WS_A16) + (size_t)((layer * SSM_G + g) * 64 + lane) * 4;
    const float a16r = a16p[0], a16i = a16p[1], a5r = a16p[2], a5i = a16p[3];
    asm volatile("s_waitcnt vmcnt(0)" ::: "memory");
    __syncthreads();
    {
        f32x16 ae[4] = {};
#pragma unroll
        for (int sx = 0; sx < 16; ++sx) {
#pragma unroll
            for (int mt = 0; mt < 4; ++mt) ae[mt] = __builtin_amdgcn_mfma_f32_32x32x16_f16(*(const LAS f16x8*)(lds + SSM_WX + ((mt * 16 + sx) * 64 + lane) * 16), uf[sx], ae[mt], 0, 0, 0);
            if ((sx & 1) == 1) asm volatile("" ::: "memory"); }
#pragma unroll
        for (int mt = 0; mt < 4; ++mt)
#pragma unroll
            for (int r = 0; r < 16; r += 2) { const int p = 16 * mt + (crow(r, hh) >> 1);
                *(LAS unsigned*)(lds + SSM_EH + n * SSM_EHP + 4 * p) = pg8::pk_f16(ae[mt][r], ae[mt][r + 1]); }
    }
    __syncthreads();
#pragma unroll
    for (int i = 0; i < 8; ++i) { const int f = wave * 8 + i;
        __builtin_amdgcn_global_load_lds((const unsigned*)(cbase + SSMC_WC + f * 1024 + lane * 16), (LAS unsigned*)(lds + SSM_WX + f * 1024), 16, 0, 0); }
    {
        LAS unsigned char* eh = lds + SSM_EH + (32 * wave) * SSM_EHP + 4 * lane;
        float sr = 0.f, si = 0.f;
#pragma unroll 8
        for (int k = 0; k < 32; ++k) { const unsigned ev = *(const LAS unsigned*)(eh + k * SSM_EHP); const float er = pg8::h_lo(ev), ei = pg8::h_hi(ev);
            const float nr = a16r * sr - a16i * si + er, ni = a16r * si + a16i * sr + ei; sr = nr; si = ni; }
        LAS f32x2v* chs = (LAS f32x2v*)(lds + SSM_CHS);
        chs[wave * 64 + lane] = (f32x2v){sr, si};
        __syncthreads();
        float cr = 0.f, ci = 0.f;
        for (int v = 0; v < wave; ++v) { const f32x2v sv = chs[v * 64 + lane]; const float nr = a5r * cr - a5i * ci + sv.x, ni = a5r * ci + a5i * cr + sv.y; cr = nr; ci = ni; }
        sr = cr; si = ci;
#pragma unroll 8
        for (int k = 0; k < 32; ++k) { const unsigned ev = *(const LAS unsigned*)(eh + k * SSM_EHP); const float er = pg8::h_lo(ev), ei = pg8::h_hi(ev);
            *(LAS unsigned*)(eh + k * SSM_EHP) = pg8::pk_f16(sr, si);
            const float nr = a16r * sr - a16i * si + er, ni = a16r * si + a16i * sr + ei; sr = nr; si = ni; }
    }
    asm volatile("s_waitcnt vmcnt(0)" ::: "memory");
    __syncthreads();
    const int rhi = nl >> 4, co = nl & 15;
    const LAS unsigned char* kjl = lds + SSM_KJ + co * 32 + hh * 16;
#pragma unroll
    for (int mh = 0; mh < 2; ++mh) {
        f32x16 ay[4] = {};
#pragma unroll
        for (int sx = 0; sx < 16; ++sx) {
#pragma unroll
            for (int i = 0; i < 4; ++i) { const int mt = 4 * mh + i; const int lag0 = 2 * mt - sx;
                if (lag0 + 1 >= 0) { const int lag = lag0 + rhi; const int row = (lag0 >= 0) ? lag : (rhi ? 0 : 16);
                    ay[i] = __builtin_amdgcn_mfma_f32_32x32x16_f16(*(const LAS f16x8*)(kjl + row * 512), uf[sx], ay[i], 0, 0, 0); } }
            if ((sx & 1) == 1) asm volatile("" ::: "memory"); }
#pragma unroll
        for (int kc = 0; kc < 8; ++kc) { const f16x8 hfr = *(const LAS f16x8*)(lds + SSM_EH + n * SSM_EHP + 32 * kc + 16 * hh);
#pragma unroll
            for (int i = 0; i < 4; ++i) { const int mt = 4 * mh + i;
                ay[i] = __builtin_amdgcn_mfma_f32_32x32x16_f16(*(const LAS f16x8*)(lds + SSM_WX + ((mt * 8 + kc) * 64 + lane) * 16), hfr, ay[i], 0, 0, 0); }
            if ((kc & 1) == 1) asm volatile("" ::: "memory"); }
#pragma unroll
        for (int i = 0; i < 4; ++i) { const int mt = 4 * mh + i;
#pragma unroll
            for (int q = 0; q < 4; ++q) { const int t = 2 * mt + (q >> 1), co0 = 8 * (q & 1) + 4 * hh;
                pg8::u32x2 w; w.x = pg8::pk_f16(gelu_tanh_fast(ay[i][4 * q]), gelu_tanh_fast(ay[i][4 * q + 1])); w.y = pg8::pk_f16(gelu_tanh_fast(ay[i][4 * q + 2]), gelu_tanh_fast(ay[i][4 * q + 3]));
                *(pg8::u32x2*)(Y2 + (size_t)(b * SEQ + 16 * n + t) * SSM_W + g * SSM_CH + co0) = w; } }
    }
    __syncthreads();
}
__device__ __forceinline__ void phase_ssm(const Params& P, int layer, LAS unsigned char* lds, int vcu, int G) {
    for (int it = vcu; it < SSM_G * BATCH; it += G) ssm_item(P, layer, lds, it);
}


#define XB_TMO      128
#define XB_XCNT(j)  (256  + 64 * (j))
#define XB_XSUB(j)  (1280 + 64 * (j))
#define XB_XGEN(j)  (2304 + 64 * (j))
#define XB_TOP      3328
#define XB_TOPGEN   3392
#define XCD_BAR_WORDS 3456
#define XB_SPIN_CAP (1u << 18)
__device__ __forceinline__ unsigned xb_ld(unsigned* p)              { return __hip_atomic_load(p, __ATOMIC_RELAXED, __HIP_MEMORY_SCOPE_AGENT); }
__device__ __forceinline__ unsigned xb_add(unsigned* p, unsigned v) { return __hip_atomic_fetch_add(p, v, __ATOMIC_RELAXED, __HIP_MEMORY_SCOPE_AGENT); }
__device__ __forceinline__ unsigned xb_xcc_id() { return (unsigned)__builtin_amdgcn_s_getreg((3 << 11) | 20) & 0xFu; }
#define XB_SPIN(cond, bar) do { unsigned _sp = 0; while (cond) { __builtin_amdgcn_s_sleep(1); \
    if ((++_sp & 255u) == 0u) { if (xb_ld(&(bar)[XB_TMO])) break; if (_sp > XB_SPIN_CAP) { atomicAdd(&(bar)[XB_TMO], 1u); break; } } } } while (0)
struct XcdBarrier { unsigned* bar; unsigned x; volatile LAS unsigned* st; };
__device__ __forceinline__ XcdBarrier xcd_barrier_post(unsigned* bar, volatile LAS unsigned* st) {
    XcdBarrier b; b.bar = bar; b.x = xb_xcc_id(); b.st = st;
    if (threadIdx.x == 0) (void)xb_add(&bar[XB_XCNT(b.x)], 1u);
    return b;
}
__device__ __forceinline__ void xcd_barrier_complete(unsigned* bar, unsigned x, unsigned& nloc, unsigned& nx) {
    const unsigned G = gridDim.x * gridDim.y * gridDim.z;
    unsigned sum, cnt, mine, sp = 0u;
    for (;;) {
        sum = 0u; cnt = 0u; mine = 0u;
#pragma unroll
        for (unsigned j = 0; j < 16; ++j) { const unsigned c = xb_ld(&bar[XB_XCNT(j)]); sum += c; cnt += (c > 0u) ? 1u : 0u; mine = (j == x) ? c : mine; }
        if (sum == G) break;
        __builtin_amdgcn_s_sleep(1);
        if ((++sp & 255u) == 0u) { if (xb_ld(&bar[XB_TMO])) break; if (sp > XB_SPIN_CAP) { atomicAdd(&bar[XB_TMO], 1u); break; } }
    }
    nloc = mine > 0u ? mine : 1u; nx = cnt > 0u ? cnt : 1u;
}
__device__ __forceinline__ void xcd_barrier(const XcdBarrier& b) {
    asm volatile("s_waitcnt vmcnt(0)" ::: "memory");
    __syncthreads();
    if (threadIdx.x == 0) {
        unsigned* bar = b.bar;
        __builtin_amdgcn_s_waitcnt(0);
        unsigned nloc = b.st[0], nx = b.st[1];
        if (nloc == 0u) { xcd_barrier_complete(bar, b.x, nloc, nx); b.st[0] = nloc; b.st[1] = nx; }
        const unsigned old = xb_add(&bar[XB_XSUB(b.x)], 1u);
        const unsigned gen = old / nloc;
        if (old + 1u == (gen + 1u) * nloc) {
            __builtin_amdgcn_fence(__ATOMIC_RELEASE, "agent");
            asm volatile("s_waitcnt vmcnt(0)" ::: "memory");
            const unsigned og = xb_add(&bar[XB_TOP], 1u);
            const unsigned tg = og / nx;
            if (og + 1u == (tg + 1u) * nx) xb_add(&bar[XB_TOPGEN], 1u);
            else XB_SPIN(xb_ld(&bar[XB_TOPGEN]) == tg, bar);
            __builtin_amdgcn_fence(__ATOMIC_ACQUIRE, "agent");
            xb_add(&bar[XB_XGEN(b.x)], 1u);
            asm volatile("s_waitcnt vmcnt(0)" ::: "memory");
        } else {
            XB_SPIN(xb_ld(&bar[XB_XGEN(b.x)]) == gen, bar);
            __builtin_amdgcn_fence(__ATOMIC_ACQUIRE, "agent");
            asm volatile("s_waitcnt vmcnt(0)" ::: "memory");
        }
    }
    __syncthreads();
}
constexpr size_t WS_CTL = WS_MISC + 512 * 1024;
constexpr int CTL_BYTES = 16384;

template <class Sched> __device__ __forceinline__ LAS float* inproj_rstd_to_lds(const Params& P, LAS unsigned char* lds, const Sched& S) {
    LAS float* rl = (LAS float*)(lds + 131072);
    const int tid = opaque_tid(); const float* sumsq = (const float*)(P.ws + WS_SUMSQ); pg8::Unit u;
    for (int i = tid >> 8; S.next(i, u); i += 2) { const int r = u.pm * 256 + (tid & 255);
        const f32x4* sp = (const f32x4*)(sumsq + (size_t)r * 16); const f32x4 s0 = sp[0], s1 = sp[1], s2 = sp[2], s3 = sp[3];
        const float ss = ((s0[0] + s0[1]) + (s0[2] + s0[3])) + ((s1[0] + s1[1]) + (s1[2] + s1[3])) + ((s2[0] + s2[1]) + (s2[2] + s2[3])) + ((s3[0] + s3[1]) + (s3[2] + s3[3]));
        rl[i * 256 + (tid & 255)] = rsqrtf(ss * (1.f / D_MODEL) + EPS); }
    asm volatile("s_waitcnt vmcnt(0) lgkmcnt(0)" ::: "memory"); __syncthreads();
    return rl;
}
constexpr int DEFER_TILE = 8;
__device__ __forceinline__ bool defer_mode(int layer, int G) { return layer > 0 && G == 256; }
__device__ __forceinline__ void run_inproj(const Params& P, int layer, LAS unsigned char* lds, int G, int bx) {
    unsigned char* ws = P.ws;
    pg8::Gemm g{(const bf16_t*)(ws + WS_XB), (const bf16_t*)(ws + WS_WIN) + (size_t)layer * IN_W * D_MODEL, MTOK, IN_W, D_MODEL};
    if (defer_mode(layer, G)) { pg8::SkipOrder S; S.init2(g.M, g.N, G, bx, DEFER_TILE); LAS float* rl = inproj_rstd_to_lds(P, lds, S);
        pg8::EpiZ E{(bf16_t*)(ws + WS_Z), rl, (const bf16_t*)(ws + WS_ROPE), P.q_norm_g + layer * HD, P.k_norm_g + layer * HD}; pg8::gemm_phase<pg8::EpiZ, pg8::SkipOrder, true>(lds, g, S, E); }
    else { pg8::StaticOrder S; S.init(g.M, g.N, G, bx); LAS float* rl = inproj_rstd_to_lds(P, lds, S);
        pg8::EpiZ E{(bf16_t*)(ws + WS_Z), rl, (const bf16_t*)(ws + WS_ROPE), P.q_norm_g + layer * HD, P.k_norm_g + layer * HD}; pg8::gemm_phase<pg8::EpiZ, pg8::StaticOrder, true>(lds, g, S, E); }
}
__device__ __forceinline__ void run_inproj_tail(const Params& P, int layer, LAS unsigned char* lds, int G, int bx) {
    if (!defer_mode(layer, G)) return;
    unsigned char* ws = P.ws;
    pg8::Gemm g{(const bf16_t*)(ws + WS_XB), (const bf16_t*)(ws + WS_WIN) + (size_t)layer * IN_W * D_MODEL, MTOK, IN_W, D_MODEL};
    pg8::DeferOrder S; S.init(g.M, G, bx, DEFER_TILE); LAS float* rl = inproj_rstd_to_lds(P, lds, S);
    pg8::EpiZ E{(bf16_t*)(ws + WS_Z), rl, (const bf16_t*)(ws + WS_ROPE), P.q_norm_g + layer * HD, P.k_norm_g + layer * HD};
    pg8::gemm_phase<pg8::EpiZ, pg8::DeferOrder, true>(lds, g, S, E);
}
__device__ __forceinline__ void run_glu(const Params& P, int layer, LAS unsigned char* lds, int G, int bx) {
    unsigned char* ws = P.ws;
    pg8::Gemm g{(const bf16_t*)(ws + WS_Y2), (const bf16_t*)(ws + WS_WGLU) + (size_t)layer * SSM_W * SSM_W, MTOK, SSM_W, SSM_W}; pg8::StaticOrder S; S.init(g.M, g.N, G, bx);
    pg8::EpiGlu E{(const bf16_t*)(ws + WS_Y2), (const bf16_t*)(ws + WS_Z), P.b_glu + layer * SSM_W, (bf16_t*)(ws + WS_MIX)};
    pg8::gemm_phase<pg8::EpiGlu, pg8::StaticOrder, true>(lds, g, S, E);
}
__device__ __forceinline__ void run_outproj(const Params& P, int layer, LAS unsigned char* lds, int G, int bx) {
    unsigned char* ws = P.ws;
    pg8::Gemm g{(const bf16_t*)(ws + WS_MIX), (const bf16_t*)(ws + WS_WOUT) + (size_t)layer * D_MODEL * MIX_W, MTOK, D_MODEL, MIX_W}; pg8::StaticOrder S; S.init(g.M, g.N, G, bx);
    if (layer == 0) { pg8::EpiOut<0> E{P.x, P.out, (bf16_t*)(ws + WS_XB), (float*)(ws + WS_SUMSQ)}; pg8::gemm_phase<pg8::EpiOut<0>, pg8::StaticOrder, true>(lds, g, S, E); }
    else if (layer + 1 < DEPTH) { pg8::EpiOut<1> E{P.x, P.out, (bf16_t*)(ws + WS_XB), (float*)(ws + WS_SUMSQ)}; pg8::gemm_phase<pg8::EpiOut<1>, pg8::StaticOrder, true>(lds, g, S, E); }
    else { pg8::EpiOut<2> E{P.x, P.out, (bf16_t*)(ws + WS_XB), (float*)(ws + WS_SUMSQ)}; pg8::gemm_phase<pg8::EpiOut<2>, pg8::StaticOrder, true>(lds, g, S, E); }
}
__device__ __forceinline__ void run_memgemm(const Params& P, LAS unsigned char* lds, int G, int bx) {
    unsigned char* ws = P.ws;
    pg8::Gemm g{(const bf16_t*)(ws + WS_MEMB), (const bf16_t*)(ws + WS_WMEM), BATCH * N_MEM, DEPTH * 1024, D_MODEL}; pg8::MemTailOrder S; S.init(g.M, g.N, G, bx, ((MTOK / 256) * (IN_W / 256)) % G);
    pg8::EpiMemF32 E{(float*)(ws + WS_Y2), DEPTH * 1024, (const float*)(ws + WS_MISC)};
    pg8::gemm_phase<pg8::EpiMemF32, pg8::MemTailOrder, true>(lds, g, S, E);
}


template <class T> __device__ __forceinline__ T* as_global(unsigned long long v) { return (T*)(__attribute__((address_space(1))) T*)v; }
__device__ __forceinline__ Params load_params() {
    typedef const volatile unsigned long long __attribute__((address_space(4)))* kp_t;
    kp_t kp = (kp_t)__builtin_amdgcn_kernarg_segment_ptr();
    Params q;
    q.x = as_global<const float>(kp[0]); q.mem = as_global<const float>(kp[1]); q.pos = as_global<const int>(kp[2]); q.norm_g = as_global<const float>(kp[3]);
    q.w_in = as_global<const float>(kp[4]); q.q_norm_g = as_global<const float>(kp[5]); q.k_norm_g = as_global<const float>(kp[6]); q.sinks = as_global<const float>(kp[7]);
    q.lam_re = as_global<const float>(kp[8]); q.lam_im = as_global<const float>(kp[9]); q.log_dt = as_global<const float>(kp[10]); q.b_re = as_global<const float>(kp[11]);
    q.b_im = as_global<const float>(kp[12]); q.c_re = as_global<const float>(kp[13]); q.c_im = as_global<const float>(kp[14]); q.d_skip = as_global<const float>(kp[15]);
    q.w_glu = as_global<const float>(kp[16]); q.b_glu = as_global<const float>(kp[17]); q.mem_norm_g = as_global<const float>(kp[18]); q.w_mem_kv = as_global<const float>(kp[19]);
    q.xq_norm_g = as_global<const float>(kp[20]); q.xk_norm_g = as_global<const float>(kp[21]); q.w_out = as_global<const float>(kp[22]);
    q.out = as_global<float>(kp[23]); q.ws = as_global<unsigned char>(kp[24]);
    return q;
}
static_assert(sizeof(Params) == 25 * 8, "Params is 25 pointers");
__global__ void __launch_bounds__(NTHREADS, 2) k_mega(Params Parg) {
    extern __shared__ __attribute__((aligned(16))) unsigned char lds_raw[];
    LAS unsigned char* lds = (LAS unsigned char*)lds_raw;
    const int G = gridDim.x, bx = blockIdx.x; const int vcu = (G % 8 == 0) ? (bx % 8) * (G / 8) + bx / 8 : bx;
    for (int u = threadIdx.x; u < (LDS_BYTES - LDSCTL_OFF) / 4; u += NTHREADS) ((LAS unsigned*)(lds + LDSCTL_OFF))[u] = 0u;
    __syncthreads();
    (void)xcd_barrier_post((unsigned*)(Parg.ws + WS_CTL), (volatile LAS unsigned*)(lds + LDSCTL_OFF));
#define GRID_BARRIER() do { XcdBarrier bar_; { const Params Pb = load_params(); bar_.bar = (unsigned*)(Pb.ws + WS_CTL); } unsigned xq_ = xb_xcc_id(); asm volatile("" : "+s"(xq_)); bar_.x = xq_; bar_.st = (volatile LAS unsigned*)(lds + LDSCTL_OFF); xcd_barrier(bar_); } while (0)
    { const Params P = load_params(); phase_prep(P, lds, vcu, G); } __syncthreads();
    { const Params P = load_params(); phase_ssm_consts(P, lds, vcu, G); }
    GRID_BARRIER();
    { const Params P = load_params(); run_inproj(P, 0, lds, G, bx); }
    { const Params P = load_params(); run_memgemm(P, lds, G, bx); }
    GRID_BARRIER();
    { const Params P = load_params(); phase_memfin(P, vcu, G); }
    GRID_BARRIER();
#pragma unroll 1
    for (int layer = 0; layer < DEPTH; ++layer) {
        { const Params P = load_params(); run_inproj_tail(P, layer, lds, G, bx); }
        { const Params P = load_params(); phase_attn_a(P, layer, lds, vcu, G, bx, defer_mode(layer, G)); }
        { const Params P = load_params(); phase_attn_c(P, layer, lds, vcu, G); }
        { const Params P = load_params(); phase_ssm(P, layer, lds, vcu, G); }
        GRID_BARRIER();
        { const Params P = load_params(); run_glu(P, layer, lds, G, bx); }
        GRID_BARRIER();
        { const Params P = load_params(); run_outproj(P, layer, lds, G, bx); }
        if (layer + 1 < DEPTH) { GRID_BARRIER(); { const Params P = load_params(); run_inproj(P, layer + 1, lds, G, bx); } GRID_BARRIER(); }
    }
}

extern "C" void kernel_launch(void* const* d_in, const int* in_sizes, int n_in, void* d_out, int out_size, void* d_ws, size_t ws_size, hipStream_t stream) {
    if (ws_size < WS_END || n_in != 23) return;
    Params P{};
    P.x = (const float*)d_in[0]; P.mem = (const float*)d_in[1]; P.pos = (const int*)d_in[2]; P.norm_g = (const float*)d_in[3]; P.w_in = (const float*)d_in[4];
    P.q_norm_g = (const float*)d_in[5]; P.k_norm_g = (const float*)d_in[6]; P.sinks = (const float*)d_in[7]; P.lam_re = (const float*)d_in[8]; P.lam_im = (const float*)d_in[9];
    P.log_dt = (const float*)d_in[10]; P.b_re = (const float*)d_in[11]; P.b_im = (const float*)d_in[12]; P.c_re = (const float*)d_in[13]; P.c_im = (const float*)d_in[14];
    P.d_skip = (const float*)d_in[15]; P.w_glu = (const float*)d_in[16]; P.b_glu = (const float*)d_in[17]; P.mem_norm_g = (const float*)d_in[18]; P.w_mem_kv = (const float*)d_in[19];
    P.xq_norm_g = (const float*)d_in[20]; P.xk_norm_g = (const float*)d_in[21]; P.w_out = (const float*)d_in[22];
    P.out = (float*)d_out; P.ws = (unsigned char*)d_ws;
    static int coop_grid = 0;
    if (coop_grid == 0) {
        int dev = 0, cus = 0, per_cu = 0; hipGetDevice(&dev); hipDeviceGetAttribute(&cus, hipDeviceAttributeMultiprocessorCount, dev);
        (void)hipFuncSetAttribute((const void*)k_mega, hipFuncAttributeMaxDynamicSharedMemorySize, LDS_BYTES);
        if (hipOccupancyMaxActiveBlocksPerMultiprocessor(&per_cu, (const void*)k_mega, NTHREADS, LDS_BYTES) != hipSuccess || per_cu < 1) { fprintf(stderr, "kernel_launch: occupancy query says %d blocks/CU\n", per_cu); (void)hipGetLastError(); per_cu = 1; }
        if (per_cu > 1) per_cu = 1;
        coop_grid = (cus > 0 ? cus : 256) * per_cu;
    }
    (void)hipMemsetAsync((char*)d_ws + WS_CTL, 0, CTL_BYTES, stream);
    { void* args[] = {(void*)&P}; hipError_t e = hipLaunchCooperativeKernel((const void*)k_mega, dim3(coop_grid), dim3(NTHREADS), args, LDS_BYTES, stream);
      if (e != hipSuccess) fprintf(stderr, "cooperative launch failed: %s (grid %d)\n", hipGetErrorString(e), coop_grid); }
}
```

```cpp
#include <hip/hip_runtime.h>
#include <cstdio>
#include <stdint.h>
#include <math.h>

constexpr int D_MODEL = 1024, BATCH = 8, SEQ = 4096, DEPTH = 4, MTOK = BATCH * SEQ;
constexpr int HD = 64, NQH = 8, NKVH = 2, WINDOW = 128;
constexpr int SSM_CH = 16, SSM_G = 32, SSM_P = 64, SSM_W = 512, N_MEM = 256, XH = 4, XHD = 128;
constexpr int MIX_W = 1536, IN_W = 3328;
constexpr int ZQ = 0, ZK = 512, ZV = 640, ZG = 768, ZU = 1280, ZSG = 1792, ZXQ = 2304, ZXG = 2816;
constexpr float EPS = 1e-6f;

typedef unsigned short bf16_t;
__device__ __forceinline__ bf16_t f2bf(float f) { _Float16 h = (_Float16)f; return __builtin_bit_cast(unsigned short, h); }
__device__ __forceinline__ float bf2f(bf16_t h) { return (float)__builtin_bit_cast(_Float16, h); }
__device__ __forceinline__ float sigmoidf_(float x) { return __builtin_amdgcn_rcpf(1.f + __expf(-x)); }
__device__ __forceinline__ float siluf_(float x) { return x * sigmoidf_(x); }
__device__ __forceinline__ float gelu_tanh(float x) { const float c = 0.7978845608028654f; float u = c * (x + 0.044715f * x * x * x); return 0.5f * x * (1.f + tanhf(u)); }
__device__ __forceinline__ float wave_sum(float v) {
#pragma unroll
    for (int o = 1; o < 64; o <<= 1) v += __shfl_xor(v, o);
    return v;
}

constexpr size_t MiB = 1u << 20;
constexpr size_t WS_Z = 0;
constexpr size_t WS_MIX = 208 * MiB;
constexpr size_t WS_XB = 304 * MiB;
constexpr size_t WS_Y2 = 368 * MiB;
constexpr size_t WS_WIN = 400 * MiB;
constexpr size_t WS_WOUT = 426 * MiB;
constexpr size_t WS_WGLU = 438 * MiB;
constexpr size_t WS_WMEM = 440 * MiB;
constexpr size_t WS_MEMB = 448 * MiB;
constexpr size_t WS_MK = 452 * MiB;
constexpr size_t WS_MV = 460 * MiB;
constexpr size_t WS_ROPE = 468 * MiB;
constexpr size_t WS_SSMP = 476 * MiB;
constexpr size_t WS_SUMSQ = 508 * MiB;
constexpr size_t WS_MISC = 510 * MiB;
constexpr size_t WS_END = 511 * MiB;


namespace pg8 {
#define PG8_LAS __attribute__((address_space(3)))
typedef _Float16 f16x8 __attribute__((ext_vector_type(8)));
typedef _Float16 f16x2 __attribute__((ext_vector_type(2)));
typedef float f32x4 __attribute__((ext_vector_type(4)));
typedef unsigned u32x4 __attribute__((ext_vector_type(4)));
typedef unsigned u32x2 __attribute__((ext_vector_type(2)));
constexpr int BM = 256, BK = 64, HALF = 128, HTB = HALF * BK * 2, STAGE_BYTES = 8 * HTB, NXCD = 8, WGM = 8;
__host__ __device__ __forceinline__ int lds_byte(int r, int c) { const int st = (r >> 4) * 2 + (c >> 5), rr = r & 15, cc = c & 31, ob = rr * 64 + cc * 2; return st * 1024 + (ob ^ (((ob >> 9) & 1) << 5)); }
__host__ __device__ __forceinline__ void stage_rc(int b, int& R, int& C) { const int st = b / 1024, sb = b % 1024, swz = sb ^ (((sb >> 9) & 1) << 5); R = (st >> 1) * 16 + swz / 64; C = (st & 1) * 32 + (swz % 64) / 2; }
__host__ __device__ __forceinline__ int perm32(int rho) { const int n = rho >> 4, i = rho & 15; return 8 * (i >> 2) + 4 * n + (i & 3); }
struct Unit { int pm, pn, c0, half, idx; };
struct Gemm { const bf16_t* A; const bf16_t* Bt; int M, N, K; };
struct StaticOrder {
    int nM, nN, nwg, G, c;
    __host__ __device__ void init(int M, int N, int G_, int c_) { nM = M / BM; nN = N / BM; nwg = nM * nN; G = G_; c = c_; }
    __host__ __device__ bool next(int i, Unit& u) const {
        const long L = (long)i * G + c; if (L >= nwg) return false;
        int wgid = (int)L; { const int q = nwg / NXCD, r = nwg % NXCD, xcd = wgid % NXCD, off = wgid / NXCD; wgid = (xcd < r ? xcd * (q + 1) : r * (q + 1) + (xcd - r) * q) + off; }
        const int nig = WGM * nN, gid = wgid / nig, fm = gid * WGM, gsz = (nM - fm) < WGM ? (nM - fm) : WGM;
        u.pm = fm + ((wgid % nig) % gsz); u.pn = (wgid % nig) / gsz; u.c0 = u.pn * BM; u.half = 0; u.idx = i; return true;
    }
    __device__ __forceinline__ void a_ready(const Unit&) const {}
    __device__ __forceinline__ void done(const Unit&) const {}
};
struct TailOrder : StaticOrder {
    __host__ __device__ bool next(int i, Unit& u) const {
        const int full = nwg / G, left = nwg - full * G;
        if (i < full || 2 * left > G) return StaticOrder::next(i, u);
        if (i > full || c >= 2 * left) return false;
        StaticOrder t = *this; t.c = c >> 1;
        (void)t.StaticOrder::next(full, u);
        u.c0 += 128 * (c & 1); u.half = 1; u.idx = i; return true;
    }
};
struct SkipOrder : StaticOrder {
    int skip;
    __host__ __device__ void init2(int M, int N, int G_, int c_, int skip_) { init(M, N - BM, G_, c_); skip = skip_; }
    __host__ __device__ bool next(int i, Unit& u) const { if (!StaticOrder::next(i, u)) return false; if (u.pn >= skip) { u.pn += 1; u.c0 = u.pn * BM; } return true; }
};
struct DeferOrder {
    int nM, pn, G, c;
    __host__ __device__ void init(int M, int G_, int c_, int pn_) { nM = M / BM; G = G_; c = c_; pn = pn_; }
    __host__ __device__ bool next(int i, Unit& u) const { const int L = i * G + c; if (L >= nM) return false; u.pm = L; u.pn = pn; u.c0 = pn * BM; u.half = 0; u.idx = i; return true; }
    __device__ __forceinline__ void a_ready(const Unit&) const {}
    __device__ __forceinline__ void done(const Unit&) const {}
};
struct MemTailOrder {
    int k, stride, nM, nwg;
    __host__ __device__ void init(int M, int N, int G, int c, int first) { nM = M / BM; nwg = nM * (N / BM); k = c - first; stride = G - first; }
    __host__ __device__ bool next(int i, Unit& u) const {
        if (k < 0) return false;
        const int L = i * stride + k; if (L >= nwg) return false;
        u.pm = L % nM; u.pn = L / nM; u.c0 = u.pn * BM; u.half = 0; u.idx = i; return true;
    }
    __device__ __forceinline__ void a_ready(const Unit&) const {}
    __device__ __forceinline__ void done(const Unit&) const {}
};
struct ARowMajor {
    __device__ static __forceinline__ unsigned voff(int R, int C, int K) { return (unsigned)(R * K + C) * 2u; }
    __device__ static __forceinline__ size_t kstep(int) { return (size_t)(BK * 2); }
    __device__ static __forceinline__ size_t hstep(int K) { return (size_t)HALF * K * 2; }
    __device__ static __forceinline__ size_t base(int pm, int K) { return (size_t)pm * 2 * HALF * K * 2; }
};
struct AGroupMajor {
    __device__ static __forceinline__ unsigned voff(int R, int C, int) { return (unsigned)((C >> 4) * (MTOK * 32) + R * 32 + (C & 15) * 2); }
    __device__ static __forceinline__ size_t kstep(int) { return (size_t)4 * MTOK * 32; }
    __device__ static __forceinline__ size_t hstep(int) { return (size_t)HALF * 32; }
    __device__ static __forceinline__ size_t base(int pm, int) { return (size_t)pm * 256 * 32; }
};
__device__ __forceinline__ size_t gm_off(int row, int c) { return ((size_t)(c >> 4) * MTOK + row) * 16 + (c & 15); }
__device__ __forceinline__ unsigned pk_f16(float lo, float hi) { f16x2 v = {(_Float16)lo, (_Float16)hi}; return __builtin_bit_cast(unsigned, v); }
__device__ __forceinline__ float h_lo(unsigned w) { return (float)__builtin_bit_cast(_Float16, (unsigned short)(w & 0xffffu)); }
__device__ __forceinline__ float h_hi(unsigned w) { return (float)__builtin_bit_cast(_Float16, (unsigned short)(w >> 16)); }

struct EpiZ {
    static constexpr bool PERM = true, AFTER_DRAIN = false;
    bf16_t* Z; const PG8_LAS float* rstd_lds; const bf16_t* rope; const float* qg; const float* kg;
    __device__ __forceinline__ void operator()(const f32x4 (&acc)[2][2][4][2], const Unit& u, int wr, int wc, int fr, int fq) const {
        const int row0 = u.pm * BM + wr * 64 + fr, cw = u.c0 + wc * 64, col0 = cw + 8 * fq;
        const bool is_q = cw < ZK, is_k = (cw >= ZK) && (cw < ZV), is_gate = (cw >= ZG && cw < ZU) || (cw >= ZSG && cw < ZXQ) || (cw >= ZXG);
        f32x4 g0a = {1.f, 1.f, 1.f, 1.f}, g0b = g0a, g1a = g0a, g1b = g0a; float qs = 1.f;
        if (is_q || is_k) { const float* g = is_q ? qg : kg; g0a = *(const f32x4*)(g + 8 * fq); g0b = *(const f32x4*)(g + 8 * fq + 4); g1a = *(const f32x4*)(g + 32 + 8 * fq); g1b = *(const f32x4*)(g + 36 + 8 * fq);
            if (is_q) qs = 0.125f * 1.4426950408889634f; }
#pragma unroll
        for (int ai = 0; ai < 2; ++ai)
#pragma unroll
            for (int m = 0; m < 4; ++m) { const int r = row0 + ai * HALF + m * 16;
                const float rs = rstd_lds[u.idx * 256 + wr * 64 + ai * HALF + m * 16 + fr];
                f32x4 a0 = acc[ai][0][m][0] * rs, a1 = acc[ai][0][m][1] * rs, b0 = acc[ai][1][m][0] * rs, b1 = acc[ai][1][m][1] * rs;
                if (is_q || is_k) {
                    float hs = ((a0[0] * a0[0] + a0[1] * a0[1]) + (a0[2] * a0[2] + a0[3] * a0[3])) + ((a1[0] * a1[0] + a1[1] * a1[1]) + (a1[2] * a1[2] + a1[3] * a1[3]))
                             + ((b0[0] * b0[0] + b0[1] * b0[1]) + (b0[2] * b0[2] + b0[3] * b0[3])) + ((b1[0] * b1[0] + b1[1] * b1[1]) + (b1[2] * b1[2] + b1[3] * b1[3]));
                    hs += __shfl_xor(hs, 16); hs += __shfl_xor(hs, 32);
                    const float rn = rsqrtf(hs * (1.f / HD) + EPS);
                    const u32x4 cv = *(const u32x4*)(rope + (size_t)r * 64 + 8 * fq), sv = *(const u32x4*)(rope + (size_t)r * 64 + 32 + 8 * fq);
                    a0 = a0 * g0a * rn; a1 = a1 * g0b * rn; b0 = b0 * g1a * rn; b1 = b1 * g1b * rn;
                    const f32x4 c0 = {h_lo(cv.x), h_hi(cv.x), h_lo(cv.y), h_hi(cv.y)}, c1 = {h_lo(cv.z), h_hi(cv.z), h_lo(cv.w), h_hi(cv.w)};
                    const f32x4 n0 = {h_lo(sv.x), h_hi(sv.x), h_lo(sv.y), h_hi(sv.y)}, n1 = {h_lo(sv.z), h_hi(sv.z), h_lo(sv.w), h_hi(sv.w)};
                    const f32x4 ra0 = (a0 * c0 - b0 * n0) * qs, ra1 = (a1 * c1 - b1 * n1) * qs, rb0 = (b0 * c0 + a0 * n0) * qs, rb1 = (b1 * c1 + a1 * n1) * qs;
                    a0 = ra0; a1 = ra1; b0 = rb0; b1 = rb1;
                } else if (is_gate) {
#pragma unroll
                    for (int j = 0; j < 4; ++j) { a0[j] = a0[j] * sigmoidf_(a0[j]); a1[j] = a1[j] * sigmoidf_(a1[j]); b0[j] = b0[j] * sigmoidf_(b0[j]); b1[j] = b1[j] * sigmoidf_(b1[j]); }
                }
                bf16_t* rowp = Z + (size_t)r * IN_W + col0;
                u32x4 w; w.x = pk_f16(a0[0], a0[1]); w.y = pk_f16(a0[2], a0[3]); w.z = pk_f16(a1[0], a1[1]); w.w = pk_f16(a1[2], a1[3]); *(u32x4*)(rowp) = w;
                w.x = pk_f16(b0[0], b0[1]); w.y = pk_f16(b0[2], b0[3]); w.z = pk_f16(b1[0], b1[1]); w.w = pk_f16(b1[2], b1[3]); *(u32x4*)(rowp + 32) = w; }
    }
};
struct EpiGlu {
    static constexpr bool PERM = true, AFTER_DRAIN = false;
    const bf16_t* Y2; const bf16_t* Z; const float* bg; bf16_t* MIX;
    __device__ __forceinline__ void operator()(const f32x4 (&acc)[2][2][4][2], const Unit& u, int wr, int wc, int fr, int fq) const {
        const int row0 = u.pm * BM + wr * 64 + fr, col0 = u.c0 + wc * 64 + 8 * fq;
#pragma unroll
        for (int bj = 0; bj < 2; ++bj) { const int c = col0 + bj * 32;
            const f32x4 b0 = *(const f32x4*)(bg + c), b1 = *(const f32x4*)(bg + c + 4);
#pragma unroll
            for (int ai = 0; ai < 2; ++ai)
#pragma unroll
                for (int m = 0; m < 4; ++m) { const int r = row0 + ai * HALF + m * 16;
                    const u32x4 yv = *(const u32x4*)(Y2 + gm_off(r, c)), sv = *(const u32x4*)(Z + (size_t)r * IN_W + ZSG + c);
                    const f32x4 a0 = acc[ai][bj][m][0] + b0, a1 = acc[ai][bj][m][1] + b1;
                    float o[8];
#pragma unroll
                    for (int j = 0; j < 4; ++j) { const unsigned yw = yv[j], sw = sv[j];
                        const float g0 = (j < 2) ? a0[2 * j] : a1[2 * j - 4], g1 = (j < 2) ? a0[2 * j + 1] : a1[2 * j - 3];
                        o[2 * j] = h_lo(yw) * sigmoidf_(g0) * h_lo(sw); o[2 * j + 1] = h_hi(yw) * sigmoidf_(g1) * h_hi(sw); }
                    u32x4 w; w.x = pk_f16(o[0], o[1]); w.y = pk_f16(o[2], o[3]); w.z = pk_f16(o[4], o[5]); w.w = pk_f16(o[6], o[7]);
                    *(u32x4*)(MIX + (size_t)r * MIX_W + 512 + c) = w; } }
    }
};
template <int MODE> struct EpiOut {
    static constexpr bool PERM = true, AFTER_DRAIN = false;
    const float* xin; float* xout; bf16_t* XB; float* sumsq;
    __device__ __forceinline__ void operator()(const f32x4 (&acc)[2][2][4][2], const Unit& u, int wr, int wc, int fr, int fq) const {
        const int row0 = u.pm * BM + wr * 64 + fr, col0 = u.c0 + wc * 64 + 8 * fq;
#pragma unroll
        for (int ai = 0; ai < 2; ++ai)
#pragma unroll
            for (int m = 0; m < 4; ++m) { const int r = row0 + ai * HALF + m * 16; const size_t off = (size_t)r * D_MODEL + col0; float ss = 0.f;
#pragma unroll
                for (int bj = 0; bj < 2; ++bj) { f32x4 x0, x1;
                    if (MODE == 0) { x0 = *(const f32x4*)(xin + off + bj * 32); x1 = *(const f32x4*)(xin + off + bj * 32 + 4); }
                    else { const u32x4 xv = *(const u32x4*)(XB + off + bj * 32); x0 = (f32x4){h_lo(xv.x), h_hi(xv.x), h_lo(xv.y), h_hi(xv.y)}; x1 = (f32x4){h_lo(xv.z), h_hi(xv.z), h_lo(xv.w), h_hi(xv.w)}; }
                    const f32x4 o0 = x0 + acc[ai][bj][m][0], o1 = x1 + acc[ai][bj][m][1];
                    if (MODE == 2) { *(f32x4*)(xout + off + bj * 32) = o0; *(f32x4*)(xout + off + bj * 32 + 4) = o1; }
                    else { u32x4 w; w.x = pk_f16(o0[0], o0[1]); w.y = pk_f16(o0[2], o0[3]); w.z = pk_f16(o1[0], o1[1]); w.w = pk_f16(o1[2], o1[3]); *(u32x4*)(XB + off + bj * 32) = w;
                        ss += ((o0[0] * o0[0] + o0[1] * o0[1]) + (o0[2] * o0[2] + o0[3] * o0[3])) + ((o1[0] * o1[0] + o1[1] * o1[1]) + (o1[2] * o1[2] + o1[3] * o1[3])); } }
                if (MODE != 2) { ss += __shfl_xor(ss, 16); ss += __shfl_xor(ss, 32);
                    if (fq == 0) sumsq[(size_t)r * 16 + (u.c0 >> 8) * 4 + wc] = ss; } }
    }
};
struct EpiMemF32 {
    static constexpr bool PERM = false, AFTER_DRAIN = false;
    float* C; int ldc; const float* rstd;
    __device__ __forceinline__ void operator()(const f32x4 (&acc)[2][2][4][2], const Unit& u, int wr, int wc, int fr, int fq) const {
        const int row0 = u.pm * BM + wr * 64 + fr, col0 = u.c0 + wc * 32 + 4 * fq;
#pragma unroll
        for (int ai = 0; ai < 2; ++ai)
#pragma unroll
            for (int m = 0; m < 4; ++m) { const int r = row0 + ai * HALF + m * 16; const float rs = rstd[r]; float* rowp = C + (size_t)r * ldc + col0;
#pragma unroll
                for (int bj = 0; bj < 2; ++bj)
#pragma unroll
                    for (int n = 0; n < 2; ++n) *(f32x4*)(rowp + bj * HALF + n * 16) = acc[ai][bj][m][n] * rs; }
    }
};

template <class Epi, class Sched, bool ALIGN_EPI, class AL = ARowMajor>
__device__ __forceinline__ void gemm_phase(PG8_LAS unsigned char* lds, const Gemm g, const Sched& S, const Epi& E) {
    int tid = threadIdx.x; asm volatile("" : "+v"(tid)); const int wid = __builtin_amdgcn_readfirstlane(tid >> 6), lane = tid & 63, wr = wid >> 2, wc = wid & 3, fr = lane & 15, fq = lane >> 4;
    const int K = g.K, nt = K / BK;
    unsigned voffA[2], voffB[2];
#pragma unroll
    for (int i = 0; i < 2; ++i) { int R, C; stage_rc(tid * 16 + i * 8192, R, C); const int Rb = Epi::PERM ? (64 * (R >> 5) + perm32(R & 31)) : R;
        voffA[i] = AL::voff(R, C, K); voffB[i] = (unsigned)(Rb * K + C) * 2u; }
    const size_t kstep = (size_t)(BK * 2);
    const size_t hstep = AL::hstep(K), akstep = AL::kstep(K);
    const size_t bhs = Epi::PERM ? (size_t)32 * K * 2 : (size_t)HALF * K * 2;
    const unsigned ldsw = (unsigned)wid * 1024u;
    const int aoff = lds_byte(wr * 64 + fr, fq * 8), boff = lds_byte(wc * 32 + fr, fq * 8);
#define PG8_SA(b, h) (((b) * 2 + (h)) * HTB)
#define PG8_SB(b, h) ((4 + (b) * 2 + (h)) * HTB)
#define PG8_STAGE(bufoff, gbase, voff) do { _Pragma("unroll") for (int _i = 0; _i < 2; ++_i) \
        __builtin_amdgcn_global_load_lds((const unsigned*)((const char*)(gbase) + (voff)[_i]), (PG8_LAS unsigned*)(lds + (bufoff) + ldsw + _i * 8192), 16, 0, 0); } while (0)
#define PG8_LDA(dst, b, h) do { _Pragma("unroll") for (int m = 0; m < 4; ++m) _Pragma("unroll") for (int k = 0; k < 2; ++k) dst[m][k] = *(const PG8_LAS f16x8*)(lds + PG8_SA(b, h) + aoff + m * 2048 + k * 1024); } while (0)
#define PG8_LDB(dst, b, h) do { _Pragma("unroll") for (int n = 0; n < 2; ++n) _Pragma("unroll") for (int k = 0; k < 2; ++k) dst[n][k] = *(const PG8_LAS f16x8*)(lds + PG8_SB(b, h) + boff + n * 2048 + k * 1024); } while (0)
#define PG8_MMA(ai, bj, At, Bt) do { __builtin_amdgcn_s_setprio(1); _Pragma("unroll") for (int m = 0; m < 4; ++m) _Pragma("unroll") for (int n = 0; n < 2; ++n) _Pragma("unroll") for (int k = 0; k < 2; ++k) \
        acc[ai][bj][m][n] = __builtin_amdgcn_mfma_f32_16x16x32_f16(Bt[n][k], At[m][k], acc[ai][bj][m][n], 0, 0, 0); __builtin_amdgcn_s_setprio(0); } while (0)
#define PG8_WAIT_V(n) asm volatile("s_waitcnt vmcnt(" #n ")" ::: "memory")
#define PG8_WAIT_L(n) asm volatile("s_waitcnt lgkmcnt(" #n ")" ::: "memory")
#define PG8_BAR __builtin_amdgcn_s_barrier()
#define PG8_SCHED __builtin_amdgcn_sched_barrier(0)
    Unit cur, nxt; int ui = 0;
    if (!S.next(0, cur)) return;
    f32x4 acc[2][2][4][2];
#pragma unroll
    for (int a = 0; a < 2; ++a)
#pragma unroll
        for (int b = 0; b < 2; ++b)
#pragma unroll
            for (int m = 0; m < 4; ++m)
#pragma unroll
                for (int n = 0; n < 2; ++n) acc[a][b][m][n] = (f32x4){0.f, 0.f, 0.f, 0.f};
    f16x8 At[4][2], B0[2][2], B1[2][2];
    const char* cA = (const char*)g.A + AL::base(cur.pm, K); const char* cB = (const char*)g.Bt + (size_t)cur.c0 * K * 2;
    S.a_ready(cur);
    PG8_STAGE(PG8_SB(0, 0), cB, voffB); PG8_STAGE(PG8_SB(0, 1), cB + bhs, voffB); PG8_STAGE(PG8_SA(0, 0), cA, voffA); PG8_STAGE(PG8_SA(0, 1), cA + hstep, voffA);
    if (wr == 1) PG8_BAR;
    PG8_WAIT_V(2); PG8_BAR;
    PG8_STAGE(PG8_SB(1, 0), cB + kstep, voffB); PG8_STAGE(PG8_SA(1, 0), cA + akstep, voffA); PG8_STAGE(PG8_SB(1, 1), cB + bhs + kstep, voffB);
    PG8_WAIT_V(6); PG8_BAR;
    for (;;) {
        const bool has_next = S.next(ui + 1, nxt);
        const char* nA = has_next ? (const char*)g.A + AL::base(nxt.pm, K) : cA; const char* nB = has_next ? (const char*)g.Bt + (size_t)nxt.c0 * K * 2 : cB;
        for (int t = 0; t < nt; t += 2) {
            const bool last = (t == nt - 2);
            const char* a1 = cA + (size_t)(t + 1) * akstep;
            const char* a2 = last ? nA : cA + (size_t)(t + 2) * akstep; const char* b2 = last ? nB : cB + (size_t)(t + 2) * kstep;
            const char* a3 = a2 + akstep; const char* b3 = b2 + kstep;
            if (last && has_next) S.a_ready(nxt);
            PG8_LDB(B0, 0, 0); PG8_LDB(B1, 0, 1); PG8_SCHED; PG8_LDA(At, 0, 0); PG8_STAGE(PG8_SA(1, 1), a1 + hstep, voffA);
            PG8_WAIT_V(8); PG8_WAIT_L(0); PG8_BAR; PG8_MMA(0, 0, At, B0); if (!cur.half) PG8_MMA(0, 1, At, B1); PG8_BAR; PG8_SCHED;
            PG8_LDA(At, 0, 1); PG8_STAGE(PG8_SB(0, 0), b2, voffB); PG8_STAGE(PG8_SB(0, 1), b2 + bhs, voffB); PG8_STAGE(PG8_SA(0, 0), a2, voffA);
            PG8_WAIT_V(8); PG8_WAIT_L(0); PG8_BAR; PG8_MMA(1, 0, At, B0); if (!cur.half) PG8_MMA(1, 1, At, B1); PG8_BAR; PG8_SCHED;
            PG8_LDB(B0, 1, 0); PG8_LDB(B1, 1, 1); PG8_SCHED; PG8_LDA(At, 1, 0); PG8_STAGE(PG8_SA(0, 1), a2 + hstep, voffA);
            PG8_WAIT_V(8); PG8_WAIT_L(0); PG8_BAR; PG8_MMA(0, 0, At, B0); if (!cur.half) PG8_MMA(0, 1, At, B1); PG8_BAR; PG8_SCHED;
            PG8_LDA(At, 1, 1); PG8_STAGE(PG8_SB(1, 0), b3, voffB); PG8_STAGE(PG8_SB(1, 1), b3 + bhs, voffB); PG8_STAGE(PG8_SA(1, 0), a3, voffA);
            PG8_WAIT_V(8); PG8_WAIT_L(0); PG8_BAR; PG8_MMA(1, 0, At, B0); if (!cur.half) PG8_MMA(1, 1, At, B1); PG8_BAR; PG8_SCHED;
        }
        if constexpr (ALIGN_EPI) { if (wr == 0) PG8_BAR; }
        E(acc, cur, wr, wc, fr, fq); S.done(cur);
        if (!has_next) break;
#pragma unroll
        for (int a = 0; a < 2; ++a)
#pragma unroll
            for (int b = 0; b < 2; ++b)
#pragma unroll
                for (int m = 0; m < 4; ++m)
#pragma unroll
                    for (int n = 0; n < 2; ++n) acc[a][b][m][n] = (f32x4){0.f, 0.f, 0.f, 0.f};
        cur = nxt; cA = nA; cB = nB; ++ui;
        if constexpr (ALIGN_EPI) { if (wr == 1) PG8_BAR; }
    }
    PG8_WAIT_V(0);
    if constexpr (!ALIGN_EPI) { if (wr == 0) PG8_BAR; }
    PG8_BAR;
#undef PG8_SA
#undef PG8_SB
#undef PG8_STAGE
#undef PG8_LDA
#undef PG8_LDB
#undef PG8_MMA
#undef PG8_WAIT_V
#undef PG8_WAIT_L
#undef PG8_BAR
#undef PG8_SCHED
}
}

constexpr int NWAVES = 8, NTHREADS = 512;
constexpr int LDS_BYTES = 163840;
constexpr int LDSCTL_OFF = 162816;
#define LAS __attribute__((address_space(3)))
typedef unsigned v4u __attribute__((ext_vector_type(4)));
typedef float f32x4 __attribute__((ext_vector_type(4)));

struct Params {
    const float* x; const float* mem; const int* pos; const float* norm_g; const float* w_in; const float* q_norm_g; const float* k_norm_g; const float* sinks;
    const float* lam_re; const float* lam_im; const float* log_dt; const float* b_re; const float* b_im; const float* c_re; const float* c_im; const float* d_skip;
    const float* w_glu; const float* b_glu; const float* mem_norm_g; const float* w_mem_kv; const float* xq_norm_g; const float* xk_norm_g; const float* w_out;
    float* out; unsigned char* ws;
};

__device__ __forceinline__ void p0_transpose_item(const float* W, int K, int N, const float* scale, bf16_t* WT, LAS float* scr, int item, int lane) {
    const int nblk = N / 64, kb = item / nblk, nb = item % nblk, k0 = 64 * kb, n0 = 64 * nb;
    const int lr = lane >> 4, lc = (lane & 15) * 4;
#pragma unroll 4
    for (int i = 0; i < 16; ++i) { const int kk = 4 * i + lr; const float sc = scale ? scale[k0 + kk] : 1.f; const f32x4 v = *(const f32x4*)(W + (size_t)(k0 + kk) * N + n0 + lc);
        LAS float* d = scr + kk * 65 + lc; d[0] = v[0] * sc; d[1] = v[1] * sc; d[2] = v[2] * sc; d[3] = v[3] * sc; }
    asm volatile("s_waitcnt lgkmcnt(0)" ::: "memory");
    const int c = lane & 7;
#pragma unroll
    for (int j = 0; j < 8; ++j) { const int n = (lane >> 3) + 8 * j; const LAS float* s = scr + (8 * c) * 65 + n;
        v4u o; o.x = pg8::pk_f16(s[0 * 65], s[1 * 65]); o.y = pg8::pk_f16(s[2 * 65], s[3 * 65]); o.z = pg8::pk_f16(s[4 * 65], s[5 * 65]); o.w = pg8::pk_f16(s[6 * 65], s[7 * 65]);
        *(v4u*)(WT + (size_t)(n0 + n) * K + k0 + 8 * c) = o; }
    asm volatile("s_waitcnt lgkmcnt(0)" ::: "memory");
}
__device__ __forceinline__ void phase_prep(const Params& P, LAS unsigned char* lds, int vcu, int G) {
    int tid = threadIdx.x; asm volatile("" : "+v"(tid)); const int lane = tid & 63, wave = __builtin_amdgcn_readfirstlane(tid >> 6);
    LAS float* scr = (LAS float*)(lds + wave * 16640);
    const int gw = vcu * NWAVES + wave, NGW = G * NWAVES;
    unsigned char* ws = P.ws;
    constexpr int I_IN = (D_MODEL / 64) * (IN_W / 64), I_OUT = (MIX_W / 64) * (D_MODEL / 64), I_GLU = (SSM_W / 64) * (SSM_W / 64), I_MEM = (D_MODEL / 64) * (1024 / 64);
    constexpr int I_LAYER = I_IN + I_OUT + I_GLU + I_MEM;
    for (int it = gw; it < DEPTH * I_LAYER; it += NGW) {
        const int l = it / I_LAYER; int r = it % I_LAYER;
        if (r < I_IN) { p0_transpose_item(P.w_in + (size_t)l * D_MODEL * IN_W, D_MODEL, IN_W, P.norm_g + l * D_MODEL, (bf16_t*)(ws + WS_WIN) + (size_t)l * IN_W * D_MODEL, scr, r, lane); continue; } r -= I_IN;
        if (r < I_OUT) { p0_transpose_item(P.w_out + (size_t)l * MIX_W * D_MODEL, MIX_W, D_MODEL, nullptr, (bf16_t*)(ws + WS_WOUT) + (size_t)l * D_MODEL * MIX_W, scr, r, lane); continue; } r -= I_OUT;
        if (r < I_GLU) { p0_transpose_item(P.w_glu + (size_t)l * SSM_W * SSM_W, SSM_W, SSM_W, nullptr, (bf16_t*)(ws + WS_WGLU) + (size_t)l * SSM_W * SSM_W, scr, r, lane); continue; } r -= I_GLU;
        p0_transpose_item(P.w_mem_kv + (size_t)l * D_MODEL * 1024, D_MODEL, 1024, P.mem_norm_g + l * D_MODEL, (bf16_t*)(ws + WS_WMEM) + (size_t)l * 1024 * D_MODEL, scr, r, lane);
    }
    for (int m = gw; m < MTOK + BATCH * N_MEM; m += NGW) {
        const bool is_x = m < MTOK; const int row = is_x ? m : m - MTOK;
        const f32x4* xr = (const f32x4*)((is_x ? P.x : P.mem) + (size_t)row * D_MODEL) + lane;
        bf16_t* ob = (bf16_t*)(ws + (is_x ? WS_XB : WS_MEMB)) + (size_t)row * D_MODEL;
        f32x4 v[4]; float s = 0.f;
#pragma unroll
        for (int j = 0; j < 4; ++j) { v[j] = xr[64 * j]; s += (v[j][0] * v[j][0] + v[j][1] * v[j][1]) + (v[j][2] * v[j][2] + v[j][3] * v[j][3]); }
        s = wave_sum(s);
#pragma unroll
        for (int j = 0; j < 4; ++j) { pg8::u32x2 w; w.x = pg8::pk_f16(v[j][0], v[j][1]); w.y = pg8::pk_f16(v[j][2], v[j][3]); *((pg8::u32x2*)ob + lane + 64 * j) = w; }
        if (is_x) { if (lane < 16) ((float*)(ws + WS_SUMSQ))[(size_t)row * 16 + lane] = (lane == 0) ? s : 0.f; }
        else if (lane == 0) ((float*)(ws + WS_MISC))[row] = rsqrtf(s * (1.f / D_MODEL) + EPS);
    }
    { bf16_t* tab = (bf16_t*)(ws + WS_ROPE);
      for (int idx = vcu * NTHREADS + tid; idx < MTOK * 32; idx += G * NTHREADS) { const int tok = idx >> 5, i = idx & 31;
          const float inv = powf(10000.0f, -(float)i / 32.0f); const float ang = (float)P.pos[tok] * inv; const double a = (double)ang;
          tab[tok * 64 + i] = f2bf((float)cos(a)); tab[tok * 64 + 32 + i] = f2bf((float)sin(a)); } }
}


typedef _Float16 f16x8 __attribute__((ext_vector_type(8)));
typedef float f32x16 __attribute__((ext_vector_type(16)));
__device__ __forceinline__ int crow(int r, int hi) { return (r & 3) + 8 * (r >> 2) + 4 * hi; }
__device__ __forceinline__ float hf(_Float16 h) { return (float)h; }
constexpr float LOG2E = 1.4426950408889634f;
__device__ __forceinline__ f16x8 pack8(const f32x16& p, int s) { f16x8 r;
#pragma unroll
    for (int j = 0; j < 8; ++j) r[j] = (_Float16)p[8 * s + j];
    return r; }


__device__ __forceinline__ void stage_tile(LAS unsigned char* st, int pitchB, int colOff, const f32x16& o, int c, int hi) {
#pragma unroll
    for (int r = 0; r < 16; ++r) *(LAS _Float16*)(st + crow(r, hi) * pitchB + (colOff + c) * 2) = (_Float16)o[r];
}

typedef unsigned v2u __attribute__((ext_vector_type(2)));
__device__ __forceinline__ void stage_ot(LAS unsigned char* st, int pitchB, int colOff, const f32x16& o, float sc, int q, int hi) {
#pragma unroll
    for (int g4 = 0; g4 < 4; ++g4) { v2u w; w.x = pg8::pk_f16(o[4 * g4] * sc, o[4 * g4 + 1] * sc); w.y = pg8::pk_f16(o[4 * g4 + 2] * sc, o[4 * g4 + 3] * sc);
        *(LAS v2u*)(st + q * pitchB + (colOff + 8 * g4 + 4 * hi) * 2) = w; }
}
__device__ __forceinline__ void stage_ot2(LAS unsigned char* st, int pitchB, int colOff, const f32x16& o0, float s0, const f32x16& o1, float s1, int q, int hi) {
#pragma unroll
    for (int g4 = 0; g4 < 4; ++g4) { v2u w; w.x = pg8::pk_f16(o0[4 * g4] * s0 + o1[4 * g4] * s1, o0[4 * g4 + 1] * s0 + o1[4 * g4 + 1] * s1); w.y = pg8::pk_f16(o0[4 * g4 + 2] * s0 + o1[4 * g4 + 2] * s1, o0[4 * g4 + 3] * s0 + o1[4 * g4 + 3] * s1);
        *(LAS v2u*)(st + q * pitchB + (colOff + 8 * g4 + 4 * hi) * 2) = w; }
}
__device__ __forceinline__ v4u pk_mul8(v4u a, v4u b) { return __builtin_bit_cast(v4u, __builtin_bit_cast(f16x8, a) * __builtin_bit_cast(f16x8, b)); }

typedef _Float16 h2_t __attribute__((ext_vector_type(2)));
__device__ __forceinline__ float sum8_f16(f16x8 v, float acc) {
    const h2_t one = {(_Float16)1.f, (_Float16)1.f};
#pragma unroll
    for (int k = 0; k < 4; ++k) { const h2_t p = {v[2 * k], v[2 * k + 1]}; acc = __builtin_amdgcn_fdot2(p, one, acc, false); }
    return acc; }
__device__ __forceinline__ float silu_fast(float x) { return x * __builtin_amdgcn_rcpf(1.f + __expf(-x)); }
constexpr int ATT_KF = 0, ATT_VF = 32768, ATT_ST = 65536;
__device__ __forceinline__ int opaque_tid() { int t = threadIdx.x; asm volatile("" : "+v"(t)); return t; }
__device__ __forceinline__ void attn_a_item(const Params& P, int layer, LAS unsigned char* lds, int item) {
    const int tid = opaque_tid(), lane = tid & 63, wave = __builtin_amdgcn_readfirstlane(tid >> 6);
    const int kvh = item & 1, blk = (item >> 1) & 31, b = item >> 6;
    const bf16_t* Z = (const bf16_t*)(P.ws + WS_Z); bf16_t* MIX = (bf16_t*)(P.ws + WS_MIX); const bf16_t* rope = (const bf16_t*)(P.ws + WS_ROPE);
    const float* kg = P.k_norm_g + layer * HD; const float* qg = P.q_norm_g + layer * HD;
    {
        const int key = tid >> 1, hh = tid & 1, tpos = blk * 128 - 128 + key; const bool valid = tpos >= 0;
        const int tok = b * SEQ + (valid ? tpos : 0);
        const bf16_t* zr = Z + (size_t)tok * IN_W;
        const int kt = key >> 5, kl = key & 31;
#pragma unroll
        for (int i = 0; i < 2; ++i) { const int c = 2 * hh + i;
            f16x8 o1 = *(const f16x8*)(zr + ZK + kvh * HD + 8 * c), o2 = *(const f16x8*)(zr + ZK + kvh * HD + 32 + 8 * c);
            if (!valid) { o1 = (f16x8){0, 0, 0, 0, 0, 0, 0, 0}; o2 = o1; }
            { const int cc = c;     *(LAS f16x8*)(lds + ATT_KF + (((kt * 4 + (cc >> 1)) * 64) + kl + 32 * (cc & 1)) * 16) = o1; }
            { const int cc = c + 4; *(LAS f16x8*)(lds + ATT_KF + (((kt * 4 + (cc >> 1)) * 64) + kl + 32 * (cc & 1)) * 16) = o2; } }
        const int sK = kl >> 4, h2 = ((kl & 15) >> 2) & 1, jj = 4 * ((kl & 15) >> 3) + (kl & 3);
        LAS unsigned short* vb = (LAS unsigned short*)(lds + ATT_VF + ((((kt * 2 + hh) * 2 + sK) * 64) + 32 * h2) * 16 + 2 * jj);
#pragma unroll
        for (int i = 0; i < 4; ++i) { const v4u v = *(const v4u*)(zr + ZV + kvh * HD + 32 * hh + 8 * i);
#pragma unroll
            for (int j = 0; j < 8; ++j) { const unsigned wv = v[j >> 1]; vb[(8 * i + j) * 8] = valid ? (unsigned short)((j & 1) ? (wv >> 16) : (wv & 0xffffu)) : (unsigned short)0; } }
    }
    const int ql = lane & 31, hi = lane >> 5;
    f16x8 qfu[2][4];
#pragma unroll
    for (int ui = 0; ui < 2; ++ui) {
        const int head = 2 * (wave >> 2) + ui, w = wave & 3, hq = kvh * 4 + head;
        const int tq = b * SEQ + blk * 128 + 32 * w + ql;
        const bf16_t* zq = Z + (size_t)tq * IN_W + ZQ + hq * HD;
#pragma unroll
        for (int d0 = 0; d0 < 4; ++d0) qfu[ui][d0] = *(const f16x8*)(zq + 16 * d0 + 8 * hi);
    }
    __syncthreads();
#pragma unroll
    for (int ui = 0; ui < 2; ++ui) {
        const int head = 2 * (wave >> 2) + ui, w = wave & 3, hq = kvh * 4 + head;
        const f16x8* qf = qfu[ui];
        const int erow = lane >> 1, ehs = lane & 1; const size_t etok = (size_t)b * SEQ + blk * 128 + 32 * w + erow; const int ecol = hq * HD + 32 * ehs;
        v4u gv[4];
#pragma unroll
        for (int i = 0; i < 4; ++i) gv[i] = *(const v4u*)(Z + etok * IN_W + ZG + ecol + 8 * i);
        f32x16 p[5];
#pragma unroll
        for (int t = 0; t < 5; ++t) { const int kt = w + t; f32x16 acc = {};
#pragma unroll
            for (int d0 = 0; d0 < 4; ++d0) { const f16x8 kf = *(const LAS f16x8*)(lds + ATT_KF + ((kt * 4 + d0) * 64 + lane) * 16);
                acc = __builtin_amdgcn_mfma_f32_32x32x16_f16(kf, qf[d0], acc, 0, 0, 0); }
            p[t] = acc; }
        float mx = -INFINITY;
        int qlv = ql; asm volatile("" : "+v"(qlv));
#pragma unroll
        for (int t = 0; t < 5; ++t) { const bool tile_off = (blk == 0) && (w + t < 4);
#pragma unroll
            for (int r = 0; r < 16; ++r) { bool ok = !tile_off; if (t == 0) ok = ok && (crow(r, hi) > qlv); if (t == 4) ok = ok && (crow(r, hi) <= qlv);
                const float v = ok ? p[t][r] : -INFINITY; p[t][r] = v; mx = fmaxf(mx, v); } }
        mx = fmaxf(mx, __shfl_xor(mx, 32));
        const float sink2 = P.sinks[layer * NQH + hq] * LOG2E;
        mx = fmaxf(mx, sink2);
#pragma unroll
        for (int t = 0; t < 5; ++t) { const f32x16 dv = p[t] - mx;
#pragma unroll
            for (int r = 0; r < 16; ++r) p[t][r] = __builtin_amdgcn_exp2f(dv[r]); }
        float l = 0.f;
        f32x16 o[2] = {};
#pragma unroll
        for (int t = 0; t < 5; ++t) { const int kt = w + t;
#pragma unroll
            for (int s2 = 0; s2 < 2; ++s2) { const f16x8 pa = pack8(p[t], s2); l = sum8_f16(pa, l);
#pragma unroll
                for (int db = 0; db < 2; ++db) { const f16x8 vf = *(const LAS f16x8*)(lds + ATT_VF + (((kt * 2 + db) * 2 + s2) * 64 + lane) * 16);
                    o[db] = __builtin_amdgcn_mfma_f32_32x32x16_f16(vf, pa, o[db], 0, 0, 0); } } }
        l += __shfl_xor(l, 32); l += __builtin_amdgcn_exp2f(sink2 - mx);
        const float linv = __builtin_amdgcn_rcpf(l);
        { LAS unsigned char* st = lds + ATT_ST + wave * 4608;
          stage_ot(st, 144, 0, o[0], linv, ql, hi); stage_ot(st, 144, 32, o[1], linv, ql, hi);
#pragma unroll
          for (int i = 0; i < 4; ++i) { const v4u ov = *(const LAS v4u*)(st + erow * 144 + ehs * 64 + 16 * i);
              *(v4u*)(MIX + etok * MIX_W + ecol + 8 * i) = pk_mul8(ov, gv[i]); } }
    }
    __syncthreads();
}
__device__ __forceinline__ void phase_attn_a(const Params& P, int layer, LAS unsigned char* lds, int vcu, int G, int bx, bool defer) {
    if (defer) {
        if (bx < 128) attn_a_item(P, layer, lds, bx);
        else for (int j = 0; j < 3; ++j) attn_a_item(P, layer, lds, 128 + 3 * (bx - 128) + j);
        return; }
    for (int it = vcu; it < BATCH * 32 * NKVH; it += G) attn_a_item(P, layer, lds, it);
}

__device__ __forceinline__ void attn_c_item(const Params& P, int layer, LAS unsigned char* lds, int item) {
    const int tid = opaque_tid(), lane = tid & 63, wave = __builtin_amdgcn_readfirstlane(tid >> 6);
    const int sblk = item & 7, h = (item >> 3) & 3, b = item >> 5;
    const bf16_t* Z = (const bf16_t*)(P.ws + WS_Z); bf16_t* MIX = (bf16_t*)(P.ws + WS_MIX);
    const f16x8* KFg = (const f16x8*)(P.ws + WS_MK) + (size_t)((layer * BATCH + b) * XH + h) * (8 * 8 * 64);
    const f16x8* VFg = (const f16x8*)(P.ws + WS_MV) + (size_t)((layer * BATCH + b) * XH + h) * (8 * 4 * 2 * 64);
    const float* xqg = P.xq_norm_g + layer * XHD;
#pragma unroll
    for (int i = 0; i < 16; ++i) { const int f = wave * 16 + i; const f16x8* src = (f < 64 ? KFg + f * 64 : VFg + (f - 64) * 64) + lane;
        __builtin_amdgcn_global_load_lds((const unsigned*)src, (LAS unsigned*)(lds + f * 1024), 16, 0, 0); }
    asm volatile("s_waitcnt vmcnt(0)" ::: "memory");
    __syncthreads();
    const int ql = lane & 31, hi = lane >> 5;
    for (int ui = 0; ui < 2; ++ui) {
        const int qbase = b * SEQ + sblk * 512 + (wave * 2 + ui) * 32;
        const bf16_t* zq = Z + (size_t)(qbase + ql) * IN_W + ZXQ + h * XHD;
        f16x8 qf[8]; float ss = 0.f;
#pragma unroll
        for (int d0 = 0; d0 < 8; ++d0) { qf[d0] = *(const f16x8*)(zq + 16 * d0 + 8 * hi);
#pragma unroll
            for (int k2 = 0; k2 < 4; ++k2) { const h2_t v = {qf[d0][2 * k2], qf[d0][2 * k2 + 1]}; ss = __builtin_amdgcn_fdot2(v, v, ss, false); } }
        ss += __shfl_xor(ss, 32);
        const _Float16 rsh = (_Float16)(rsqrtf(ss * (1.f / XHD) + EPS) * (0.08838834764831845f * LOG2E));
#pragma unroll
        for (int d0 = 0; d0 < 8; ++d0) qf[d0] = qf[d0] * rsh;
        f16x8 pa[2][4][2]; float mh[2], lh[2];
#pragma unroll
        for (int hf2 = 0; hf2 < 2; ++hf2) {
            f32x16 p[4];
#pragma unroll
            for (int t = 0; t < 4; ++t) { const int kt = 4 * hf2 + t; f32x16 acc = {};
#pragma unroll
                for (int d0 = 0; d0 < 8; ++d0) acc = __builtin_amdgcn_mfma_f32_32x32x16_f16(*(const LAS f16x8*)(lds + ((kt * 8 + d0) * 64 + lane) * 16), qf[d0], acc, 0, 0, 0);
                p[t] = acc; asm volatile("" ::: "memory"); }
            float mx = -INFINITY;
#pragma unroll
            for (int t = 0; t < 4; ++t)
#pragma unroll
                for (int r = 0; r < 16; ++r) mx = fmaxf(mx, p[t][r]);
            mx = fmaxf(mx, __shfl_xor(mx, 32));
            float l = 0.f;
#pragma unroll
            for (int t = 0; t < 4; ++t) { const f32x16 dv = p[t] - mx;
#pragma unroll
                for (int r = 0; r < 16; ++r) p[t][r] = __builtin_amdgcn_exp2f(dv[r]);
                pa[hf2][t][0] = pack8(p[t], 0); pa[hf2][t][1] = pack8(p[t], 1); l = sum8_f16(pa[hf2][t][0], l); l = sum8_f16(pa[hf2][t][1], l); }
            l += __shfl_xor(l, 32);
            mh[hf2] = mx; lh[hf2] = l;
        }
        const float mm = fmaxf(mh[0], mh[1]); const float e0 = __builtin_amdgcn_exp2f(mh[0] - mm), e1 = __builtin_amdgcn_exp2f(mh[1] - mm);
        const float linv = __builtin_amdgcn_rcpf(lh[0] * e0 + lh[1] * e1); const float f0 = e0 * linv, f1 = e1 * linv;
        const int erow = lane >> 1, ehs = lane & 1; const size_t tok = (size_t)qbase + erow;
        v4u gall[4][2];
#pragma unroll
        for (int db = 0; db < 4; ++db) { const int col = h * XHD + 32 * db + 16 * ehs; gall[db][0] = *(const v4u*)(Z + tok * IN_W + ZXG + col); gall[db][1] = *(const v4u*)(Z + tok * IN_W + ZXG + col + 8); }
#pragma unroll
        for (int db = 0; db < 4; ++db) { f32x16 o0 = {}, o1 = {};
#pragma unroll
            for (int t = 0; t < 4; ++t) {
#pragma unroll
                for (int s2 = 0; s2 < 2; ++s2) { o0 = __builtin_amdgcn_mfma_f32_32x32x16_f16(*(const LAS f16x8*)(lds + 65536 + (((t * 4 + db) * 2 + s2) * 64 + lane) * 16), pa[0][t][s2], o0, 0, 0, 0);
                    o1 = __builtin_amdgcn_mfma_f32_32x32x16_f16(*(const LAS f16x8*)(lds + 65536 + ((((4 + t) * 4 + db) * 2 + s2) * 64 + lane) * 16), pa[1][t][s2], o1, 0, 0, 0); }
                asm volatile("" ::: "memory"); }
            { LAS unsigned char* st = lds + 131072 + wave * 2560; const int col = h * XHD + 32 * db + 16 * ehs;
              const v4u ga = gall[db][0], gb = gall[db][1];
              stage_ot2(st, 80, 0, o0, f0, o1, f1, ql, hi);
              const v4u a0 = *(const LAS v4u*)(st + erow * 80 + ehs * 32), a1 = *(const LAS v4u*)(st + erow * 80 + ehs * 32 + 16);
              *(v4u*)(MIX + tok * MIX_W + 1024 + col) = pk_mul8(a0, ga); *(v4u*)(MIX + tok * MIX_W + 1024 + col + 8) = pk_mul8(a1, gb); }
            asm volatile("" ::: "memory"); }
    }
    __syncthreads();
}
__device__ __forceinline__ void phase_attn_c(const Params& P, int layer, LAS unsigned char* lds, int vcu, int G) {
    for (int it = vcu; it < BATCH * XH * 8; it += G) attn_c_item(P, layer, lds, it);
}
__device__ __forceinline__ void phase_memfin(const Params& P, int vcu, int G) {
    const int tid = opaque_tid(), lane = tid & 63, wave = __builtin_amdgcn_readfirstlane(tid >> 6);
    const float* mkv = (const float*)(P.ws + WS_Y2);
    for (int it = vcu * NWAVES + wave; it < DEPTH * BATCH * N_MEM; it += G * NWAVES) {
        const int l = it / (BATCH * N_MEM), row = it % (BATCH * N_MEM), b = row / N_MEM, key = row % N_MEM;
        const float* r = mkv + (size_t)row * (DEPTH * 1024) + l * 1024; const float* xkg = P.xk_norm_g + l * XHD; const float* xqg = P.xq_norm_g + l * XHD;
        const int kt = key >> 5, kl = key & 31, sK = kl >> 4, h2 = ((kl & 15) >> 2) & 1, jj = 4 * ((kl & 15) >> 3) + (kl & 3);
        for (int h = 0; h < XH; ++h) {
            bf16_t* KF = (bf16_t*)(P.ws + WS_MK) + (size_t)((l * BATCH + b) * XH + h) * (8 * 8 * 64 * 8);
            bf16_t* VF = (bf16_t*)(P.ws + WS_MV) + (size_t)((l * BATCH + b) * XH + h) * (8 * 4 * 2 * 64 * 8);
            float v[2]; v[0] = r[h * XHD + lane]; v[1] = r[h * XHD + 64 + lane];
            const float s = wave_sum(v[0] * v[0] + v[1] * v[1]); const float rs = rsqrtf(s * (1.f / XHD) + EPS);
#pragma unroll
            for (int e = 0; e < 2; ++e) { const int d = lane + 64 * e;
                KF[(size_t)((kt * 8 + (d >> 4)) * 64 + kl + 32 * ((d >> 3) & 1)) * 8 + (d & 7)] = f2bf(v[e] * rs * xkg[d] * xqg[d]);
                VF[(size_t)(((kt * 4 + (d >> 5)) * 2 + sK) * 64 + (d & 31) + 32 * h2) * 8 + jj] = f2bf(r[512 + h * XHD + d]); }
        }
    }
}


constexpr size_t SSMC_WE = 0, SSMC_WC = 64 * 1024, SSMC_KJ = 128 * 1024, SSMC_STRIDE = 144 * 1024;
constexpr size_t WS_A16 = WS_MISC + 128 * 1024;
__device__ __forceinline__ void ssm_consts_item(const Params& P, LAS unsigned char* lds, int item) {
    const int tid = opaque_tid(); const int l = item / SSM_G, g = item % SSM_G;
    LAS float* apw = (LAS float*)lds;
    LAS float* bbar = apw + 17 * 64 * 2;
    LAS float* kj = bbar + 64 * 16 * 2;
    LAS float* cre = kj + 16 * 256; LAS float* cim = cre + 16 * 64;
    { const float* c_re_g = P.c_re + (size_t)(l * SSM_G + g) * SSM_CH * SSM_P; const float* c_im_g = P.c_im + (size_t)(l * SSM_G + g) * SSM_CH * SSM_P;
      for (int i = tid; i < 16 * 64; i += NTHREADS) { cre[i] = c_re_g[i]; cim[i] = c_im_g[i]; } }
    const LAS float* c_re = cre; const LAS float* c_im = cim;
    const double dt = exp((double)P.log_dt[l * SSM_G + g]);
    for (int i = tid; i < 17 * 64; i += NTHREADS) { const int j = i / 64, p = i % 64; const int gp = (l * SSM_G + g) * SSM_P + p;
        const double lr = P.lam_re[gp], li = P.lam_im[gp]; const double mag = exp(lr * dt * j); double sn, cs; sincos(li * dt * j, &sn, &cs);
        apw[i * 2] = (float)(mag * cs); apw[i * 2 + 1] = (float)(mag * sn); }
    for (int i = tid; i < 64 * 16; i += NTHREADS) { const int p = i / 16, c = i % 16; const int gp = (l * SSM_G + g) * SSM_P + p;
        const double lr = P.lam_re[gp], li = P.lam_im[gp]; const double mag = exp(lr * dt), ar = mag * cos(li * dt), ai = mag * sin(li * dt), den = lr * lr + li * li;
        const double fr = ((ar - 1.0) * lr + ai * li) / den, fi = (ai * lr - (ar - 1.0) * li) / den;
        const double br = P.b_re[(size_t)gp * SSM_CH + c], bi = P.b_im[(size_t)gp * SSM_CH + c];
        bbar[i * 2] = (float)(fr * br - fi * bi); bbar[i * 2 + 1] = (float)(fr * bi + fi * br); }
    __syncthreads();
    for (int i = tid; i < 16 * 256; i += NTHREADS) { const int j = i >> 8, co = (i >> 4) & 15, ci = i & 15; float acc = 0.f;
        for (int p = 0; p < 64; ++p) { const float er = apw[(j * 64 + p) * 2], ei = apw[(j * 64 + p) * 2 + 1], br = bbar[(p * 16 + ci) * 2], bi = bbar[(p * 16 + ci) * 2 + 1];
            const float wr = er * br - ei * bi, wi = er * bi + ei * br; acc += c_re[co * SSM_P + p] * wr - c_im[co * SSM_P + p] * wi; }
        if (j == 0 && co == ci) acc += P.d_skip[l * SSM_W + g * SSM_CH + co];
        kj[i] = acc; }
    __syncthreads();
    unsigned char* base = P.ws + WS_SSMP + (size_t)item * SSMC_STRIDE;
    bf16_t* WE = (bf16_t*)(base + SSMC_WE); bf16_t* WC = (bf16_t*)(base + SSMC_WC); bf16_t* KJ = (bf16_t*)(base + SSMC_KJ);
    for (int i = tid; i < 64 * 512; i += NTHREADS) { const int f = i >> 9, e = i & 511, ln = e >> 3, j = e & 7, mt = f >> 4, sx = f & 15, r = ln & 31, hh = ln >> 5;
        const int R = 32 * mt + r, p = R >> 1, ri = R & 1, ci = 8 * hh + j; const float er = apw[((15 - sx) * 64 + p) * 2], ei = apw[((15 - sx) * 64 + p) * 2 + 1], br = bbar[(p * 16 + ci) * 2], bi = bbar[(p * 16 + ci) * 2 + 1];
        WE[i] = f2bf(ri ? (er * bi + ei * br) : (er * br - ei * bi)); }
    for (int i = tid; i < 9216 / 2; i += NTHREADS) KJ[i] = (i < 16 * 256) ? f2bf(kj[i]) : (bf16_t)0;
    for (int i = tid; i < 64 * 512; i += NTHREADS) { const int f = i >> 9, e = i & 511, ln = e >> 3, j = e & 7, mt = f >> 3, kc = f & 7, r = ln & 31, hh = ln >> 5;
        const int t = 2 * mt + (r >> 4), co = r & 15, p = 8 * kc + 4 * hh + (j >> 1), ri = j & 1; const float er = apw[((t + 1) * 64 + p) * 2], ei = apw[((t + 1) * 64 + p) * 2 + 1];
        const float cr = c_re[co * SSM_P + p], cim = c_im[co * SSM_P + p]; WC[i] = f2bf(ri ? -(cr * ei + cim * er) : (cr * er - cim * ei)); }
    if (tid < 64) { float* a16 = (float*)(P.ws + WS_A16) + (size_t)(item * 64 + tid) * 4; a16[0] = apw[(16 * 64 + tid) * 2]; a16[1] = apw[(16 * 64 + tid) * 2 + 1];
        const int gp = (l * SSM_G + g) * SSM_P + tid; const double lr = P.lam_re[gp], li = P.lam_im[gp]; const double mag = exp(lr * dt * 512.0); double sn, cs; sincos(li * dt * 512.0, &sn, &cs);
        a16[2] = (float)(mag * cs); a16[3] = (float)(mag * sn); }
    __syncthreads();
}
__device__ __forceinline__ void phase_ssm_consts(const Params& P, LAS unsigned char* lds, int vcu, int G) {
    for (int it = vcu; it < DEPTH * SSM_G; it += G) ssm_consts_item(P, lds, it);
}
__device__ __forceinline__ float gelu_tanh_fast(float x) {
    const float u = 0.7978845608028654f * (x + 0.044715f * x * x * x); return x * __builtin_amdgcn_rcpf(1.f + __expf(-2.f * u)); }

constexpr int SSM_EH = 0, SSM_EHP = 272, SSM_WX = 69632, SSM_KJ = SSM_WX + 65536, SSM_CHS = SSM_KJ + 9216, SSM_TR = SSM_CHS;
static_assert(SSM_CHS + 4096 <= LDSCTL_OFF && SSM_TR + 8 * 2304 <= LDSCTL_OFF, "ssm lds map");
__device__ __forceinline__ void ssm_item(const Params& P, int layer, LAS unsigned char* lds, int item) {
    const int tid = opaque_tid(), lane = tid & 63, wave = __builtin_amdgcn_readfirstlane(tid >> 6);
    const int g = item >> 3, b = item & 7;
    const bf16_t* Z = (const bf16_t*)(P.ws + WS_Z); bf16_t* Y2 = (bf16_t*)(P.ws + WS_Y2);
    const unsigned char* cbase = P.ws + WS_SSMP + (size_t)(layer * SSM_G + g) * SSMC_STRIDE;
    const int nl = lane & 31, hh = lane >> 5;
    typedef float f32x2v __attribute__((ext_vector_type(2)));
#pragma unroll
    for (int i = 0; i < 8; ++i) { const int f = wave * 8 + i;
        __builtin_amdgcn_global_load_lds((const unsigned*)(cbase + SSMC_WE + f * 1024 + lane * 16), (LAS unsigned*)(lds + SSM_WX + f * 1024), 16, 0, 0); }
    __builtin_amdgcn_global_load_lds((const unsigned*)(cbase + SSMC_KJ + wave * 1024 + lane * 16), (LAS unsigned*)(lds + SSM_KJ + wave * 1024), 16, 0, 0);
    if (wave == 0) __builtin_amdgcn_global_load_lds((const unsigned*)(cbase + SSMC_KJ + 8192 + lane * 16), (LAS unsigned*)(lds + SSM_KJ + 8192), 16, 0, 0);
    const int n = 32 * wave + nl;
    const bf16_t* up = Z + (size_t)(b * SEQ + 16 * n) * IN_W + ZU + g * SSM_CH + 8 * hh;
    f16x8 uf[16];
#pragma unroll
    for (int sx = 0; sx < 16; ++sx) uf[sx] = *(const f16x8*)(up + (size_t)sx * IN_W);
    const float* a16p = (const float*)(P.ws + WS_A16) + (size_t)((layer * SSM_G + g) * 64 + lane) * 4;
    const float a16r = a16p[0], a16i = a16p[1], a5r = a16p[2], a5i = a16p[3];
    asm volatile("s_waitcnt vmcnt(0)" ::: "memory");
    __syncthreads();
    {
        f32x16 ae[4] = {};
#pragma unroll
        for (int sx = 0; sx < 16; ++sx) {
#pragma unroll
            for (int mt = 0; mt < 4; ++mt) ae[mt] = __builtin_amdgcn_mfma_f32_32x32x16_f16(*(const LAS f16x8*)(lds + SSM_WX + ((mt * 16 + sx) * 64 + lane) * 16), uf[sx], ae[mt], 0, 0, 0);
            if ((sx & 1) == 1) asm volatile("" ::: "memory"); }
#pragma unroll
        for (int mt = 0; mt < 4; ++mt)
#pragma unroll
            for (int r = 0; r < 16; r += 2) { const int p = 16 * mt + (crow(r, hh) >> 1);
                *(LAS unsigned*)(lds + SSM_EH + n * SSM_EHP + 4 * p) = pg8::pk_f16(ae[mt][r], ae[mt][r + 1]); }
    }
    __syncthreads();
#pragma unroll
    for (int i = 0; i < 8; ++i) { const int f = wave * 8 + i;
        __builtin_amdgcn_global_load_lds((const unsigned*)(cbase + SSMC_WC + f * 1024 + lane * 16), (LAS unsigned*)(lds + SSM_WX + f * 1024), 16, 0, 0); }
    {
        LAS unsigned char* eh = lds + SSM_EH + (32 * wave) * SSM_EHP + 4 * lane;
        float sr = 0.f, si = 0.f;
#pragma unroll 8
        for (int k = 0; k < 32; ++k) { const unsigned ev = *(const LAS unsigned*)(eh + k * SSM_EHP); const float er = pg8::h_lo(ev), ei = pg8::h_hi(ev);
            const float nr = a16r * sr - a16i * si + er, ni = a16r * si + a16i * sr + ei; sr = nr; si = ni; }
        LAS f32x2v* chs = (LAS f32x2v*)(lds + SSM_CHS);
        chs[wave * 64 + lane] = (f32x2v){sr, si};
        __syncthreads();
        float cr = 0.f, ci = 0.f;
        for (int v = 0; v < wave; ++v) { const f32x2v sv = chs[v * 64 + lane]; const float nr = a5r * cr - a5i * ci + sv.x, ni = a5r * ci + a5i * cr + sv.y; cr = nr; ci = ni; }
        sr = cr; si = ci;
#pragma unroll 8
        for (int k = 0; k < 32; ++k) { const unsigned ev = *(const LAS unsigned*)(eh + k * SSM_EHP); const float er = pg8::h_lo(ev), ei = pg8::h_hi(ev);
            *(LAS unsigned*)(eh + k * SSM_EHP) = pg8::pk_f16(sr, si);
            const float nr = a16r * sr - a16i * si + er, ni = a16r * si + a16i * sr + ei; sr = nr; si = ni; }
    }
    asm volatile("s_waitcnt vmcnt(0)" ::: "memory");
    __syncthreads();
    const int rhi = nl >> 4, co = nl & 15;
    const LAS unsigned char* kjl = lds + SSM_KJ + co * 32 + hh * 16;
#pragma unroll
    for (int mh = 0; mh < 2; ++mh) {
        f32x16 ay[4] = {};
#pragma unroll
        for (int sx = 0; sx < 16; ++sx) {
#pragma unroll
            for (int i = 0; i < 4; ++i) { const int mt = 4 * mh + i; const int lag0 = 2 * mt - sx;
                if (lag0 + 1 >= 0) { const int lag = lag0 + rhi; const int row = (lag0 >= 0) ? lag : (rhi ? 0 : 16);
                    ay[i] = __builtin_amdgcn_mfma_f32_32x32x16_f16(*(const LAS f16x8*)(kjl + row * 512), uf[sx], ay[i], 0, 0, 0); } }
            if ((sx & 1) == 1) asm volatile("" ::: "memory"); }
#pragma unroll
        for (int kc = 0; kc < 8; ++kc) { const f16x8 hfr = *(const LAS f16x8*)(lds + SSM_EH + n * SSM_EHP + 32 * kc + 16 * hh);
#pragma unroll
            for (int i = 0; i < 4; ++i) { const int mt = 4 * mh + i;
                ay[i] = __builtin_amdgcn_mfma_f32_32x32x16_f16(*(const LAS f16x8*)(lds + SSM_WX + ((mt * 8 + kc) * 64 + lane) * 16), hfr, ay[i], 0, 0, 0); }
            if ((kc & 1) == 1) asm volatile("" ::: "memory"); }
        LAS unsigned char* tr = lds + SSM_TR + wave * 2304;
#pragma unroll
        for (int i = 0; i < 4; ++i) { const int mt = 4 * mh + i;
#pragma unroll
            for (int q = 0; q < 4; ++q) { v2u w; w.x = pg8::pk_f16(gelu_tanh_fast(ay[i][4 * q]), gelu_tanh_fast(ay[i][4 * q + 1])); w.y = pg8::pk_f16(gelu_tanh_fast(ay[i][4 * q + 2]), gelu_tanh_fast(ay[i][4 * q + 3]));
                *(LAS v2u*)(tr + nl * 72 + (q >> 1) * 32 + (q & 1) * 16 + hh * 8) = w; }
#pragma unroll
            for (int r2 = 0; r2 < 2; ++r2) { const int n2 = (lane >> 2) + 16 * r2, qt = lane & 3;
                const v2u lo = *(const LAS v2u*)(tr + n2 * 72 + qt * 16), hi2 = *(const LAS v2u*)(tr + n2 * 72 + qt * 16 + 8);
                *(v4u*)(Y2 + ((size_t)g * MTOK + b * SEQ + 16 * (32 * wave + n2) + 2 * mt) * 16 + qt * 8) = (v4u){lo.x, lo.y, hi2.x, hi2.y}; }
            asm volatile("" ::: "memory"); }
    }
    __syncthreads();
}
__device__ __forceinline__ void phase_ssm(const Params& P, int layer, LAS unsigned char* lds, int vcu, int G) {
    for (int it = vcu; it < SSM_G * BATCH; it += G) ssm_item(P, layer, lds, it);
}


#define XB_TMO      128
#define XB_XCNT(j)  (256  + 64 * (j))
#define XB_XSUB(j)  (1280 + 64 * (j))
#define XB_XGEN(j)  (2304 + 64 * (j))
#define XB_TOP      3328
#define XB_TOPGEN   3392
#define XCD_BAR_WORDS 3456
#define XB_SPIN_CAP (1u << 18)
__device__ __forceinline__ unsigned xb_ld(unsigned* p)              { return __hip_atomic_load(p, __ATOMIC_RELAXED, __HIP_MEMORY_SCOPE_AGENT); }
__device__ __forceinline__ unsigned xb_add(unsigned* p, unsigned v) { return __hip_atomic_fetch_add(p, v, __ATOMIC_RELAXED, __HIP_MEMORY_SCOPE_AGENT); }
__device__ __forceinline__ unsigned xb_xcc_id() { return (unsigned)__builtin_amdgcn_s_getreg((3 << 11) | 20) & 0xFu; }
#define XB_SPIN(cond, bar) do { unsigned _sp = 0; while (cond) { __builtin_amdgcn_s_sleep(1); \
    if ((++_sp & 255u) == 0u) { if (xb_ld(&(bar)[XB_TMO])) break; if (_sp > XB_SPIN_CAP) { atomicAdd(&(bar)[XB_TMO], 1u); break; } } } } while (0)
struct XcdBarrier { unsigned* bar; unsigned x; volatile LAS unsigned* st; };
__device__ __forceinline__ XcdBarrier xcd_barrier_post(unsigned* bar, volatile LAS unsigned* st) {
    XcdBarrier b; b.bar = bar; b.x = xb_xcc_id(); b.st = st;
    if (threadIdx.x == 0) (void)xb_add(&bar[XB_XCNT(b.x)], 1u);
    return b;
}
__device__ __forceinline__ void xcd_barrier_complete(unsigned* bar, unsigned x, unsigned& nloc, unsigned& nx) {
    const unsigned G = gridDim.x * gridDim.y * gridDim.z;
    unsigned sum, cnt, mine, sp = 0u;
    for (;;) {
        sum = 0u; cnt = 0u; mine = 0u;
#pragma unroll
        for (unsigned j = 0; j < 16; ++j) { const unsigned c = xb_ld(&bar[XB_XCNT(j)]); sum += c; cnt += (c > 0u) ? 1u : 0u; mine = (j == x) ? c : mine; }
        if (sum == G) break;
        __builtin_amdgcn_s_sleep(1);
        if ((++sp & 255u) == 0u) { if (xb_ld(&bar[XB_TMO])) break; if (sp > XB_SPIN_CAP) { atomicAdd(&bar[XB_TMO], 1u); break; } }
    }
    nloc = mine > 0u ? mine : 1u; nx = cnt > 0u ? cnt : 1u;
}
__device__ __forceinline__ void xcd_barrier(const XcdBarrier& b) {
    asm volatile("s_waitcnt vmcnt(0)" ::: "memory");
    __syncthreads();
    if (threadIdx.x == 0) {
        unsigned* bar = b.bar;
        __builtin_amdgcn_s_waitcnt(0);
        unsigned nloc = b.st[0], nx = b.st[1];
        if (nloc == 0u) { xcd_barrier_complete(bar, b.x, nloc, nx); b.st[0] = nloc; b.st[1] = nx; }
        const unsigned old = xb_add(&bar[XB_XSUB(b.x)], 1u);
        const unsigned gen = old / nloc;
        if (old + 1u == (gen + 1u) * nloc) {
            __builtin_amdgcn_fence(__ATOMIC_RELEASE, "agent");
            asm volatile("s_waitcnt vmcnt(0)" ::: "memory");
            const unsigned og = xb_add(&bar[XB_TOP], 1u);
            const unsigned tg = og / nx;
            if (og + 1u == (tg + 1u) * nx) xb_add(&bar[XB_TOPGEN], 1u);
            else XB_SPIN(xb_ld(&bar[XB_TOPGEN]) == tg, bar);
            __builtin_amdgcn_fence(__ATOMIC_ACQUIRE, "agent");
            xb_add(&bar[XB_XGEN(b.x)], 1u);
            asm volatile("s_waitcnt vmcnt(0)" ::: "memory");
        } else {
            XB_SPIN(xb_ld(&bar[XB_XGEN(b.x)]) == gen, bar);
            __builtin_amdgcn_fence(__ATOMIC_ACQUIRE, "agent");
            asm volatile("s_waitcnt vmcnt(0)" ::: "memory");
        }
    }
    __syncthreads();
}
constexpr size_t WS_CTL = WS_MISC + 512 * 1024;
constexpr int CTL_BYTES = 16384;

template <class Sched> __device__ __forceinline__ LAS float* inproj_rstd_to_lds(const Params& P, LAS unsigned char* lds, const Sched& S) {
    LAS float* rl = (LAS float*)(lds + 131072);
    const int tid = opaque_tid(); const float* sumsq = (const float*)(P.ws + WS_SUMSQ); pg8::Unit u;
    for (int i = tid >> 8; S.next(i, u); i += 2) { const int r = u.pm * 256 + (tid & 255);
        const f32x4* sp = (const f32x4*)(sumsq + (size_t)r * 16); const f32x4 s0 = sp[0], s1 = sp[1], s2 = sp[2], s3 = sp[3];
        const float ss = ((s0[0] + s0[1]) + (s0[2] + s0[3])) + ((s1[0] + s1[1]) + (s1[2] + s1[3])) + ((s2[0] + s2[1]) + (s2[2] + s2[3])) + ((s3[0] + s3[1]) + (s3[2] + s3[3]));
        rl[i * 256 + (tid & 255)] = rsqrtf(ss * (1.f / D_MODEL) + EPS); }
    asm volatile("s_waitcnt vmcnt(0) lgkmcnt(0)" ::: "memory"); __syncthreads();
    return rl;
}
constexpr int DEFER_TILE = 8;
__device__ __forceinline__ bool defer_mode(int layer, int G) { return layer > 0 && G == 256; }
__device__ __forceinline__ void run_inproj(const Params& P, int layer, LAS unsigned char* lds, int G, int bx) {
    unsigned char* ws = P.ws;
    pg8::Gemm g{(const bf16_t*)(ws + WS_XB), (const bf16_t*)(ws + WS_WIN) + (size_t)layer * IN_W * D_MODEL, MTOK, IN_W, D_MODEL};
    if (defer_mode(layer, G)) { pg8::SkipOrder S; S.init2(g.M, g.N, G, bx, DEFER_TILE); LAS float* rl = inproj_rstd_to_lds(P, lds, S);
        pg8::EpiZ E{(bf16_t*)(ws + WS_Z), rl, (const bf16_t*)(ws + WS_ROPE), P.q_norm_g + layer * HD, P.k_norm_g + layer * HD}; pg8::gemm_phase<pg8::EpiZ, pg8::SkipOrder, true>(lds, g, S, E); }
    else { pg8::StaticOrder S; S.init(g.M, g.N, G, bx); LAS float* rl = inproj_rstd_to_lds(P, lds, S);
        pg8::EpiZ E{(bf16_t*)(ws + WS_Z), rl, (const bf16_t*)(ws + WS_ROPE), P.q_norm_g + layer * HD, P.k_norm_g + layer * HD}; pg8::gemm_phase<pg8::EpiZ, pg8::StaticOrder, true>(lds, g, S, E); }
}
__device__ __forceinline__ void run_inproj_tail(const Params& P, int layer, LAS unsigned char* lds, int G, int bx) {
    if (!defer_mode(layer, G)) return;
    unsigned char* ws = P.ws;
    pg8::Gemm g{(const bf16_t*)(ws + WS_XB), (const bf16_t*)(ws + WS_WIN) + (size_t)layer * IN_W * D_MODEL, MTOK, IN_W, D_MODEL};
    pg8::DeferOrder S; S.init(g.M, G, bx, DEFER_TILE); LAS float* rl = inproj_rstd_to_lds(P, lds, S);
    pg8::EpiZ E{(bf16_t*)(ws + WS_Z), rl, (const bf16_t*)(ws + WS_ROPE), P.q_norm_g + layer * HD, P.k_norm_g + layer * HD};
    pg8::gemm_phase<pg8::EpiZ, pg8::DeferOrder, true>(lds, g, S, E);
}
__device__ __forceinline__ void run_glu(const Params& P, int layer, LAS unsigned char* lds, int G, int bx) {
    unsigned char* ws = P.ws;
    pg8::Gemm g{(const bf16_t*)(ws + WS_Y2), (const bf16_t*)(ws + WS_WGLU) + (size_t)layer * SSM_W * SSM_W, MTOK, SSM_W, SSM_W}; pg8::StaticOrder S; S.init(g.M, g.N, G, bx);
    pg8::EpiGlu E{(const bf16_t*)(ws + WS_Y2), (const bf16_t*)(ws + WS_Z), P.b_glu + layer * SSM_W, (bf16_t*)(ws + WS_MIX)};
    pg8::gemm_phase<pg8::EpiGlu, pg8::StaticOrder, true, pg8::AGroupMajor>(lds, g, S, E);
}
__device__ __forceinline__ void run_outproj(const Params& P, int layer, LAS unsigned char* lds, int G, int bx) {
    unsigned char* ws = P.ws;
    pg8::Gemm g{(const bf16_t*)(ws + WS_MIX), (const bf16_t*)(ws + WS_WOUT) + (size_t)layer * D_MODEL * MIX_W, MTOK, D_MODEL, MIX_W}; pg8::StaticOrder S; S.init(g.M, g.N, G, bx);
    if (layer == 0) { pg8::EpiOut<0> E{P.x, P.out, (bf16_t*)(ws + WS_XB), (float*)(ws + WS_SUMSQ)}; pg8::gemm_phase<pg8::EpiOut<0>, pg8::StaticOrder, true>(lds, g, S, E); }
    else if (layer + 1 < DEPTH) { pg8::EpiOut<1> E{P.x, P.out, (bf16_t*)(ws + WS_XB), (float*)(ws + WS_SUMSQ)}; pg8::gemm_phase<pg8::EpiOut<1>, pg8::StaticOrder, true>(lds, g, S, E); }
    else { pg8::EpiOut<2> E{P.x, P.out, (bf16_t*)(ws + WS_XB), (float*)(ws + WS_SUMSQ)}; pg8::gemm_phase<pg8::EpiOut<2>, pg8::StaticOrder, true>(lds, g, S, E); }
}
__device__ __forceinline__ void run_memgemm(const Params& P, LAS unsigned char* lds, int G, int bx) {
    unsigned char* ws = P.ws;
    pg8::Gemm g{(const bf16_t*)(ws + WS_MEMB), (const bf16_t*)(ws + WS_WMEM), BATCH * N_MEM, DEPTH * 1024, D_MODEL}; pg8::MemTailOrder S; S.init(g.M, g.N, G, bx, ((MTOK / 256) * (IN_W / 256)) % G);
    pg8::EpiMemF32 E{(float*)(ws + WS_Y2), DEPTH * 1024, (const float*)(ws + WS_MISC)};
    pg8::gemm_phase<pg8::EpiMemF32, pg8::MemTailOrder, true>(lds, g, S, E);
}


template <class T> __device__ __forceinline__ T* as_global(unsigned long long v) { return (T*)(__attribute__((address_space(1))) T*)v; }
__device__ __forceinline__ Params load_params() {
    typedef const volatile unsigned long long __attribute__((address_space(4)))* kp_t;
    kp_t kp = (kp_t)__builtin_amdgcn_kernarg_segment_ptr();
    Params q;
    q.x = as_global<const float>(kp[0]); q.mem = as_global<const float>(kp[1]); q.pos = as_global<const int>(kp[2]); q.norm_g = as_global<const float>(kp[3]);
    q.w_in = as_global<const float>(kp[4]); q.q_norm_g = as_global<const float>(kp[5]); q.k_norm_g = as_global<const float>(kp[6]); q.sinks = as_global<const float>(kp[7]);
    q.lam_re = as_global<const float>(kp[8]); q.lam_im = as_global<const float>(kp[9]); q.log_dt = as_global<const float>(kp[10]); q.b_re = as_global<const float>(kp[11]);
    q.b_im = as_global<const float>(kp[12]); q.c_re = as_global<const float>(kp[13]); q.c_im = as_global<const float>(kp[14]); q.d_skip = as_global<const float>(kp[15]);
    q.w_glu = as_global<const float>(kp[16]); q.b_glu = as_global<const float>(kp[17]); q.mem_norm_g = as_global<const float>(kp[18]); q.w_mem_kv = as_global<const float>(kp[19]);
    q.xq_norm_g = as_global<const float>(kp[20]); q.xk_norm_g = as_global<const float>(kp[21]); q.w_out = as_global<const float>(kp[22]);
    q.out = as_global<float>(kp[23]); q.ws = as_global<unsigned char>(kp[24]);
    return q;
}
static_assert(sizeof(Params) == 25 * 8, "Params is 25 pointers");
__global__ void __launch_bounds__(NTHREADS, 2) k_mega(Params Parg) {
    extern __shared__ __attribute__((aligned(16))) unsigned char lds_raw[];
    LAS unsigned char* lds = (LAS unsigned char*)lds_raw;
    const int G = gridDim.x, bx = blockIdx.x; const int vcu = (G % 8 == 0) ? (bx % 8) * (G / 8) + bx / 8 : bx;
    for (int u = threadIdx.x; u < (LDS_BYTES - LDSCTL_OFF) / 4; u += NTHREADS) ((LAS unsigned*)(lds + LDSCTL_OFF))[u] = 0u;
    __syncthreads();
    (void)xcd_barrier_post((unsigned*)(Parg.ws + WS_CTL), (volatile LAS unsigned*)(lds + LDSCTL_OFF));
#define GRID_BARRIER() do { XcdBarrier bar_; { const Params Pb = load_params(); bar_.bar = (unsigned*)(Pb.ws + WS_CTL); } unsigned xq_ = xb_xcc_id(); asm volatile("" : "+s"(xq_)); bar_.x = xq_; bar_.st = (volatile LAS unsigned*)(lds + LDSCTL_OFF); xcd_barrier(bar_); } while (0)
    { const Params P = load_params(); phase_prep(P, lds, vcu, G); } __syncthreads();
    { const Params P = load_params(); phase_ssm_consts(P, lds, vcu, G); }
    GRID_BARRIER();
    { const Params P = load_params(); run_inproj(P, 0, lds, G, bx); }
    { const Params P = load_params(); run_memgemm(P, lds, G, bx); }
    GRID_BARRIER();
    { const Params P = load_params(); phase_memfin(P, vcu, G); }
    GRID_BARRIER();
#pragma unroll 1
    for (int layer = 0; layer < DEPTH; ++layer) {
        { const Params P = load_params(); run_inproj_tail(P, layer, lds, G, bx); }
        { const Params P = load_params(); phase_attn_a(P, layer, lds, vcu, G, bx, defer_mode(layer, G)); }
        { const Params P = load_params(); phase_attn_c(P, layer, lds, vcu, G); }
        { const Params P = load_params(); phase_ssm(P, layer, lds, vcu, G); }
        GRID_BARRIER();
        { const Params P = load_params(); run_glu(P, layer, lds, G, bx); }
        GRID_BARRIER();
        { const Params P = load_params(); run_outproj(P, layer, lds, G, bx); }
        if (layer + 1 < DEPTH) { GRID_BARRIER(); { const Params P = load_params(); run_inproj(P, layer + 1, lds, G, bx); } GRID_BARRIER(); }
    }
}

extern "C" void kernel_launch(void* const* d_in, const int* in_sizes, int n_in, void* d_out, int out_size, void* d_ws, size_t ws_size, hipStream_t stream) {
    if (ws_size < WS_END || n_in != 23) return;
    Params P{};
    P.x = (const float*)d_in[0]; P.mem = (const float*)d_in[1]; P.pos = (const int*)d_in[2]; P.norm_g = (const float*)d_in[3]; P.w_in = (const float*)d_in[4];
    P.q_norm_g = (const float*)d_in[5]; P.k_norm_g = (const float*)d_in[6]; P.sinks = (const float*)d_in[7]; P.lam_re = (const float*)d_in[8]; P.lam_im = (const float*)d_in[9];
    P.log_dt = (const float*)d_in[10]; P.b_re = (const float*)d_in[11]; P.b_im = (const float*)d_in[12]; P.c_re = (const float*)d_in[13]; P.c_im = (const float*)d_in[14];
    P.d_skip = (const float*)d_in[15]; P.w_glu = (const float*)d_in[16]; P.b_glu = (const float*)d_in[17]; P.mem_norm_g = (const float*)d_in[18]; P.w_mem_kv = (const float*)d_in[19];
    P.xq_norm_g = (const float*)d_in[20]; P.xk_norm_g = (const float*)d_in[21]; P.w_out = (const float*)d_in[22];
    P.out = (float*)d_out; P.ws = (unsigned char*)d_ws;
    static int coop_grid = 0;
    if (coop_grid == 0) {
        int dev = 0, cus = 0, per_cu = 0; hipGetDevice(&dev); hipDeviceGetAttribute(&cus, hipDeviceAttributeMultiprocessorCount, dev);
        (void)hipFuncSetAttribute((const void*)k_mega, hipFuncAttributeMaxDynamicSharedMemorySize, LDS_BYTES);
        if (hipOccupancyMaxActiveBlocksPerMultiprocessor(&per_cu, (const void*)k_mega, NTHREADS, LDS_BYTES) != hipSuccess || per_cu < 1) { fprintf(stderr, "kernel_launch: occupancy query says %d blocks/CU\n", per_cu); (void)hipGetLastError(); per_cu = 1; }
        if (per_cu > 1) per_cu = 1;
        coop_grid = (cus > 0 ? cus : 256) * per_cu;
    }
    (void)hipMemsetAsync((char*)d_ws + WS_CTL, 0, CTL_BYTES, stream);
    { void* args[] = {(void*)&P}; hipError_t e = hipLaunchCooperativeKernel((const void*)k_mega, dim3(coop_grid), dim3(NTHREADS), args, LDS_BYTES, stream);
      if (e != hipSuccess) fprintf(stderr, "cooperative launch failed: %s (grid %d)\n", hipGetErrorString(e), coop_grid); }
}
```
